# Optimizing an MI355X kernel written in HIP

```python
import math
import jax, jax.numpy as jnp
from jax import lax
import numpy as np

D_MODEL = 1024
BATCH = 8
SEQ = 2048
DEPTH = 1
DEC_BATCH = 128
DEC_SEQ = 8
PAST_LEN = 16384
PAGE_SIZE = 128

D_MIX = D_MODEL
A_WIDTH = D_MIX // 2
A_HEAD = 64
A_HEADS = A_WIDTH // A_HEAD
A_DECAY_LORA = 64
A_AAA_LORA = 64
A_GATE_LORA = 128
A_SHIFT_W = 3 * A_WIDTH + A_DECAY_LORA + A_AAA_LORA + A_GATE_LORA
B_WIDTH = D_MIX - A_WIDTH
B_HEAD = 128
B_HEADS = B_WIDTH // B_HEAD
B_CONV = 4
B_QKV = 3 * B_WIDTH
B_CHUNK = 64
B_PROJ_W = B_QKV + B_WIDTH + 2 * B_HEADS
IN_W = A_SHIFT_W + B_PROJ_W
D_FF = 2816
FFN_CONV = 3
PLE_DIM = 256
DN_ALPHA = (2.0 * DEPTH) ** 0.25
DN_BETA = (8.0 * DEPTH) ** -0.25
LN_EPS = 1e-5
GN_EPS = 64e-5
RMS_EPS = 1e-6
L2_EPS = 1e-12

kernel_name = 'hybrid_rwkv7_gdn_convffn_step'

F32 = jnp.float32


def _split_at(t, sizes):
    idx = np.cumsum(sizes)[:-1].tolist()
    return jnp.split(t, idx, axis=-1)


def _heads(t, n_heads):
    return t.reshape(t.shape[:-1] + (n_heads, t.shape[-1] // n_heads))


def _layer_norm(x, g, b):
    xf = x.astype(F32)
    mu = xf.mean(-1, keepdims=True)
    var = jnp.square(xf - mu).mean(-1, keepdims=True)
    return ((xf - mu) * lax.rsqrt(var + LN_EPS) * g + b).astype(x.dtype)


def _rms_norm(x, g):
    xf = x.astype(F32)
    return (xf * lax.rsqrt(jnp.square(xf).mean(-1, keepdims=True) + RMS_EPS) * g).astype(x.dtype)


def _l2norm(x):
    xf = x.astype(F32)
    return xf * lax.rsqrt(jnp.square(xf).sum(-1, keepdims=True) + L2_EPS)


def _causal_dwconv(buf, x, w):
    K = w.shape[0]
    T = x.shape[1]
    full = jnp.concatenate([buf.astype(x.dtype), x], axis=1)
    y = sum(full[:, j:j + T] * w[j] for j in range(K))
    return y, full[:, full.shape[1] - (K - 1):]


def _rwkv7_mix(u, shift_buf, wkv0, mu, w0, w_w2, a0, w_a2, w_g2, k_k, k_a, r_k, gn_g, gn_b):
    bsz, T, _ = u.shape
    prev = jnp.concatenate([shift_buf[:, None, :].astype(u.dtype), u[:, :-1]], axis=1)
    xs = u + (prev - u) * mu
    r, k, v, wd, ad, gd = _split_at(xs, (A_WIDTH, A_WIDTH, A_WIDTH, A_DECAY_LORA, A_AAA_LORA, A_GATE_LORA))
    w = -jax.nn.softplus(-(w0 + jnp.tanh(wd) @ w_w2)) - 0.5
    decay = jnp.exp(-jnp.exp(w.astype(F32)))
    a = jax.nn.sigmoid(a0 + ad @ w_a2)
    g = jax.nn.sigmoid(gd) @ w_g2
    kk = _l2norm(_heads(k * k_k, A_HEADS))
    k = k * (1.0 + (a - 1.0) * k_a)
    r_h, k_h, v_h, a_h, w_h = (_heads(t, A_HEADS).astype(F32) for t in (r, k, v, a, decay))

    def step(S, inp):
        r_t, w_t, k_t, v_t, kk_t, a_t = inp
        sa = jnp.einsum('bhvk,bhk->bhv', S, -kk_t)
        S = S * w_t[:, :, None, :] + sa[..., None] * (kk_t * a_t)[:, :, None, :] + v_t[..., None] * k_t[:, :, None, :]
        return S, jnp.einsum('bhvk,bhk->bhv', S, r_t)

    seq = tuple(jnp.swapaxes(t, 0, 1) for t in (r_h, w_h, k_h, v_h, kk, a_h))
    S_fin, o = lax.scan(step, wkv0.astype(F32), seq)
    o = jnp.swapaxes(o, 0, 1)
    mean = o.mean(-1, keepdims=True)
    var = jnp.square(o - mean).mean(-1, keepdims=True)
    o = (o - mean) * lax.rsqrt(var + GN_EPS) * gn_g.reshape(A_HEADS, A_HEAD) + gn_b.reshape(A_HEADS, A_HEAD)
    bonus = (r_h * k_h * r_k.reshape(A_HEADS, A_HEAD)).sum(-1, keepdims=True) * v_h
    o = (o + bonus).reshape(bsz, T, A_WIDTH) * g
    return o.astype(u.dtype), u[:, -1].astype(shift_buf.dtype), S_fin.astype(wkv0.dtype)


def _chunk_gated_delta(q, k, v, beta, g, S0):
    bsz, T, H, Dk = q.shape
    Dv = v.shape[-1]
    C = min(B_CHUNK, T)
    n = -(-T // C)
    pad = n * C - T

    def prep(t):
        t = jnp.pad(t.astype(F32), [(0, 0), (0, pad)] + [(0, 0)] * (t.ndim - 2))
        t = t.reshape((bsz, n, C) + t.shape[2:])
        return jnp.moveaxis(jnp.swapaxes(t, 2, 3), 1, 0)

    q, k, v, beta, g = (prep(t) for t in (q, k, v, beta, g))
    G = jnp.cumsum(g, axis=-1)
    diff = G[..., :, None] - G[..., None, :]
    incl = jnp.tril(jnp.ones((C, C), bool))
    strict = jnp.tril(jnp.ones((C, C), bool), -1)
    dec_incl = jnp.exp(jnp.where(incl, diff, -jnp.inf))
    dec_strict = jnp.where(strict, dec_incl, 0.0)
    kb = k * beta[..., None]
    Lmat = jnp.einsum('nbhid,nbhjd->nbhij', kb, k) * dec_strict
    eye = jnp.eye(C, dtype=F32)
    rhs = jnp.concatenate([v * beta[..., None], kb * jnp.exp(G)[..., None]], axis=-1)
    sol = lax.linalg.triangular_solve(eye + Lmat, rhs, left_side=True, lower=True, unit_diagonal=True)
    u_val, w_k = sol[..., :Dv], sol[..., Dv:]
    attn_in = jnp.einsum('nbhid,nbhjd->nbhij', q, k) * dec_incl
    q_dec = q * jnp.exp(G)[..., None]
    k_dec = k * jnp.exp(G[..., -1:] - G)[..., None]
    g_last = jnp.exp(G[..., -1])

    def step(S, inp):
        u_c, w_c, a_c, q_c, k_c, gl = inp
        v_new = u_c - jnp.einsum('bhcd,bhdv->bhcv', w_c, S)
        o = jnp.einsum('bhcd,bhdv->bhcv', q_c, S) + jnp.einsum('bhij,bhjv->bhiv', a_c, v_new)
        S = S * gl[..., None, None] + jnp.einsum('bhcd,bhcv->bhdv', k_c, v_new)
        return S, o

    S_fin, o = lax.scan(step, S0.astype(F32), (u_val, w_k, attn_in, q_dec, k_dec, g_last))
    o = jnp.swapaxes(jnp.moveaxis(o, 0, 1), 2, 3).reshape(bsz, n * C, H, Dv)[:, :T]
    return o, S_fin


def _gated_delta_mix(proj, conv_buf, S0, conv_w, a_log, dt_bias, norm_g):
    bsz, T, _ = proj.shape
    qkv, z, b, a = _split_at(proj, (B_QKV, B_WIDTH, B_HEADS, B_HEADS))
    qkv_c, new_buf = _causal_dwconv(conv_buf, qkv, conv_w)
    qkv_c = jax.nn.silu(qkv_c)
    q, k, v = (_heads(t, B_HEADS) for t in jnp.split(qkv_c, 3, axis=-1))
    q = _l2norm(q) * (B_HEAD ** -0.5)
    k = _l2norm(k)
    beta = jax.nn.sigmoid(b.astype(F32))
    g = -jnp.exp(a_log) * jax.nn.softplus(a.astype(F32) + dt_bias)
    o, S_fin = _chunk_gated_delta(q, k, v, beta, g, S0)
    o = _rms_norm(o, norm_g) * jax.nn.silu(_heads(z, B_HEADS).astype(F32))
    return o.reshape(bsz, T, B_WIDTH).astype(proj.dtype), new_buf.astype(conv_buf.dtype), S_fin.astype(S0.dtype)


def _conv_ffn(x, buf, w_up, conv_w, conv_b, w_down):
    gate, up = jnp.split(x @ w_up, 2, axis=-1)
    gate_c, new_buf = _causal_dwconv(buf, gate, conv_w)
    y = (jax.nn.silu(gate_c + conv_b) * up) @ w_down
    return y, new_buf.astype(buf.dtype)


def _layer(x, p, st, lw):
    (w_in, a_mu, a_w0, a_w_w2, a_a0, a_w_a2, a_w_g2, a_k_k, a_k_a, a_r_k, a_gn_g, a_gn_b,
     b_conv_w, b_a_log, b_dt_bias, b_norm_g, w_o, ln1_g, ln1_b, w_up, f_conv_w, f_conv_b,
     w_down, ln2_g, ln2_b, w_ple, ple_g, w_ple_gate) = lw
    a_wkv, a_shift, b_ssm, b_conv, f_conv = st
    proj = x @ w_in
    o_a, a_shift_new, a_wkv_new = _rwkv7_mix(proj[..., :A_SHIFT_W], a_shift, a_wkv, a_mu, a_w0, a_w_w2,
                                             a_a0, a_w_a2, a_w_g2, a_k_k, a_k_a, a_r_k, a_gn_g, a_gn_b)
    o_b, b_conv_new, b_ssm_new = _gated_delta_mix(proj[..., A_SHIFT_W:], b_conv, b_ssm, b_conv_w,
                                                  b_a_log, b_dt_bias, b_norm_g)
    mix = jnp.concatenate([o_a, o_b], axis=-1) @ w_o
    x = _layer_norm(DN_ALPHA * x + mix, ln1_g, ln1_b)
    ffn, f_conv_new = _conv_ffn(x, f_conv, w_up, f_conv_w, f_conv_b, w_down)
    x = _layer_norm(DN_ALPHA * x + ffn, ln2_g, ln2_b)
    e = _rms_norm(p @ w_ple, ple_g)
    x = x + jax.nn.sigmoid(x @ w_ple_gate) * e
    return x, (a_wkv_new, a_shift_new, b_ssm_new, b_conv_new, f_conv_new)


def _trunk(x, p, states, weights):
    new = []
    for i in range(DEPTH):
        x, st = _layer(x, p[i], tuple(s[i] for s in states), tuple(w[i] for w in weights))
        new.append(st)
    stacked = tuple(jnp.stack([st[j] for st in new]) for j in range(len(states)))
    return x, stacked


def setup_inputs(seed: int = 0) -> dict:
    key = jax.random.key(seed)
    ks = iter(jax.random.split(key, 64))
    nrm = lambda shape, scale: scale * jax.random.normal(next(ks), shape, F32)
    uni = lambda shape, lo, hi: jax.random.uniform(next(ks), shape, F32, lo, hi)
    L = DEPTH
    dt = jnp.exp(uni((L, B_HEADS), math.log(1e-3), math.log(1e-1)))
    return {
        'x_prompt': nrm((BATCH, SEQ, D_MODEL), 1.0),
        'x_sample': nrm((DEC_BATCH, DEC_SEQ, D_MODEL), 1.0),
        'p_prompt': nrm((L, BATCH, SEQ, PLE_DIM), 1.0),
        'p_sample': nrm((L, DEC_BATCH, DEC_SEQ, PLE_DIM), 1.0),
        'state_a_wkv': nrm((L, DEC_BATCH, A_HEADS, A_HEAD, A_HEAD), 0.3),
        'state_a_shift': nrm((L, DEC_BATCH, A_SHIFT_W), 1.0),
        'state_b_ssm': nrm((L, DEC_BATCH, B_HEADS, B_HEAD, B_HEAD), 0.1),
        'state_b_conv': nrm((L, DEC_BATCH, B_CONV - 1, B_QKV), 1.0),
        'state_ffn_conv': nrm((L, DEC_BATCH, FFN_CONV - 1, D_FF), 1.0),
        'w_in': nrm((L, D_MODEL, IN_W), D_MODEL ** -0.5),
        'a_mu': uni((L, A_SHIFT_W), 0.0, 1.0),
        'a_w0': uni((L, A_WIDTH), -6.0, -1.0),
        'a_w_w2': nrm((L, A_DECAY_LORA, A_WIDTH), 0.1),
        'a_a0': nrm((L, A_WIDTH), 0.1),
        'a_w_a2': nrm((L, A_AAA_LORA, A_WIDTH), 0.5 * A_AAA_LORA ** -0.5),
        'a_w_g2': nrm((L, A_GATE_LORA, A_WIDTH), A_GATE_LORA ** -0.5),
        'a_k_k': 0.85 + nrm((L, A_WIDTH), 0.02),
        'a_k_a': 1.0 + nrm((L, A_WIDTH), 0.02),
        'a_r_k': nrm((L, A_WIDTH), 0.1),
        'a_gn_g': 1.0 + nrm((L, A_WIDTH), 0.02),
        'a_gn_b': nrm((L, A_WIDTH), 0.02),
        'b_conv_w': nrm((L, B_CONV, B_QKV), 0.5),
        'b_a_log': jnp.log(uni((L, B_HEADS), 1.0, 16.0)),
        'b_dt_bias': dt + jnp.log(-jnp.expm1(-dt)),
        'b_norm_g': 1.0 + nrm((L, B_HEAD), 0.02),
        'w_o': nrm((L, D_MIX, D_MODEL), DN_BETA * D_MIX ** -0.5),
        'ln1_g': 1.0 + nrm((L, D_MODEL), 0.02),
        'ln1_b': nrm((L, D_MODEL), 0.02),
        'w_up': nrm((L, D_MODEL, 2 * D_FF), D_MODEL ** -0.5),
        'f_conv_w': nrm((L, FFN_CONV, D_FF), FFN_CONV ** -0.5),
        'f_conv_b': nrm((L, D_FF), 0.02),
        'w_down': nrm((L, D_FF, D_MODEL), DN_BETA * D_FF ** -0.5),
        'ln2_g': 1.0 + nrm((L, D_MODEL), 0.02),
        'ln2_b': nrm((L, D_MODEL), 0.02),
        'w_ple': nrm((L, PLE_DIM, D_MODEL), PLE_DIM ** -0.5),
        'ple_g': 1.0 + nrm((L, D_MODEL), 0.02),
        'w_ple_gate': nrm((L, D_MODEL, D_MODEL), D_MODEL ** -0.5),
    }


def reference(x_prompt, x_sample, p_prompt, p_sample, state_a_wkv, state_a_shift, state_b_ssm,
              state_b_conv, state_ffn_conv, w_in, a_mu, a_w0, a_w_w2, a_a0, a_w_a2, a_w_g2, a_k_k,
              a_k_a, a_r_k, a_gn_g, a_gn_b, b_conv_w, b_a_log, b_dt_bias, b_norm_g, w_o, ln1_g,
              ln1_b, w_up, f_conv_w, f_conv_b, w_down, ln2_g, ln2_b, w_ple, ple_g, w_ple_gate):
    weights = (w_in, a_mu, a_w0, a_w_w2, a_a0, a_w_a2, a_w_g2, a_k_k, a_k_a, a_r_k, a_gn_g, a_gn_b,
               b_conv_w, b_a_log, b_dt_bias, b_norm_g, w_o, ln1_g, ln1_b, w_up, f_conv_w, f_conv_b,
               w_down, ln2_g, ln2_b, w_ple, ple_g, w_ple_gate)
    bp = x_prompt.shape[0]
    zeros = lambda *s: jnp.zeros((DEPTH, bp) + s, x_prompt.dtype)
    prompt_init = (zeros(A_HEADS, A_HEAD, A_HEAD), zeros(A_SHIFT_W), zeros(B_HEADS, B_HEAD, B_HEAD),
                   zeros(B_CONV - 1, B_QKV), zeros(FFN_CONV - 1, D_FF))
    y_prompt, (pa_wkv, pa_shift, pb_ssm, pb_conv, pf_conv) = _trunk(x_prompt, p_prompt, prompt_init, weights)
    sample_init = (state_a_wkv, state_a_shift, state_b_ssm, state_b_conv, state_ffn_conv)
    y_sample, (sa_wkv, sa_shift, sb_ssm, sb_conv, sf_conv) = _trunk(x_sample, p_sample, sample_init, weights)
    return (y_prompt, y_sample, pa_wkv, pa_shift, pb_ssm, pb_conv, pf_conv,
            sa_wkv, sa_shift, sb_ssm, sb_conv, sf_conv)
```

```cpp
#include <hip/hip_runtime.h>
#include <hip/hip_bf16.h>
#include <hip/hip_cooperative_groups.h>
#include <cstdio>
#include <cstring>
namespace cg = cooperative_groups;

#ifndef MULTI_LAUNCH
#define MULTI_LAUNCH 1
#endif

#define DI __device__ __forceinline__
typedef unsigned short bfu;
using bf16x8 = __attribute__((ext_vector_type(8))) short;
using f32x4 = __attribute__((ext_vector_type(4))) float;
using u32x4 = __attribute__((ext_vector_type(4))) unsigned;

constexpr int M_TOK = 17408, M_P = 16384, NSEQ = 136;
constexpr int DM = 1024, AW = 512, ASW = 1792, BQKV = 1536, PB_W = 2048, INW = 3848, INW_PAD = 3968;
constexpr int DFF = 2816, PLE = 256;
constexpr float DN_ALPHA = 1.189207115002721f;
constexpr float LN_EPS = 1e-5f, GN_EPS = 64e-5f, RMS_EPS = 1e-6f, L2_EPS = 1e-12f;

constexpr size_t O_Y = 0;
constexpr size_t O_PA_WKV = (size_t)M_TOK * 1024;
constexpr size_t O_PA_SHIFT = O_PA_WKV + 8 * 8 * 64 * 64;
constexpr size_t O_PB_SSM = O_PA_SHIFT + 8 * 1792;
constexpr size_t O_PB_CONV = O_PB_SSM + 8 * 4 * 128 * 128;
constexpr size_t O_PF_CONV = O_PB_CONV + 8 * 3 * 1536;
constexpr size_t O_SA_WKV = O_PF_CONV + 8 * 2 * 2816;
constexpr size_t O_SA_SHIFT = O_SA_WKV + (size_t)128 * 8 * 64 * 64;
constexpr size_t O_SB_SSM = O_SA_SHIFT + 128 * 1792;
constexpr size_t O_SB_CONV = O_SB_SSM + (size_t)128 * 4 * 128 * 128;
constexpr size_t O_SF_CONV = O_SB_CONV + 128 * 3 * 1536;

constexpr size_t WT_IN = 0;
constexpr size_t WT_W2 = WT_IN + (size_t)INW_PAD * 1024 * 2;
constexpr size_t WT_A2 = WT_W2 + 512 * 64 * 2;
constexpr size_t WT_G2 = WT_A2 + 512 * 64 * 2;
constexpr size_t WT_O = WT_G2 + 512 * 128 * 2;
constexpr size_t WT_UP = WT_O + 1024 * 1024 * 2;
constexpr size_t WT_DOWN = WT_UP + (size_t)5632 * 1024 * 2;
constexpr size_t WT_PLE = WT_DOWN + (size_t)1024 * 2816 * 2;
constexpr size_t WT_GATE = WT_PLE + 1024 * 256 * 2;
constexpr size_t OFF_STREAM = WT_GATE + 1024 * 1024 * 2;
constexpr size_t OFF_G = OFF_STREAM + (size_t)M_TOK * 8 * 384 * 2;
constexpr size_t OFF_PROJA = OFF_G + (size_t)M_TOK * 512 * 2;
constexpr size_t OFF_LORAIN = OFF_PROJA + (size_t)M_TOK * 1792 * 2;
constexpr size_t OFF_ABUF = OFF_LORAIN + (size_t)M_TOK * 256 * 2;
constexpr size_t OFF_BA = OFF_ABUF + (size_t)M_TOK * 512 * 2;
constexpr size_t OFF_BG = OFF_BA + (size_t)M_TOK * 8 * 4;
constexpr size_t OFF_BONUS = OFF_BG + (size_t)M_TOK * 8 * 4;
constexpr size_t OFF_RINV = OFF_BONUS + (size_t)M_TOK * 8 * 4;
constexpr size_t OFF_END = OFF_RINV + (size_t)M_TOK * 4;
constexpr size_t OFF_STREAMB = OFF_PROJA;
constexpr size_t OFF_OMIX = OFF_STREAMB + (size_t)M_TOK * 4 * 384 * 2;
constexpr size_t OFF_GU = OFF_STREAM;
constexpr size_t OFF_X2 = OFF_STREAM;
constexpr size_t OFF_EPRE = OFF_X2 + (size_t)M_TOK * 1024 * 4;
static_assert(OFF_OMIX + (size_t)M_TOK * 1024 * 2 <= OFF_BA, "omix overlap");
static_assert(OFF_GU + (size_t)M_TOK * 5632 * 2 <= OFF_BA, "gu overlap");
static_assert(OFF_END <= 256ull * 1024 * 1024, "ws too small");

struct WD { const float* src; bfu* dst; int K, N, Npad, t0; };

struct Params {
  const float *x_p, *x_s, *p_p, *p_s, *st_wkv, *st_shift, *st_ssm, *st_bconv, *st_fconv;
  const float *w_in, *a_mu, *a_w0, *a_w_w2, *a_a0, *a_w_a2, *a_w_g2, *a_k_k, *a_k_a, *a_r_k, *a_gn_g, *a_gn_b;
  const float *b_conv_w, *b_a_log, *b_dt_bias, *b_norm_g, *w_o, *ln1_g, *ln1_b, *w_up, *f_conv_w, *f_conv_b,
      *w_down, *ln2_g, *ln2_b, *w_ple, *ple_g, *w_ple_gate;
  float* out;
  char* ws;
  WD wd[9];
  int wd_tiles;
  int pad_;
};

DI bfu f2bf(float f) {
  unsigned u = __float_as_uint(f);
  u += 0x7fffu + ((u >> 16) & 1u);
  return (bfu)(u >> 16);
}
DI float bf2f(bfu h) { return __uint_as_float(((unsigned)h) << 16); }
DI unsigned pack2(float a, float b) { return (unsigned)f2bf(a) | ((unsigned)f2bf(b) << 16); }
DI float lo_bf(unsigned u) { return __uint_as_float(u << 16); }
DI float hi_bf(unsigned u) { return __uint_as_float(u & 0xffff0000u); }
DI float sigmoidf_(float x) { return 1.f / (1.f + __expf(-x)); }
DI float siluf_(float x) { return x / (1.f + __expf(-x)); }
DI float softplusf_(float x) { return fmaxf(x, 0.f) + log1pf(__expf(-fabsf(x))); }
DI float wave_sum(float v) {
#pragma unroll
  for (int o = 32; o > 0; o >>= 1) v += __shfl_xor(v, o, 64);
  return v;
}
DI float row16_sum(float x) {
  x += __int_as_float(__builtin_amdgcn_update_dpp(0, __float_as_int(x), 0x128, 0xf, 0xf, false));
  x += __int_as_float(__builtin_amdgcn_update_dpp(0, __float_as_int(x), 0x124, 0xf, 0xf, false));
  x += __int_as_float(__builtin_amdgcn_update_dpp(0, __float_as_int(x), 0x122, 0xf, 0xf, false));
  x += __int_as_float(__builtin_amdgcn_update_dpp(0, __float_as_int(x), 0x121, 0xf, 0xf, false));
  return x;
}
DI int seq_of_row(int m) { return m < M_P ? (m >> 11) : 8 + ((m - M_P) >> 3); }
DI int t_of_row(int m) { return m < M_P ? (m & 2047) : (m & 7); }
DI int row0_of_seq(int s) { return s < 8 ? s * 2048 : M_P + (s - 8) * 8; }
DI int T_of_seq(int s) { return s < 8 ? 2048 : 8; }

constexpr int SMEM_BYTES = 65536;

constexpr int LDT = 72;
constexpr int TILE_ELEMS = 128 * LDT;
constexpr int GBK = 64;

template <bool AF32>
DI void g_load(const void* __restrict__ Ap, int lda, const bfu* __restrict__ Bp, int K, int kt, int lrow, int lkc,
               u32x4 (&ra)[4], u32x4 (&rb)[4], f32x4 (&fa)[4][2]) {
#pragma unroll
  for (int j = 0; j < 4; ++j) {
    const int row = lrow + 32 * j;
    if constexpr (AF32) {
      const float* ap = (const float*)Ap + (size_t)row * lda + kt * GBK + lkc;
      fa[j][0] = *(const f32x4*)ap;
      fa[j][1] = *(const f32x4*)(ap + 4);
    } else {
      const bfu* ap = (const bfu*)Ap + (size_t)row * lda + kt * GBK + lkc;
      ra[j] = *(const u32x4*)ap;
    }
    rb[j] = *(const u32x4*)(Bp + (size_t)row * K + kt * GBK + lkc);
  }
}
template <bool AF32>
DI void l_store(bfu* As, bfu* Bs, int lrow, int lkc, const u32x4 (&ra)[4], const u32x4 (&rb)[4],
                const f32x4 (&fa)[4][2]) {
#pragma unroll
  for (int j = 0; j < 4; ++j) {
    const int row = lrow + 32 * j;
    u32x4 va;
    if constexpr (AF32) {
      va.x = pack2(fa[j][0].x, fa[j][0].y);
      va.y = pack2(fa[j][0].z, fa[j][0].w);
      va.z = pack2(fa[j][1].x, fa[j][1].y);
      va.w = pack2(fa[j][1].z, fa[j][1].w);
    } else {
      va = ra[j];
    }
    *(u32x4*)(As + row * LDT + lkc) = va;
    *(u32x4*)(Bs + row * LDT + lkc) = rb[j];
  }
}

template <bool AF32, class Epi>
DI void gemm_tile(const void* __restrict__ Ap, int lda, const bfu* __restrict__ Bp, int K, int m0, int n0,
                  bfu* smem, Epi epi) {
  const int tid = threadIdx.x, lane = tid & 63, wave = tid >> 6;
  const int wm = wave >> 1, wn = wave & 1;
  bfu* As = smem;
  bfu* Bs = smem + TILE_ELEMS;
  f32x4 acc[4][4];
#pragma unroll
  for (int i = 0; i < 4; ++i)
#pragma unroll
    for (int j = 0; j < 4; ++j) acc[i][j] = f32x4{0.f, 0.f, 0.f, 0.f};
  const int lrow = tid >> 3, lkc = (tid & 7) * 8;
  u32x4 ra[4], rb[4];
  f32x4 fa[4][2];
  const int nk = K / GBK;

  g_load<AF32>(Ap, lda, Bp, K, 0, lrow, lkc, ra, rb, fa);
  for (int kt = 0; kt < nk; ++kt) {
    __syncthreads();
    l_store<AF32>(As, Bs, lrow, lkc, ra, rb, fa);
    __syncthreads();
    if (kt + 1 < nk) g_load<AF32>(Ap, lda, Bp, K, kt + 1, lrow, lkc, ra, rb, fa);
#pragma unroll
    for (int ks = 0; ks < 2; ++ks) {
      bf16x8 af[4], bfr[4];
#pragma unroll
      for (int mi = 0; mi < 4; ++mi)
        af[mi] = *(const bf16x8*)(As + (wm * 64 + mi * 16 + (lane & 15)) * LDT + ks * 32 + (lane >> 4) * 8);
#pragma unroll
      for (int ni = 0; ni < 4; ++ni)
        bfr[ni] = *(const bf16x8*)(Bs + (wn * 64 + ni * 16 + (lane & 15)) * LDT + ks * 32 + (lane >> 4) * 8);
#pragma unroll
      for (int mi = 0; mi < 4; ++mi)
#pragma unroll
        for (int ni = 0; ni < 4; ++ni)
          acc[mi][ni] = __builtin_amdgcn_mfma_f32_16x16x32_bf16(bfr[ni], af[mi], acc[mi][ni], 0, 0, 0);
    }
  }
#pragma unroll
  for (int mi = 0; mi < 4; ++mi)
#pragma unroll
    for (int ni = 0; ni < 4; ++ni) {
      int m = m0 + wm * 64 + mi * 16 + (lane & 15);
      int n = n0 + wn * 64 + ni * 16 + (lane >> 4) * 4;
      epi(m, n, acc[mi][ni]);
    }
  __syncthreads();
}

DI void store_bf4(bfu* p, f32x4 v) {
  uint2 u;
  u.x = pack2(v[0], v[1]);
  u.y = pack2(v[2], v[3]);
  *(uint2*)p = u;
}

enum {
  PH_WT = 0,
  PH_GEMM_IN,
  PH_LORAIN,
  PH_LORA,
  PH_PREPA,
  PH_PREPB,
  PH_SCAN,
  PH_POST,
  PH_GEMM_O,
  PH_LN1,
  PH_GEMM_UP,
  PH_FFNCONV,
  PH_GEMM_DOWN,
  PH_LN2_PLE,
  PH_RINV,
  PH_GEMM_FIN,
  PH_COUNT
};

constexpr int MT = M_TOK / 128;

__host__ __device__ constexpr int units_of(int ph, int wd_tiles) {
  return ph == PH_WT ? wd_tiles
       : ph == PH_GEMM_IN ? MT * 31
       : ph == PH_LORAIN ? (M_TOK / 16 + NSEQ)
       : ph == PH_LORA ? MT * 4 * 3
       : ph == PH_PREPA ? M_TOK * 8 / 4
       : ph == PH_PREPB ? M_TOK / 8
       : ph == PH_SCAN ? 2 * NSEQ * 32
       : ph == PH_POST ? M_TOK * 3
       : ph == PH_GEMM_O ? MT * 8
       : ph == PH_LN1 ? M_TOK / 4
       : ph == PH_GEMM_UP ? MT * 44
       : ph == PH_FFNCONV ? M_TOK / 8
       : ph == PH_GEMM_DOWN ? MT * 8
       : ph == PH_LN2_PLE ? (M_TOK / 4 + MT * 8)
       : ph == PH_RINV ? M_TOK / 4
       : ph == PH_GEMM_FIN ? MT * 8
       : 0;
}

DI void ph_wt(const Params& P, int u, char* smem) {
  int wi = 0;
#pragma unroll
  for (int i = 1; i < 9; ++i)
    if (u >= P.wd[i].t0) wi = i;
  const float* src = P.wd[wi].src;
  bfu* dst = P.wd[wi].dst;
  const int K = P.wd[wi].K, N = P.wd[wi].N;
  int tl = u - P.wd[wi].t0;
  const int kts = K >> 6;
  const int nt = tl / kts, kt = tl - nt * kts;
  const int n0 = nt * 64, k0 = kt * 64;
  float* tile = (float*)smem;
  const int r = threadIdx.x >> 6, c = threadIdx.x & 63;
#pragma unroll
  for (int i = 0; i < 16; ++i) {
    int kr = i * 4 + r;
    float v = (n0 + c < N) ? src[(size_t)(k0 + kr) * N + n0 + c] : 0.f;
    tile[kr * 65 + c] = v;
  }
  __syncthreads();
#pragma unroll
  for (int i = 0; i < 16; ++i) {
    int nr = i * 4 + r;
    dst[(size_t)(n0 + nr) * K + k0 + c] = f2bf(tile[c * 65 + nr]);
  }
  __syncthreads();
}

DI void ph_gemm_in(const Params& P, int u, char* smem) {
  const int mt = u / 31, nt = u - mt * 31;
  const int m0 = mt * 128, n0 = nt * 128;
  const float* A = (m0 < M_P) ? P.x_p + (size_t)m0 * DM : P.x_s + (size_t)(m0 - M_P) * DM;
  bfu* projA = (bfu*)(P.ws + OFF_PROJA);
  bfu* projB = (bfu*)P.out;
  float* ba = (float*)(P.ws + OFF_BA);
  gemm_tile<true>(A, DM, (const bfu*)(P.ws + WT_IN) + (size_t)n0 * DM, DM, m0, n0, (bfu*)smem,
                  [&](int m, int n, f32x4 v) {
                    if (n < ASW) store_bf4(projA + (size_t)m * ASW + n, v);
                    else if (n < 3840) store_bf4(projB + (size_t)m * PB_W + (n - ASW), v);
                    else if (n < INW) *(f32x4*)(ba + (size_t)m * 8 + (n - 3840)) = v;
                  });
}

DI void ph_lorain(const Params& P, int u, char* smem) {
  const bfu* projA = (const bfu*)(P.ws + OFF_PROJA);
  const int tid = threadIdx.x;
  if (u < M_TOK / 16) {
    bfu* lin = (bfu*)(P.ws + OFF_LORAIN);
    const int col = 1536 + tid;
    const float mu = P.a_mu[col];
    const int m0 = u * 16;
    float uprev = 0.f;
    {
      int t = t_of_row(m0);
      if (t != 0) uprev = bf2f(projA[(size_t)(m0 - 1) * ASW + col]);
    }
    for (int i = 0; i < 16; ++i) {
      int m = m0 + i;
      int t = t_of_row(m);
      float uc = bf2f(projA[(size_t)m * ASW + col]);
      float prev = uprev;
      if (t == 0) {
        int s = seq_of_row(m);
        prev = (s < 8) ? 0.f : P.st_shift[(size_t)(s - 8) * ASW + col];
      }
      float xs = uc + (prev - uc) * mu;
      float o = (tid < 64) ? tanhf(xs) : (tid < 128 ? xs : sigmoidf_(xs));
      lin[(size_t)m * 256 + tid] = f2bf(o);
      uprev = uc;
    }
  } else {
    const int s = u - M_TOK / 16;
    const int row0 = row0_of_seq(s), T = T_of_seq(s);
    const bfu* projB = (const bfu*)P.out;
    float* oshift = P.out + (s < 8 ? O_PA_SHIFT + (size_t)s * ASW : O_SA_SHIFT + (size_t)(s - 8) * ASW);
    for (int i = tid; i < ASW; i += 256) oshift[i] = bf2f(projA[(size_t)(row0 + T - 1) * ASW + i]);
    float* oconv = P.out + (s < 8 ? O_PB_CONV + (size_t)s * 3 * BQKV : O_SB_CONV + (size_t)(s - 8) * 3 * BQKV);
    for (int i = tid; i < 3 * BQKV; i += 256) {
      int j = i / BQKV, c = i - j * BQKV;
      oconv[i] = bf2f(projB[(size_t)(row0 + T - 3 + j) * PB_W + c]);
    }
  }
}

DI void ph_lora(const Params& P, int u, char* smem) {
  const int which = u / (MT * 4);
  const int r = u - which * (MT * 4);
  const int mt = r >> 2, nt = r & 3;
  const int m0 = mt * 128, n0 = nt * 128;
  const bfu* lin = (const bfu*)(P.ws + OFF_LORAIN);
  if (which == 0) {
    bfu* stream = (bfu*)(P.ws + OFF_STREAM);
    const float* w0 = P.a_w0;
    gemm_tile<false>(lin + (size_t)m0 * 256, 256, (const bfu*)(P.ws + WT_W2) + (size_t)n0 * 64, 64, m0, n0,
                     (bfu*)smem, [&](int m, int n, f32x4 v) {
                       f32x4 e;
#pragma unroll
                       for (int j = 0; j < 4; ++j) {
                         float w = -softplusf_(-(w0[n + j] + v[j])) - 0.5f;
                         e[j] = __expf(w);
                       }
                       store_bf4(stream + ((size_t)(m * 8 + (n >> 6)) * 6 + 1) * 64 + (n & 63), e);
                     });
  } else if (which == 1) {
    bfu* abuf = (bfu*)(P.ws + OFF_ABUF);
    const float* a0 = P.a_a0;
    gemm_tile<false>(lin + (size_t)m0 * 256 + 64, 256, (const bfu*)(P.ws + WT_A2) + (size_t)n0 * 64, 64, m0, n0,
                     (bfu*)smem, [&](int m, int n, f32x4 v) {
                       f32x4 e;
#pragma unroll
                       for (int j = 0; j < 4; ++j) e[j] = sigmoidf_(a0[n + j] + v[j]);
                       store_bf4(abuf + (size_t)m * 512 + n, e);
                     });
  } else {
    bfu* gbuf = (bfu*)(P.ws + OFF_G);
    gemm_tile<false>(lin + (size_t)m0 * 256 + 128, 256, (const bfu*)(P.ws + WT_G2) + (size_t)n0 * 128, 128, m0, n0,
                     (bfu*)smem, [&](int m, int n, f32x4 v) { store_bf4(gbuf + (size_t)m * 512 + n, v); });
  }
}

DI void ph_prepa(const Params& P, int u, char* smem) {
  const int tid = threadIdx.x, lane = tid & 63, wave = tid >> 6;
  const int wt = u * 4 + wave;
  const int m = wt >> 3, h = wt & 7;
  const int c = h * 64 + lane;
  const bfu* projA = (const bfu*)(P.ws + OFF_PROJA);
  const bfu* abuf = (const bfu*)(P.ws + OFF_ABUF);
  bfu* stream = (bfu*)(P.ws + OFF_STREAM);
  const int t = t_of_row(m), s = seq_of_row(m);
  float xs[3];
#pragma unroll
  for (int j = 0; j < 3; ++j) {
    int col = j * 512 + c;
    float uc = bf2f(projA[(size_t)m * ASW + col]);
    float prev;
    if (t == 0) prev = (s < 8) ? 0.f : P.st_shift[(size_t)(s - 8) * ASW + col];
    else prev = bf2f(projA[(size_t)(m - 1) * ASW + col]);
    xs[j] = uc + (prev - uc) * P.a_mu[col];
  }
  const float r = xs[0], k = xs[1], v = xs[2];
  const float a = bf2f(abuf[(size_t)m * 512 + c]);
  float kkr = k * P.a_k_k[c];
  float ss = wave_sum(kkr * kkr);
  float kk = kkr * rsqrtf(ss + L2_EPS);
  float k2 = k * (1.f + (a - 1.f) * P.a_k_a[c]);
  float b = kk * a;
  float bonus = wave_sum(r * k2 * P.a_r_k[c]);
  bfu* sp = stream + (size_t)(m * 8 + h) * 384 + lane;
  sp[0] = f2bf(r);
  sp[128] = f2bf(k2);
  sp[192] = f2bf(v);
  sp[256] = f2bf(kk);
  sp[320] = f2bf(b);
  if (lane == 0) ((float*)(P.ws + OFF_BONUS))[m * 8 + h] = bonus;
}

DI void ph_prepb(const Params& P, int u, char* smem) {
  const int tid = threadIdx.x, lane = tid & 63, h = tid >> 6;
  const int m0 = u * 8;
  const int s = seq_of_row(m0), t0 = t_of_row(m0);
  const bfu* projB = (const bfu*)P.out;
  bfu* sb = (bfu*)(P.ws + OFF_STREAMB);
  float raw[11][3][2];
  float cw[4][3][2];
#pragma unroll
  for (int p = 0; p < 3; ++p) {
    int c = p * 512 + tid * 2;
#pragma unroll
    for (int j = 0; j < 4; ++j) {
      float2 w = *(const float2*)(P.b_conv_w + j * BQKV + c);
      cw[j][p][0] = w.x;
      cw[j][p][1] = w.y;
    }
#pragma unroll
    for (int i = 0; i < 11; ++i) {
      int tt = t0 + i - 3;
      float a0, a1;
      if (tt >= 0) {
        unsigned q = *(const unsigned*)(projB + (size_t)(m0 + i - 3) * PB_W + c);
        a0 = lo_bf(q);
        a1 = hi_bf(q);
      } else if (s >= 8) {
        float2 q = *(const float2*)(P.st_bconv + ((size_t)(s - 8) * 3 + i) * BQKV + c);
        a0 = q.x;
        a1 = q.y;
      } else {
        a0 = 0.f;
        a1 = 0.f;
      }
      raw[i][p][0] = a0;
      raw[i][p][1] = a1;
    }
  }
#pragma unroll
  for (int i = 0; i < 8; ++i) {
    float y[3][2];
#pragma unroll
    for (int p = 0; p < 3; ++p)
#pragma unroll
      for (int e = 0; e < 2; ++e) {
        float acc = 0.f;
#pragma unroll
        for (int j = 0; j < 4; ++j) acc += cw[j][p][e] * raw[i + j][p][e];
        y[p][e] = siluf_(acc);
      }
    float sq = wave_sum(y[0][0] * y[0][0] + y[0][1] * y[0][1]);
    float sk = wave_sum(y[1][0] * y[1][0] + y[1][1] * y[1][1]);
    float rq = rsqrtf(sq + L2_EPS) * 0.08838834764831845f;
    float rk = rsqrtf(sk + L2_EPS);
    bfu* dst = sb + (size_t)((m0 + i) * 4 + h) * 384 + lane * 2;
    *(unsigned*)(dst) = pack2(y[0][0] * rq, y[0][1] * rq);
    *(unsigned*)(dst + 128) = pack2(y[1][0] * rk, y[1][1] * rk);
    *(unsigned*)(dst + 256) = pack2(y[2][0], y[2][1]);
  }
  if (tid < 32) {
    int i = tid >> 2, hh = tid & 3;
    const float* ba = (const float*)(P.ws + OFF_BA) + (size_t)(m0 + i) * 8;
    float beta = sigmoidf_(ba[hh]);
    float g = -__expf(P.b_a_log[hh]) * softplusf_(ba[4 + hh] + P.b_dt_bias[hh]);
    float* bg = (float*)(P.ws + OFF_BG) + (size_t)(m0 + i) * 8;
    bg[hh] = beta;
    bg[4 + hh] = __expf(g);
  }
}

constexpr int CH = 16;

DI void chunk_gload(u32x4 (&rg)[3], const bfu* base, size_t step_stride, int nsteps) {
#pragma unroll
  for (int j = 0; j < 3; ++j) {
    int idx = threadIdx.x + 256 * j;
    int st = idx / 48, w = idx - st * 48;
    if (st < nsteps) rg[j] = *(const u32x4*)(base + (size_t)st * step_stride + w * 8);
  }
}
template <bool DECAY>
DI void chunk_lstore(const u32x4 (&rg)[3], float* buf, int nsteps) {
#pragma unroll
  for (int j = 0; j < 3; ++j) {
    int idx = threadIdx.x + 256 * j;
    int st = idx / 48, w = idx - st * 48;
    if (st < nsteps) {
      float4 a, b;
      a.x = lo_bf(rg[j].x); a.y = hi_bf(rg[j].x); a.z = lo_bf(rg[j].y); a.w = hi_bf(rg[j].y);
      b.x = lo_bf(rg[j].z); b.y = hi_bf(rg[j].z); b.z = lo_bf(rg[j].w); b.w = hi_bf(rg[j].w);
      if (DECAY && (w >> 3) == 1) {
        a.x = __expf(-a.x); a.y = __expf(-a.y); a.z = __expf(-a.z); a.w = __expf(-a.w);
        b.x = __expf(-b.x); b.y = __expf(-b.y); b.z = __expf(-b.z); b.w = __expf(-b.w);
      }
      float* d = buf + st * 384 + w * 8;
      *(float4*)d = a;
      *(float4*)(d + 4) = b;
    }
  }
}

DI void rwkv_unit(const Params& P, int u, char* smem) {
  const int tid = threadIdx.x, lane = tid & 63, wave = tid >> 6;
  const int s = u >> 5, h = (u >> 2) & 7, rgp = u & 3;
  const int T = T_of_seq(s), row0 = row0_of_seq(s);
  const int vl = wave * 4 + (lane >> 4);
  const int v = rgp * 16 + vl;
  const int j0 = (lane & 15) * 4;
  float* buf0 = (float*)smem;
  float* obuf = buf0 + 2 * CH * 384;
  float4 S;
  if (s < 8) S = float4{0.f, 0.f, 0.f, 0.f};
  else S = *(const float4*)(P.st_wkv + (((size_t)(s - 8) * 8 + h) * 64 + v) * 64 + j0);
  const bfu* stream = (const bfu*)(P.ws + OFF_STREAM) + ((size_t)row0 * 8 + h) * 384;
  const size_t sstride = 8 * 384;
  bfu* omix = (bfu*)(P.ws + OFF_OMIX);
  const int nch = (T + CH - 1) / CH;
  u32x4 rg[3];
  chunk_gload(rg, stream, sstride, min(CH, T));
  chunk_lstore<true>(rg, buf0, min(CH, T));
  __syncthreads();
  for (int c = 0; c < nch; ++c) {
    const int nsteps = min(CH, T - c * CH);
    const int nnext = (c + 1 < nch) ? min(CH, T - (c + 1) * CH) : 0;
    if (nnext > 0) chunk_gload(rg, stream + (size_t)(c + 1) * CH * sstride, sstride, nnext);
    const float* buf = buf0 + (c & 1) * CH * 384;
    for (int st = 0; st < nsteps; ++st) {
      const float* b = buf + st * 384;
      float4 r4 = *(const float4*)(b + j0);
      float4 w4 = *(const float4*)(b + 64 + j0);
      float4 k4 = *(const float4*)(b + 128 + j0);
      float vv = b[192 + v];
      float4 kk4 = *(const float4*)(b + 256 + j0);
      float4 b4 = *(const float4*)(b + 320 + j0);
      float p = S.x * kk4.x + S.y * kk4.y + S.z * kk4.z + S.w * kk4.w;
      p = row16_sum(p);
      float sa = -p;
      S.x = S.x * w4.x + (sa * b4.x + vv * k4.x);
      S.y = S.y * w4.y + (sa * b4.y + vv * k4.y);
      S.z = S.z * w4.z + (sa * b4.z + vv * k4.z);
      S.w = S.w * w4.w + (sa * b4.w + vv * k4.w);
      float q = S.x * r4.x + S.y * r4.y + S.z * r4.z + S.w * r4.w;
      q = row16_sum(q);
      if ((lane & 15) == 0) obuf[st * 16 + vl] = q;
    }
    __syncthreads();
    if (tid < nsteps * 16) {
      int st = tid >> 4, r = tid & 15;
      omix[(size_t)(row0 + c * CH + st) * 1024 + h * 64 + rgp * 16 + r] = f2bf(obuf[tid]);
    }
    if (nnext > 0) chunk_lstore<true>(rg, buf0 + ((c + 1) & 1) * CH * 384, nnext);
    __syncthreads();
  }
  float* o = P.out + (s < 8 ? O_PA_WKV + (((size_t)s * 8 + h) * 64 + v) * 64 + j0
                            : O_SA_WKV + (((size_t)(s - 8) * 8 + h) * 64 + v) * 64 + j0);
  *(float4*)o = S;
}

DI void delta_unit(const Params& P, int u, char* smem) {
  const int tid = threadIdx.x, lane = tid & 63, wave = tid >> 6;
  const int s = u >> 5, h = (u >> 3) & 3, cg_ = u & 7;
  const int T = T_of_seq(s), row0 = row0_of_seq(s);
  const int cl = wave * 4 + (lane >> 4);
  const int c = cg_ * 16 + cl;
  const int j0 = (lane & 15) * 8;
  float* buf0 = (float*)smem;
  float* obuf = buf0 + 2 * CH * 384;
  float* bgb = obuf + CH * 16;
  float S[8];
  if (s < 8) {
#pragma unroll
    for (int i = 0; i < 8; ++i) S[i] = 0.f;
  } else {
#pragma unroll
    for (int i = 0; i < 8; ++i) S[i] = P.st_ssm[(((size_t)(s - 8) * 4 + h) * 128 + j0 + i) * 128 + c];
  }
  const bfu* stream = (const bfu*)(P.ws + OFF_STREAMB) + ((size_t)row0 * 4 + h) * 384;
  const size_t sstride = 4 * 384;
  const float* bg = (const float*)(P.ws + OFF_BG);
  bfu* omix = (bfu*)(P.ws + OFF_OMIX);
  const int nch = (T + CH - 1) / CH;
  u32x4 rg[3];
  float bgr = 0.f;
  {
    int n0 = min(CH, T);
    chunk_gload(rg, stream, sstride, n0);
    if (tid < n0 * 2) bgr = bg[(size_t)(row0 + (tid >> 1)) * 8 + (tid & 1) * 4 + h];
    chunk_lstore<false>(rg, buf0, n0);
    if (tid < n0 * 2) bgb[tid] = bgr;
  }
  __syncthreads();
  for (int ci = 0; ci < nch; ++ci) {
    const int nsteps = min(CH, T - ci * CH);
    const int nnext = (ci + 1 < nch) ? min(CH, T - (ci + 1) * CH) : 0;
    if (nnext > 0) {
      chunk_gload(rg, stream + (size_t)(ci + 1) * CH * sstride, sstride, nnext);
      if (tid < nnext * 2) bgr = bg[(size_t)(row0 + (ci + 1) * CH + (tid >> 1)) * 8 + (tid & 1) * 4 + h];
    }
    const float* buf = buf0 + (ci & 1) * CH * 384;
    const float* bgc = bgb + (ci & 1) * CH * 2;
    for (int st = 0; st < nsteps; ++st) {
      const float* b = buf + st * 384;
      float4 q0 = *(const float4*)(b + j0), q1 = *(const float4*)(b + j0 + 4);
      float4 k0 = *(const float4*)(b + 128 + j0), k1 = *(const float4*)(b + 128 + j0 + 4);
      float vv = b[256 + c];
      float beta = bgc[st * 2], alpha = bgc[st * 2 + 1];
      float p = S[0] * k0.x + S[1] * k0.y + S[2] * k0.z + S[3] * k0.w + S[4] * k1.x + S[5] * k1.y + S[6] * k1.z +
                S[7] * k1.w;
      p = row16_sum(p);
      float vn = beta * (vv - alpha * p);
      S[0] = alpha * S[0] + k0.x * vn;
      S[1] = alpha * S[1] + k0.y * vn;
      S[2] = alpha * S[2] + k0.z * vn;
      S[3] = alpha * S[3] + k0.w * vn;
      S[4] = alpha * S[4] + k1.x * vn;
      S[5] = alpha * S[5] + k1.y * vn;
      S[6] = alpha * S[6] + k1.z * vn;
      S[7] = alpha * S[7] + k1.w * vn;
      float q = S[0] * q0.x + S[1] * q0.y + S[2] * q0.z + S[3] * q0.w + S[4] * q1.x + S[5] * q1.y + S[6] * q1.z +
                S[7] * q1.w;
      q = row16_sum(q);
      if ((lane & 15) == 0) obuf[st * 16 + cl] = q;
    }
    __syncthreads();
    if (tid < nsteps * 16) {
      int st = tid >> 4, r = tid & 15;
      omix[(size_t)(row0 + ci * CH + st) * 1024 + 512 + h * 128 + cg_ * 16 + r] = f2bf(obuf[tid]);
    }
    if (nnext > 0) {
      chunk_lstore<false>(rg, buf0 + ((ci + 1) & 1) * CH * 384, nnext);
      if (tid < nnext * 2) bgb[((ci + 1) & 1) * CH * 2 + tid] = bgr;
    }
    __syncthreads();
  }
  float* o = P.out + (s < 8 ? O_PB_SSM + (((size_t)s * 4 + h) * 128 + j0) * 128 + c
                            : O_SB_SSM + (((size_t)(s - 8) * 4 + h) * 128 + j0) * 128 + c);
#pragma unroll
  for (int i = 0; i < 8; ++i) o[(size_t)i * 128] = S[i];
}

DI void ph_scan(const Params& P, int u, char* smem) {
  if (u < 256) rwkv_unit(P, u, smem);
  else if (u < 512) delta_unit(P, u - 256, smem);
  else if (u < 512 + 4096) rwkv_unit(P, u - 512 + 256, smem);
  else delta_unit(P, u - 512 - 4096 + 256, smem);
}

DI void ph_post(const Params& P, int u, char* smem) {
  const int tid = threadIdx.x, lane = tid & 63, wave = tid >> 6;
  const int m = u / 3;
  const int task = (u - m * 3) * 4 + wave;
  bfu* omix = (bfu*)(P.ws + OFF_OMIX);
  if (task < 8) {
    const int h = task, c = h * 64 + lane;
    float o = bf2f(omix[(size_t)m * 1024 + c]);
    float mean = wave_sum(o) * (1.f / 64.f);
    float d = o - mean;
    float var = wave_sum(d * d) * (1.f / 64.f);
    float on = d * rsqrtf(var + GN_EPS) * P.a_gn_g[c] + P.a_gn_b[c];
    float v = bf2f(((const bfu*)(P.ws + OFF_STREAM))[(size_t)(m * 8 + h) * 384 + 192 + lane]);
    float bonus = ((const float*)(P.ws + OFF_BONUS))[m * 8 + h];
    float g = bf2f(((const bfu*)(P.ws + OFF_G))[(size_t)m * 512 + c]);
    omix[(size_t)m * 1024 + c] = f2bf((on + bonus * v) * g);
  } else {
    const int h = task - 8;
    const int ci = h * 128 + lane * 2;
    unsigned q = *(const unsigned*)(omix + (size_t)m * 1024 + 512 + ci);
    float o0 = lo_bf(q), o1 = hi_bf(q);
    float ms = wave_sum(o0 * o0 + o1 * o1) * (1.f / 128.f);
    float rinv = rsqrtf(ms + RMS_EPS);
    unsigned zq = *(const unsigned*)((const bfu*)P.out + (size_t)m * PB_W + 1536 + ci);
    float z0 = lo_bf(zq), z1 = hi_bf(zq);
    float r0 = o0 * rinv * P.b_norm_g[lane * 2] * siluf_(z0);
    float r1 = o1 * rinv * P.b_norm_g[lane * 2 + 1] * siluf_(z1);
    *(unsigned*)(omix + (size_t)m * 1024 + 512 + ci) = pack2(r0, r1);
  }
}

DI void ph_gemm_o(const Params& P, int u, char* smem) {
  const int mt = u >> 3, nt = u & 7;
  const int m0 = mt * 128, n0 = nt * 128;
  const bfu* A = (const bfu*)(P.ws + OFF_OMIX) + (size_t)m0 * 1024;
  const float* x = (m0 < M_P) ? P.x_p : P.x_s - (size_t)M_P * DM;
  float* y = P.out;
  gemm_tile<false>(A, 1024, (const bfu*)(P.ws + WT_O) + (size_t)n0 * 1024, 1024, m0, n0, (bfu*)smem,
                   [&](int m, int n, f32x4 v) {
                     f32x4 xv = *(const f32x4*)(x + (size_t)m * DM + n);
                     f32x4 r;
#pragma unroll
                     for (int j = 0; j < 4; ++j) r[j] = DN_ALPHA * xv[j] + v[j];
                     *(f32x4*)(y + (size_t)m * DM + n) = r;
                   });
}

DI void ln_row(const float* src, float* dst, const float* g, const float* b, int lane) {
  float4 v[4];
  float s = 0.f;
#pragma unroll
  for (int i = 0; i < 4; ++i) {
    v[i] = *(const float4*)(src + i * 256 + lane * 4);
    s += v[i].x + v[i].y + v[i].z + v[i].w;
  }
  float mean = wave_sum(s) * (1.f / 1024.f);
  float q = 0.f;
#pragma unroll
  for (int i = 0; i < 4; ++i) {
    float a = v[i].x - mean, bb = v[i].y - mean, c = v[i].z - mean, d = v[i].w - mean;
    q += a * a + bb * bb + c * c + d * d;
  }
  float rstd = rsqrtf(wave_sum(q) * (1.f / 1024.f) + LN_EPS);
#pragma unroll
  for (int i = 0; i < 4; ++i) {
    float4 gg = *(const float4*)(g + i * 256 + lane * 4);
    float4 bb = *(const float4*)(b + i * 256 + lane * 4);
    float4 o;
    o.x = (v[i].x - mean) * rstd * gg.x + bb.x;
    o.y = (v[i].y - mean) * rstd * gg.y + bb.y;
    o.z = (v[i].z - mean) * rstd * gg.z + bb.z;
    o.w = (v[i].w - mean) * rstd * gg.w + bb.w;
    *(float4*)(dst + i * 256 + lane * 4) = o;
  }
}

DI void ph_ln1(const Params& P, int u, char* smem) {
  const int lane = threadIdx.x & 63, wave = threadIdx.x >> 6;
  const int m = u * 4 + wave;
  float* row = P.out + (size_t)m * DM;
  ln_row(row, row, P.ln1_g, P.ln1_b, lane);
}

DI void ph_gemm_up(const Params& P, int u, char* smem) {
  const int mt = u / 44, nt = u - mt * 44;
  const int m0 = mt * 128, n0 = nt * 128;
  const float* A = P.out + (size_t)m0 * DM;
  bfu* gu = (bfu*)(P.ws + OFF_GU);
  gemm_tile<true>(A, DM, (const bfu*)(P.ws + WT_UP) + (size_t)n0 * 1024, 1024, m0, n0, (bfu*)smem,
                  [&](int m, int n, f32x4 v) { store_bf4(gu + (size_t)m * 5632 + n, v); });
}

DI void ph_ffnconv(const Params& P, int u, char* smem) {
  const int tid = threadIdx.x;
  const int m0 = u * 8;
  const int s = seq_of_row(m0), t0 = t_of_row(m0);
  const int T = T_of_seq(s);
  bfu* gu = (bfu*)(P.ws + OFF_GU);
  float* ostate = P.out + (s < 8 ? O_PF_CONV + (size_t)s * 2 * DFF : O_SF_CONV + (size_t)(s - 8) * 2 * DFF);
  const bool last = (t0 + 8 == T);
  for (int cp = tid; cp < DFF / 2; cp += 256) {
    const int c = cp * 2;
    float w[3][2];
#pragma unroll
    for (int j = 0; j < 3; ++j) {
      float2 ww = *(const float2*)(P.f_conv_w + j * DFF + c);
      w[j][0] = ww.x;
      w[j][1] = ww.y;
    }
    float2 fb = *(const float2*)(P.f_conv_b + c);
    float g[10][2];
#pragma unroll
    for (int i = 0; i < 10; ++i) {
      int tt = t0 + i - 2;
      if (tt >= 0) {
        unsigned q = *(const unsigned*)(gu + (size_t)(m0 + i - 2) * 5632 + c);
        g[i][0] = lo_bf(q);
        g[i][1] = hi_bf(q);
      } else if (s >= 8) {
        float2 q = *(const float2*)(P.st_fconv + ((size_t)(s - 8) * 2 + i) * DFF + c);
        g[i][0] = q.x;
        g[i][1] = q.y;
      } else {
        g[i][0] = 0.f;
        g[i][1] = 0.f;
      }
    }
#pragma unroll
    for (int i = 0; i < 8; ++i) {
      unsigned uq = *(const unsigned*)(gu + (size_t)(m0 + i) * 5632 + DFF + c);
      float a0 = w[0][0] * g[i][0] + w[1][0] * g[i + 1][0] + w[2][0] * g[i + 2][0] + fb.x;
      float a1 = w[0][1] * g[i][1] + w[1][1] * g[i + 1][1] + w[2][1] * g[i + 2][1] + fb.y;
      float h0 = siluf_(a0) * lo_bf(uq), h1 = siluf_(a1) * hi_bf(uq);
      *(unsigned*)(gu + (size_t)(m0 + i) * 5632 + DFF + c) = pack2(h0, h1);
    }
    if (last) {
      *(float2*)(ostate + c) = float2{g[8][0], g[8][1]};
      *(float2*)(ostate + DFF + c) = float2{g[9][0], g[9][1]};
    }
  }
}

DI void ph_gemm_down(const Params& P, int u, char* smem) {
  const int mt = u >> 3, nt = u & 7;
  const int m0 = mt * 128, n0 = nt * 128;
  const bfu* A = (const bfu*)(P.ws + OFF_GU) + (size_t)m0 * 5632 + DFF;
  float* y = P.out;
  gemm_tile<false>(A, 5632, (const bfu*)(P.ws + WT_DOWN) + (size_t)n0 * DFF, DFF, m0, n0, (bfu*)smem,
                   [&](int m, int n, f32x4 v) {
                     f32x4 xv = *(const f32x4*)(y + (size_t)m * DM + n);
                     f32x4 r;
#pragma unroll
                     for (int j = 0; j < 4; ++j) r[j] = DN_ALPHA * xv[j] + v[j];
                     *(f32x4*)(y + (size_t)m * DM + n) = r;
                   });
}

DI void ph_ln2_ple(const Params& P, int u, char* smem) {
  if (u < M_TOK / 4) {
    const int lane = threadIdx.x & 63, wave = threadIdx.x >> 6;
    const int m = u * 4 + wave;
    ln_row(P.out + (size_t)m * DM, (float*)(P.ws + OFF_X2) + (size_t)m * DM, P.ln2_g, P.ln2_b, lane);
  } else {
    const int r = u - M_TOK / 4;
    const int mt = r >> 3, nt = r & 7;
    const int m0 = mt * 128, n0 = nt * 128;
    const float* A = (m0 < M_P) ? P.p_p + (size_t)m0 * PLE : P.p_s + (size_t)(m0 - M_P) * PLE;
    float* ep = (float*)(P.ws + OFF_EPRE);
    gemm_tile<true>(A, PLE, (const bfu*)(P.ws + WT_PLE) + (size_t)n0 * PLE, PLE, m0, n0, (bfu*)smem,
                    [&](int m, int n, f32x4 v) { *(f32x4*)(ep + (size_t)m * DM + n) = v; });
  }
}

DI void ph_rinv(const Params& P, int u, char* smem) {
  const int lane = threadIdx.x & 63, wave = threadIdx.x >> 6;
  const int m = u * 4 + wave;
  const float* ep = (const float*)(P.ws + OFF_EPRE) + (size_t)m * DM;
  float q = 0.f;
#pragma unroll
  for (int i = 0; i < 4; ++i) {
    float4 v = *(const float4*)(ep + i * 256 + lane * 4);
    q += v.x * v.x + v.y * v.y + v.z * v.z + v.w * v.w;
  }
  q = wave_sum(q);
  if (lane == 0) ((float*)(P.ws + OFF_RINV))[m] = rsqrtf(q * (1.f / 1024.f) + RMS_EPS);
}

DI void ph_gemm_fin(const Params& P, int u, char* smem) {
  const int mt = u >> 3, nt = u & 7;
  const int m0 = mt * 128, n0 = nt * 128;
  const float* x2 = (const float*)(P.ws + OFF_X2);
  const float* ep = (const float*)(P.ws + OFF_EPRE);
  const float* rinv = (const float*)(P.ws + OFF_RINV);
  const float* pg = P.ple_g;
  float* y = P.out;
  gemm_tile<true>(x2 + (size_t)m0 * DM, DM, (const bfu*)(P.ws + WT_GATE) + (size_t)n0 * 1024, 1024, m0, n0,
                  (bfu*)smem, [&](int m, int n, f32x4 v) {
                    f32x4 xv = *(const f32x4*)(x2 + (size_t)m * DM + n);
                    f32x4 ev = *(const f32x4*)(ep + (size_t)m * DM + n);
                    f32x4 gv = *(const f32x4*)(pg + n);
                    float ri = rinv[m];
                    f32x4 r;
#pragma unroll
                    for (int j = 0; j < 4; ++j) r[j] = xv[j] + sigmoidf_(v[j]) * (ev[j] * ri * gv[j]);
                    *(f32x4*)(y + (size_t)m * DM + n) = r;
                  });
}

template <int PH>
DI void run_unit(const Params& P, int u, char* smem) {
  if (PH == PH_WT) ph_wt(P, u, smem);
  else if (PH == PH_GEMM_IN) ph_gemm_in(P, u, smem);
  else if (PH == PH_LORAIN) ph_lorain(P, u, smem);
  else if (PH == PH_LORA) ph_lora(P, u, smem);
  else if (PH == PH_PREPA) ph_prepa(P, u, smem);
  else if (PH == PH_PREPB) ph_prepb(P, u, smem);
  else if (PH == PH_SCAN) ph_scan(P, u, smem);
  else if (PH == PH_POST) ph_post(P, u, smem);
  else if (PH == PH_GEMM_O) ph_gemm_o(P, u, smem);
  else if (PH == PH_LN1) ph_ln1(P, u, smem);
  else if (PH == PH_GEMM_UP) ph_gemm_up(P, u, smem);
  else if (PH == PH_FFNCONV) ph_ffnconv(P, u, smem);
  else if (PH == PH_GEMM_DOWN) ph_gemm_down(P, u, smem);
  else if (PH == PH_LN2_PLE) ph_ln2_ple(P, u, smem);
  else if (PH == PH_RINV) ph_rinv(P, u, smem);
  else if (PH == PH_GEMM_FIN) ph_gemm_fin(P, u, smem);
}

template <int PH>
DI void run_phase(const Params& P, char* smem) {
  const int n = units_of(PH, P.wd_tiles);
  for (int u = blockIdx.x; u < n; u += gridDim.x) run_unit<PH>(P, u, smem);
}

#if MULTI_LAUNCH
template <int PH>
__global__ void __launch_bounds__(256) k_phase(Params P) {
  __shared__ __attribute__((aligned(16))) char smem[SMEM_BYTES];
  run_phase<PH>(P, smem);
}
#else
__global__ void __launch_bounds__(256) k_mega(Params P) {
  __shared__ __attribute__((aligned(16))) char smem[SMEM_BYTES];
  cg::grid_group grid = cg::this_grid();
  run_phase<PH_WT>(P, smem); grid.sync();
  run_phase<PH_GEMM_IN>(P, smem); grid.sync();
  run_phase<PH_LORAIN>(P, smem); grid.sync();
  run_phase<PH_LORA>(P, smem); grid.sync();
  run_phase<PH_PREPA>(P, smem); grid.sync();
  run_phase<PH_PREPB>(P, smem); grid.sync();
  run_phase<PH_SCAN>(P, smem); grid.sync();
  run_phase<PH_POST>(P, smem); grid.sync();
  run_phase<PH_GEMM_O>(P, smem); grid.sync();
  run_phase<PH_LN1>(P, smem); grid.sync();
  run_phase<PH_GEMM_UP>(P, smem); grid.sync();
  run_phase<PH_FFNCONV>(P, smem); grid.sync();
  run_phase<PH_GEMM_DOWN>(P, smem); grid.sync();
  run_phase<PH_LN2_PLE>(P, smem); grid.sync();
  run_phase<PH_RINV>(P, smem); grid.sync();
  run_phase<PH_GEMM_FIN>(P, smem);
}
#endif

#if MULTI_LAUNCH
template <int PH>
static void launch_phase(const Params& P, hipStream_t stream) {
  int n = units_of(PH, P.wd_tiles);
  int grid = (PH == PH_SCAN) ? 512 : (n < 4096 ? n : 4096);
  hipLaunchKernelGGL(k_phase<PH>, dim3(grid), dim3(256), 0, stream, P);
}
#endif

extern "C" void kernel_launch(void* const* d_in, const int* in_sizes, int n_in, void* d_out, int out_size,
                              void* d_ws, size_t ws_size, hipStream_t stream) {
  Params P;
  memset(&P, 0, sizeof(P));
  const float** f = (const float**)&P;
  for (int i = 0; i < 37; ++i) f[i] = (const float*)d_in[i];
  P.out = (float*)d_out;
  P.ws = (char*)d_ws;
  char* ws = (char*)d_ws;
  struct { const float* src; size_t off; int K, N, Npad; } wl[9] = {
      {P.w_in, WT_IN, 1024, INW, INW_PAD},   {P.a_w_w2, WT_W2, 64, 512, 512},   {P.a_w_a2, WT_A2, 64, 512, 512},
      {P.a_w_g2, WT_G2, 128, 512, 512},      {P.w_o, WT_O, 1024, 1024, 1024},   {P.w_up, WT_UP, 1024, 5632, 5632},
      {P.w_down, WT_DOWN, 2816, 1024, 1024}, {P.w_ple, WT_PLE, 256, 1024, 1024}, {P.w_ple_gate, WT_GATE, 1024, 1024, 1024}};
  int t0 = 0;
  for (int i = 0; i < 9; ++i) {
    P.wd[i].src = wl[i].src;
    P.wd[i].dst = (bfu*)(ws + wl[i].off);
    P.wd[i].K = wl[i].K;
    P.wd[i].N = wl[i].N;
    P.wd[i].Npad = wl[i].Npad;
    P.wd[i].t0 = t0;
    t0 += (wl[i].Npad / 64) * (wl[i].K / 64);
  }
  P.wd_tiles = t0;
#if MULTI_LAUNCH
  launch_phase<PH_WT>(P, stream);
  launch_phase<PH_GEMM_IN>(P, stream);
  launch_phase<PH_LORAIN>(P, stream);
  launch_phase<PH_LORA>(P, stream);
  launch_phase<PH_PREPA>(P, stream);
  launch_phase<PH_PREPB>(P, stream);
  launch_phase<PH_SCAN>(P, stream);
  launch_phase<PH_POST>(P, stream);
  launch_phase<PH_GEMM_O>(P, stream);
  launch_phase<PH_LN1>(P, stream);
  launch_phase<PH_GEMM_UP>(P, stream);
  launch_phase<PH_FFNCONV>(P, stream);
  launch_phase<PH_GEMM_DOWN>(P, stream);
  launch_phase<PH_LN2_PLE>(P, stream);
  launch_phase<PH_RINV>(P, stream);
  launch_phase<PH_GEMM_FIN>(P, stream);
#else
  static int grid_blocks = 0;
  if (!grid_blocks) {
    int dev = 0, cus = 0, per_cu = 0;
    hipGetDevice(&dev);
    hipDeviceGetAttribute(&cus, hipDeviceAttributeMultiprocessorCount, dev);
    hipOccupancyMaxActiveBlocksPerMultiprocessor(&per_cu, k_mega, 256, 0);
    if (per_cu > 2) per_cu = 2;
    grid_blocks = cus * per_cu;
  }
  void* args[] = {&P};
  hipError_t e = hipLaunchCooperativeKernel((void*)k_mega, dim3(grid_blocks), dim3(256), args, 0, stream);
  if (e != hipSuccess) fprintf(stderr, "cooperative launch failed: %s (grid %d)\n", hipGetErrorString(e), grid_blocks);
#endif
}
```

```cpp
#include <hip/hip_runtime.h>
#include <hip/hip_bf16.h>
#include <hip/hip_cooperative_groups.h>
#include <cstdio>
#include <cstring>
namespace cg = cooperative_groups;

#ifndef MULTI_LAUNCH
#define MULTI_LAUNCH 0
#endif

#define DI __device__ __forceinline__
typedef unsigned short bfu;
using bf16x8 = __attribute__((ext_vector_type(8))) short;
using f32x4 = __attribute__((ext_vector_type(4))) float;
using u32x4 = __attribute__((ext_vector_type(4))) unsigned;

constexpr int M_TOK = 17408, M_P = 16384, NSEQ = 136;
constexpr int DM = 1024, AW = 512, ASW = 1792, BQKV = 1536, PB_W = 2048, INW = 3848, INW_PAD = 3968;
constexpr int DFF = 2816, PLE = 256;
constexpr float DN_ALPHA = 1.189207115002721f;
constexpr float LN_EPS = 1e-5f, GN_EPS = 64e-5f, RMS_EPS = 1e-6f, L2_EPS = 1e-12f;

constexpr size_t O_Y = 0;
constexpr size_t O_PA_WKV = (size_t)M_TOK * 1024;
constexpr size_t O_PA_SHIFT = O_PA_WKV + 8 * 8 * 64 * 64;
constexpr size_t O_PB_SSM = O_PA_SHIFT + 8 * 1792;
constexpr size_t O_PB_CONV = O_PB_SSM + 8 * 4 * 128 * 128;
constexpr size_t O_PF_CONV = O_PB_CONV + 8 * 3 * 1536;
constexpr size_t O_SA_WKV = O_PF_CONV + 8 * 2 * 2816;
constexpr size_t O_SA_SHIFT = O_SA_WKV + (size_t)128 * 8 * 64 * 64;
constexpr size_t O_SB_SSM = O_SA_SHIFT + 128 * 1792;
constexpr size_t O_SB_CONV = O_SB_SSM + (size_t)128 * 4 * 128 * 128;
constexpr size_t O_SF_CONV = O_SB_CONV + 128 * 3 * 1536;

constexpr size_t WT_IN = 0;
constexpr size_t WT_W2 = WT_IN + (size_t)INW_PAD * 1024 * 2;
constexpr size_t WT_A2 = WT_W2 + 512 * 64 * 2;
constexpr size_t WT_G2 = WT_A2 + 512 * 64 * 2;
constexpr size_t WT_O = WT_G2 + 512 * 128 * 2;
constexpr size_t WT_UP = WT_O + 1024 * 1024 * 2;
constexpr size_t WT_DOWN = WT_UP + (size_t)5632 * 1024 * 2;
constexpr size_t WT_PLE = WT_DOWN + (size_t)1024 * 2816 * 2;
constexpr size_t WT_GATE = WT_PLE + 1024 * 256 * 2;
constexpr size_t OFF_STREAM = WT_GATE + 1024 * 1024 * 2;
constexpr size_t OFF_G = OFF_STREAM + (size_t)M_TOK * 8 * 384 * 2;
constexpr size_t OFF_PROJA = OFF_G + (size_t)M_TOK * 512 * 2;
constexpr size_t OFF_LORAIN = OFF_PROJA + (size_t)M_TOK * 1792 * 2;
constexpr size_t OFF_ABUF = OFF_LORAIN + (size_t)M_TOK * 256 * 2;
constexpr size_t OFF_BA = OFF_ABUF + (size_t)M_TOK * 512 * 2;
constexpr size_t OFF_BG = OFF_BA + (size_t)M_TOK * 8 * 4;
constexpr size_t OFF_BONUS = OFF_BG + (size_t)M_TOK * 8 * 4;
constexpr size_t OFF_RINV = OFF_BONUS + (size_t)M_TOK * 8 * 4;
constexpr size_t OFF_END = OFF_RINV + (size_t)M_TOK * 4;
constexpr size_t OFF_STREAMB = OFF_PROJA;
constexpr size_t OFF_OMIX = OFF_STREAMB + (size_t)M_TOK * 4 * 384 * 2;
constexpr size_t OFF_GU = OFF_STREAM;
constexpr size_t OFF_X2 = OFF_STREAM;
constexpr size_t OFF_EPRE = OFF_X2 + (size_t)M_TOK * 1024 * 4;
static_assert(OFF_OMIX + (size_t)M_TOK * 1024 * 2 <= OFF_BA, "omix overlap");
static_assert(OFF_GU + (size_t)M_TOK * 5632 * 2 <= OFF_BA, "gu overlap");
static_assert(OFF_END <= 256ull * 1024 * 1024, "ws too small");

struct WD { const float* src; bfu* dst; int K, N, Npad, t0; };

struct Params {
  const float *x_p, *x_s, *p_p, *p_s, *st_wkv, *st_shift, *st_ssm, *st_bconv, *st_fconv;
  const float *w_in, *a_mu, *a_w0, *a_w_w2, *a_a0, *a_w_a2, *a_w_g2, *a_k_k, *a_k_a, *a_r_k, *a_gn_g, *a_gn_b;
  const float *b_conv_w, *b_a_log, *b_dt_bias, *b_norm_g, *w_o, *ln1_g, *ln1_b, *w_up, *f_conv_w, *f_conv_b,
      *w_down, *ln2_g, *ln2_b, *w_ple, *ple_g, *w_ple_gate;
  float* out;
  char* ws;
  WD wd[9];
  int wd_tiles;
  int pad_;
};

DI bfu f2bf(float f) {
  unsigned u = __float_as_uint(f);
  u += 0x7fffu + ((u >> 16) & 1u);
  return (bfu)(u >> 16);
}
DI float bf2f(bfu h) { return __uint_as_float(((unsigned)h) << 16); }
DI unsigned pack2(float a, float b) { return (unsigned)f2bf(a) | ((unsigned)f2bf(b) << 16); }
DI float lo_bf(unsigned u) { return __uint_as_float(u << 16); }
DI float hi_bf(unsigned u) { return __uint_as_float(u & 0xffff0000u); }
DI float sigmoidf_(float x) { return 1.f / (1.f + __expf(-x)); }
DI float siluf_(float x) { return x / (1.f + __expf(-x)); }
DI float softplusf_(float x) { return fmaxf(x, 0.f) + log1pf(__expf(-fabsf(x))); }
DI float wave_sum(float v) {
#pragma unroll
  for (int o = 32; o > 0; o >>= 1) v += __shfl_xor(v, o, 64);
  return v;
}
DI float row16_sum(float x) {
  x += __int_as_float(__builtin_amdgcn_update_dpp(0, __float_as_int(x), 0x128, 0xf, 0xf, false));
  x += __int_as_float(__builtin_amdgcn_update_dpp(0, __float_as_int(x), 0x124, 0xf, 0xf, false));
  x += __int_as_float(__builtin_amdgcn_update_dpp(0, __float_as_int(x), 0x122, 0xf, 0xf, false));
  x += __int_as_float(__builtin_amdgcn_update_dpp(0, __float_as_int(x), 0x121, 0xf, 0xf, false));
  return x;
}
DI int seq_of_row(int m) { return m < M_P ? (m >> 11) : 8 + ((m - M_P) >> 3); }
DI int t_of_row(int m) { return m < M_P ? (m & 2047) : (m & 7); }
DI int row0_of_seq(int s) { return s < 8 ? s * 2048 : M_P + (s - 8) * 8; }
DI int T_of_seq(int s) { return s < 8 ? 2048 : 8; }

constexpr int SMEM_BYTES = 65536;

constexpr int LDT = 72;
constexpr int TILE_ELEMS = 128 * LDT;
constexpr int GBK = 64;

template <bool AF32>
DI void g_load(const void* __restrict__ Ap, int lda, const bfu* __restrict__ Bp, int K, int kt, int lrow, int lkc,
               u32x4 (&ra)[4], u32x4 (&rb)[4], f32x4 (&fa)[4][2]) {
#pragma unroll
  for (int j = 0; j < 4; ++j) {
    const int row = lrow + 32 * j;
    if constexpr (AF32) {
      const float* ap = (const float*)Ap + (size_t)row * lda + kt * GBK + lkc;
      fa[j][0] = *(const f32x4*)ap;
      fa[j][1] = *(const f32x4*)(ap + 4);
    } else {
      const bfu* ap = (const bfu*)Ap + (size_t)row * lda + kt * GBK + lkc;
      ra[j] = *(const u32x4*)ap;
    }
    rb[j] = *(const u32x4*)(Bp + (size_t)row * K + kt * GBK + lkc);
  }
}
template <bool AF32>
DI void l_store(bfu* As, bfu* Bs, int lrow, int lkc, const u32x4 (&ra)[4], const u32x4 (&rb)[4],
                const f32x4 (&fa)[4][2]) {
#pragma unroll
  for (int j = 0; j < 4; ++j) {
    const int row = lrow + 32 * j;
    u32x4 va;
    if constexpr (AF32) {
      va.x = pack2(fa[j][0].x, fa[j][0].y);
      va.y = pack2(fa[j][0].z, fa[j][0].w);
      va.z = pack2(fa[j][1].x, fa[j][1].y);
      va.w = pack2(fa[j][1].z, fa[j][1].w);
    } else {
      va = ra[j];
    }
    *(u32x4*)(As + row * LDT + lkc) = va;
    *(u32x4*)(Bs + row * LDT + lkc) = rb[j];
  }
}

template <bool AF32, class Epi>
DI void gemm_tile(const void* __restrict__ Ap, int lda, const bfu* __restrict__ Bp, int K, int m0, int n0,
                  bfu* smem, Epi epi) {
  const int tid = threadIdx.x, lane = tid & 63, wave = tid >> 6;
  const int wm = wave >> 1, wn = wave & 1;
  bfu* As = smem;
  bfu* Bs = smem + TILE_ELEMS;
  f32x4 acc[4][4];
#pragma unroll
  for (int i = 0; i < 4; ++i)
#pragma unroll
    for (int j = 0; j < 4; ++j) acc[i][j] = f32x4{0.f, 0.f, 0.f, 0.f};
  const int lrow = tid >> 3, lkc = (tid & 7) * 8;
  u32x4 ra[4], rb[4];
  f32x4 fa[4][2];
  const int nk = K / GBK;

  g_load<AF32>(Ap, lda, Bp, K, 0, lrow, lkc, ra, rb, fa);
  for (int kt = 0; kt < nk; ++kt) {
    __syncthreads();
    l_store<AF32>(As, Bs, lrow, lkc, ra, rb, fa);
    __syncthreads();
    if (kt + 1 < nk) g_load<AF32>(Ap, lda, Bp, K, kt + 1, lrow, lkc, ra, rb, fa);
#pragma unroll
    for (int ks = 0; ks < 2; ++ks) {
      bf16x8 af[4], bfr[4];
#pragma unroll
      for (int mi = 0; mi < 4; ++mi)
        af[mi] = *(const bf16x8*)(As + (wm * 64 + mi * 16 + (lane & 15)) * LDT + ks * 32 + (lane >> 4) * 8);
#pragma unroll
      for (int ni = 0; ni < 4; ++ni)
        bfr[ni] = *(const bf16x8*)(Bs + (wn * 64 + ni * 16 + (lane & 15)) * LDT + ks * 32 + (lane >> 4) * 8);
#pragma unroll
      for (int mi = 0; mi < 4; ++mi)
#pragma unroll
        for (int ni = 0; ni < 4; ++ni)
          acc[mi][ni] = __builtin_amdgcn_mfma_f32_16x16x32_bf16(bfr[ni], af[mi], acc[mi][ni], 0, 0, 0);
    }
  }
#pragma unroll
  for (int mi = 0; mi < 4; ++mi)
#pragma unroll
    for (int ni = 0; ni < 4; ++ni) {
      int m = m0 + wm * 64 + mi * 16 + (lane & 15);
      int n = n0 + wn * 64 + ni * 16 + (lane >> 4) * 4;
      epi(m, n, acc[mi][ni]);
    }
  __syncthreads();
}

DI void store_bf4(bfu* p, f32x4 v) {
  uint2 u;
  u.x = pack2(v[0], v[1]);
  u.y = pack2(v[2], v[3]);
  *(uint2*)p = u;
}

enum {
  PH_WT = 0,
  PH_GEMM_IN,
  PH_LORAIN,
  PH_LORA,
  PH_PREPA,
  PH_PREPB,
  PH_SCAN,
  PH_POST,
  PH_GEMM_O,
  PH_LN1,
  PH_GEMM_UP,
  PH_FFNCONV,
  PH_GEMM_DOWN,
  PH_LN2_PLE,
  PH_RINV,
  PH_GEMM_FIN,
  PH_COUNT
};

constexpr int MT = M_TOK / 128;

__host__ __device__ constexpr int units_of(int ph, int wd_tiles) {
  return ph == PH_WT ? wd_tiles
       : ph == PH_GEMM_IN ? MT * 31
       : ph == PH_LORAIN ? (M_TOK / 16 + NSEQ)
       : ph == PH_LORA ? MT * 4 * 3
       : ph == PH_PREPA ? M_TOK * 8 / 4
       : ph == PH_PREPB ? M_TOK / 8
       : ph == PH_SCAN ? 2 * NSEQ * 32
       : ph == PH_POST ? M_TOK * 3
       : ph == PH_GEMM_O ? MT * 8
       : ph == PH_LN1 ? M_TOK / 4
       : ph == PH_GEMM_UP ? MT * 44
       : ph == PH_FFNCONV ? M_TOK / 8
       : ph == PH_GEMM_DOWN ? MT * 8
       : ph == PH_LN2_PLE ? (M_TOK / 4 + MT * 8)
       : ph == PH_RINV ? M_TOK / 4
       : ph == PH_GEMM_FIN ? MT * 8
       : 0;
}

DI void ph_wt(const Params& P, int u, char* smem) {
  int wi = 0;
#pragma unroll
  for (int i = 1; i < 9; ++i)
    if (u >= P.wd[i].t0) wi = i;
  const float* src = P.wd[wi].src;
  bfu* dst = P.wd[wi].dst;
  const int K = P.wd[wi].K, N = P.wd[wi].N;
  int tl = u - P.wd[wi].t0;
  const int kts = K >> 6;
  const int nt = tl / kts, kt = tl - nt * kts;
  const int n0 = nt * 64, k0 = kt * 64;
  float* tile = (float*)smem;
  const int r = threadIdx.x >> 6, c = threadIdx.x & 63;
#pragma unroll
  for (int i = 0; i < 16; ++i) {
    int kr = i * 4 + r;
    float v = (n0 + c < N) ? src[(size_t)(k0 + kr) * N + n0 + c] : 0.f;
    tile[kr * 65 + c] = v;
  }
  __syncthreads();
#pragma unroll
  for (int i = 0; i < 16; ++i) {
    int nr = i * 4 + r;
    dst[(size_t)(n0 + nr) * K + k0 + c] = f2bf(tile[c * 65 + nr]);
  }
  __syncthreads();
}

DI void ph_gemm_in(const Params& P, int u, char* smem) {
  const int mt = u / 31, nt = u - mt * 31;
  const int m0 = mt * 128, n0 = nt * 128;
  const float* A = (m0 < M_P) ? P.x_p + (size_t)m0 * DM : P.x_s + (size_t)(m0 - M_P) * DM;
  bfu* projA = (bfu*)(P.ws + OFF_PROJA);
  bfu* projB = (bfu*)P.out;
  float* ba = (float*)(P.ws + OFF_BA);
  gemm_tile<true>(A, DM, (const bfu*)(P.ws + WT_IN) + (size_t)n0 * DM, DM, m0, n0, (bfu*)smem,
                  [&](int m, int n, f32x4 v) {
                    if (n < ASW) store_bf4(projA + (size_t)m * ASW + n, v);
                    else if (n < 3840) store_bf4(projB + (size_t)m * PB_W + (n - ASW), v);
                    else if (n < INW) *(f32x4*)(ba + (size_t)m * 8 + (n - 3840)) = v;
                  });
}

DI void ph_lorain(const Params& P, int u, char* smem) {
  const bfu* projA = (const bfu*)(P.ws + OFF_PROJA);
  const int tid = threadIdx.x;
  if (u < M_TOK / 16) {
    bfu* lin = (bfu*)(P.ws + OFF_LORAIN);
    const int col = 1536 + tid;
    const float mu = P.a_mu[col];
    const int m0 = u * 16;
    float uprev = 0.f;
    {
      int t = t_of_row(m0);
      if (t != 0) uprev = bf2f(projA[(size_t)(m0 - 1) * ASW + col]);
    }
    for (int i = 0; i < 16; ++i) {
      int m = m0 + i;
      int t = t_of_row(m);
      float uc = bf2f(projA[(size_t)m * ASW + col]);
      float prev = uprev;
      if (t == 0) {
        int s = seq_of_row(m);
        prev = (s < 8) ? 0.f : P.st_shift[(size_t)(s - 8) * ASW + col];
      }
      float xs = uc + (prev - uc) * mu;
      float o = (tid < 64) ? tanhf(xs) : (tid < 128 ? xs : sigmoidf_(xs));
      lin[(size_t)m * 256 + tid] = f2bf(o);
      uprev = uc;
    }
  } else {
    const int s = u - M_TOK / 16;
    const int row0 = row0_of_seq(s), T = T_of_seq(s);
    const bfu* projB = (const bfu*)P.out;
    float* oshift = P.out + (s < 8 ? O_PA_SHIFT + (size_t)s * ASW : O_SA_SHIFT + (size_t)(s - 8) * ASW);
    for (int i = tid; i < ASW; i += 256) oshift[i] = bf2f(projA[(size_t)(row0 + T - 1) * ASW + i]);
    float* oconv = P.out + (s < 8 ? O_PB_CONV + (size_t)s * 3 * BQKV : O_SB_CONV + (size_t)(s - 8) * 3 * BQKV);
    for (int i = tid; i < 3 * BQKV; i += 256) {
      int j = i / BQKV, c = i - j * BQKV;
      oconv[i] = bf2f(projB[(size_t)(row0 + T - 3 + j) * PB_W + c]);
    }
  }
}

DI void ph_lora(const Params& P, int u, char* smem) {
  const int which = u / (MT * 4);
  const int r = u - which * (MT * 4);
  const int mt = r >> 2, nt = r & 3;
  const int m0 = mt * 128, n0 = nt * 128;
  const bfu* lin = (const bfu*)(P.ws + OFF_LORAIN);
  if (which == 0) {
    bfu* stream = (bfu*)(P.ws + OFF_STREAM);
    const float* w0 = P.a_w0;
    gemm_tile<false>(lin + (size_t)m0 * 256, 256, (const bfu*)(P.ws + WT_W2) + (size_t)n0 * 64, 64, m0, n0,
                     (bfu*)smem, [&](int m, int n, f32x4 v) {
                       f32x4 e;
#pragma unroll
                       for (int j = 0; j < 4; ++j) {
                         float w = -softplusf_(-(w0[n + j] + v[j])) - 0.5f;
                         e[j] = __expf(w);
                       }
                       store_bf4(stream + ((size_t)(m * 8 + (n >> 6)) * 6 + 1) * 64 + (n & 63), e);
                     });
  } else if (which == 1) {
    bfu* abuf = (bfu*)(P.ws + OFF_ABUF);
    const float* a0 = P.a_a0;
    gemm_tile<false>(lin + (size_t)m0 * 256 + 64, 256, (const bfu*)(P.ws + WT_A2) + (size_t)n0 * 64, 64, m0, n0,
                     (bfu*)smem, [&](int m, int n, f32x4 v) {
                       f32x4 e;
#pragma unroll
                       for (int j = 0; j < 4; ++j) e[j] = sigmoidf_(a0[n + j] + v[j]);
                       store_bf4(abuf + (size_t)m * 512 + n, e);
                     });
  } else {
    bfu* gbuf = (bfu*)(P.ws + OFF_G);
    gemm_tile<false>(lin + (size_t)m0 * 256 + 128, 256, (const bfu*)(P.ws + WT_G2) + (size_t)n0 * 128, 128, m0, n0,
                     (bfu*)smem, [&](int m, int n, f32x4 v) { store_bf4(gbuf + (size_t)m * 512 + n, v); });
  }
}

DI void ph_prepa(const Params& P, int u, char* smem) {
  const int tid = threadIdx.x, lane = tid & 63, wave = tid >> 6;
  const int wt = u * 4 + wave;
  const int m = wt >> 3, h = wt & 7;
  const int c = h * 64 + lane;
  const bfu* projA = (const bfu*)(P.ws + OFF_PROJA);
  const bfu* abuf = (const bfu*)(P.ws + OFF_ABUF);
  bfu* stream = (bfu*)(P.ws + OFF_STREAM);
  const int t = t_of_row(m), s = seq_of_row(m);
  float xs[3];
#pragma unroll
  for (int j = 0; j < 3; ++j) {
    int col = j * 512 + c;
    float uc = bf2f(projA[(size_t)m * ASW + col]);
    float prev;
    if (t == 0) prev = (s < 8) ? 0.f : P.st_shift[(size_t)(s - 8) * ASW + col];
    else prev = bf2f(projA[(size_t)(m - 1) * ASW + col]);
    xs[j] = uc + (prev - uc) * P.a_mu[col];
  }
  const float r = xs[0], k = xs[1], v = xs[2];
  const float a = bf2f(abuf[(size_t)m * 512 + c]);
  float kkr = k * P.a_k_k[c];
  float ss = wave_sum(kkr * kkr);
  float kk = kkr * rsqrtf(ss + L2_EPS);
  float k2 = k * (1.f + (a - 1.f) * P.a_k_a[c]);
  float b = kk * a;
  float bonus = wave_sum(r * k2 * P.a_r_k[c]);
  bfu* sp = stream + (size_t)(m * 8 + h) * 384 + lane;
  sp[0] = f2bf(r);
  sp[128] = f2bf(k2);
  sp[192] = f2bf(v);
  sp[256] = f2bf(kk);
  sp[320] = f2bf(b);
  if (lane == 0) ((float*)(P.ws + OFF_BONUS))[m * 8 + h] = bonus;
}

DI void ph_prepb(const Params& P, int u, char* smem) {
  const int tid = threadIdx.x, lane = tid & 63, h = tid >> 6;
  const int m0 = u * 8;
  const int s = seq_of_row(m0), t0 = t_of_row(m0);
  const bfu* projB = (const bfu*)P.out;
  bfu* sb = (bfu*)(P.ws + OFF_STREAMB);
  float raw[11][3][2];
  float cw[4][3][2];
#pragma unroll
  for (int p = 0; p < 3; ++p) {
    int c = p * 512 + tid * 2;
#pragma unroll
    for (int j = 0; j < 4; ++j) {
      float2 w = *(const float2*)(P.b_conv_w + j * BQKV + c);
      cw[j][p][0] = w.x;
      cw[j][p][1] = w.y;
    }
#pragma unroll
    for (int i = 0; i < 11; ++i) {
      int tt = t0 + i - 3;
      float a0, a1;
      if (tt >= 0) {
        unsigned q = *(const unsigned*)(projB + (size_t)(m0 + i - 3) * PB_W + c);
        a0 = lo_bf(q);
        a1 = hi_bf(q);
      } else if (s >= 8) {
        float2 q = *(const float2*)(P.st_bconv + ((size_t)(s - 8) * 3 + i) * BQKV + c);
        a0 = q.x;
        a1 = q.y;
      } else {
        a0 = 0.f;
        a1 = 0.f;
      }
      raw[i][p][0] = a0;
      raw[i][p][1] = a1;
    }
  }
#pragma unroll
  for (int i = 0; i < 8; ++i) {
    float y[3][2];
#pragma unroll
    for (int p = 0; p < 3; ++p)
#pragma unroll
      for (int e = 0; e < 2; ++e) {
        float acc = 0.f;
#pragma unroll
        for (int j = 0; j < 4; ++j) acc += cw[j][p][e] * raw[i + j][p][e];
        y[p][e] = siluf_(acc);
      }
    float sq = wave_sum(y[0][0] * y[0][0] + y[0][1] * y[0][1]);
    float sk = wave_sum(y[1][0] * y[1][0] + y[1][1] * y[1][1]);
    float rq = rsqrtf(sq + L2_EPS) * 0.08838834764831845f;
    float rk = rsqrtf(sk + L2_EPS);
    bfu* dst = sb + (size_t)((m0 + i) * 4 + h) * 384 + lane * 2;
    *(unsigned*)(dst) = pack2(y[0][0] * rq, y[0][1] * rq);
    *(unsigned*)(dst + 128) = pack2(y[1][0] * rk, y[1][1] * rk);
    *(unsigned*)(dst + 256) = pack2(y[2][0], y[2][1]);
  }
  if (tid < 32) {
    int i = tid >> 2, hh = tid & 3;
    const float* ba = (const float*)(P.ws + OFF_BA) + (size_t)(m0 + i) * 8;
    float beta = sigmoidf_(ba[hh]);
    float g = -__expf(P.b_a_log[hh]) * softplusf_(ba[4 + hh] + P.b_dt_bias[hh]);
    float* bg = (float*)(P.ws + OFF_BG) + (size_t)(m0 + i) * 8;
    bg[hh] = beta;
    bg[4 + hh] = __expf(g);
  }
}

constexpr int CH = 16;

DI void chunk_gload(u32x4 (&rg)[3], const bfu* base, size_t step_stride, int nsteps) {
#pragma unroll
  for (int j = 0; j < 3; ++j) {
    int idx = threadIdx.x + 256 * j;
    int st = idx / 48, w = idx - st * 48;
    if (st < nsteps) rg[j] = *(const u32x4*)(base + (size_t)st * step_stride + w * 8);
  }
}
template <bool DECAY>
DI void chunk_lstore(const u32x4 (&rg)[3], float* buf, int nsteps) {
#pragma unroll
  for (int j = 0; j < 3; ++j) {
    int idx = threadIdx.x + 256 * j;
    int st = idx / 48, w = idx - st * 48;
    if (st < nsteps) {
      float4 a, b;
      a.x = lo_bf(rg[j].x); a.y = hi_bf(rg[j].x); a.z = lo_bf(rg[j].y); a.w = hi_bf(rg[j].y);
      b.x = lo_bf(rg[j].z); b.y = hi_bf(rg[j].z); b.z = lo_bf(rg[j].w); b.w = hi_bf(rg[j].w);
      if (DECAY && (w >> 3) == 1) {
        a.x = __expf(-a.x); a.y = __expf(-a.y); a.z = __expf(-a.z); a.w = __expf(-a.w);
        b.x = __expf(-b.x); b.y = __expf(-b.y); b.z = __expf(-b.z); b.w = __expf(-b.w);
      }
      float* d = buf + st * 384 + w * 8;
      *(float4*)d = a;
      *(float4*)(d + 4) = b;
    }
  }
}

DI void rwkv_unit(const Params& P, int u, char* smem) {
  const int tid = threadIdx.x, lane = tid & 63, wave = tid >> 6;
  const int s = u >> 5, h = (u >> 2) & 7, rgp = u & 3;
  const int T = T_of_seq(s), row0 = row0_of_seq(s);
  const int vl = wave * 4 + (lane >> 4);
  const int v = rgp * 16 + vl;
  const int j0 = (lane & 15) * 4;
  float* buf0 = (float*)smem;
  float* obuf = buf0 + 2 * CH * 384;
  float4 S;
  if (s < 8) S = float4{0.f, 0.f, 0.f, 0.f};
  else S = *(const float4*)(P.st_wkv + (((size_t)(s - 8) * 8 + h) * 64 + v) * 64 + j0);
  const bfu* stream = (const bfu*)(P.ws + OFF_STREAM) + ((size_t)row0 * 8 + h) * 384;
  const size_t sstride = 8 * 384;
  bfu* omix = (bfu*)(P.ws + OFF_OMIX);
  const int nch = (T + CH - 1) / CH;
  u32x4 rg[3];
  chunk_gload(rg, stream, sstride, min(CH, T));
  chunk_lstore<true>(rg, buf0, min(CH, T));
  __syncthreads();
  for (int c = 0; c < nch; ++c) {
    const int nsteps = min(CH, T - c * CH);
    const int nnext = (c + 1 < nch) ? min(CH, T - (c + 1) * CH) : 0;
    if (nnext > 0) chunk_gload(rg, stream + (size_t)(c + 1) * CH * sstride, sstride, nnext);
    const float* buf = buf0 + (c & 1) * CH * 384;
    for (int st = 0; st < nsteps; ++st) {
      const float* b = buf + st * 384;
      float4 r4 = *(const float4*)(b + j0);
      float4 w4 = *(const float4*)(b + 64 + j0);
      float4 k4 = *(const float4*)(b + 128 + j0);
      float vv = b[192 + v];
      float4 kk4 = *(const float4*)(b + 256 + j0);
      float4 b4 = *(const float4*)(b + 320 + j0);
      float p = S.x * kk4.x + S.y * kk4.y + S.z * kk4.z + S.w * kk4.w;
      p = row16_sum(p);
      float sa = -p;
      S.x = S.x * w4.x + (sa * b4.x + vv * k4.x);
      S.y = S.y * w4.y + (sa * b4.y + vv * k4.y);
      S.z = S.z * w4.z + (sa * b4.z + vv * k4.z);
      S.w = S.w * w4.w + (sa * b4.w + vv * k4.w);
      float q = S.x * r4.x + S.y * r4.y + S.z * r4.z + S.w * r4.w;
      q = row16_sum(q);
      if ((lane & 15) == 0) obuf[st * 16 + vl] = q;
    }
    __syncthreads();
    if (tid < nsteps * 16) {
      int st = tid >> 4, r = tid & 15;
      omix[(size_t)(row0 + c * CH + st) * 1024 + h * 64 + rgp * 16 + r] = f2bf(obuf[tid]);
    }
    if (nnext > 0) chunk_lstore<true>(rg, buf0 + ((c + 1) & 1) * CH * 384, nnext);
    __syncthreads();
  }
  float* o = P.out + (s < 8 ? O_PA_WKV + (((size_t)s * 8 + h) * 64 + v) * 64 + j0
                            : O_SA_WKV + (((size_t)(s - 8) * 8 + h) * 64 + v) * 64 + j0);
  *(float4*)o = S;
}

DI void delta_unit(const Params& P, int u, char* smem) {
  const int tid = threadIdx.x, lane = tid & 63, wave = tid >> 6;
  const int s = u >> 5, h = (u >> 3) & 3, cg_ = u & 7;
  const int T = T_of_seq(s), row0 = row0_of_seq(s);
  const int cl = wave * 4 + (lane >> 4);
  const int c = cg_ * 16 + cl;
  const int j0 = (lane & 15) * 8;
  float* buf0 = (float*)smem;
  float* obuf = buf0 + 2 * CH * 384;
  float* bgb = obuf + CH * 16;
  float S[8];
  if (s < 8) {
#pragma unroll
    for (int i = 0; i < 8; ++i) S[i] = 0.f;
  } else {
#pragma unroll
    for (int i = 0; i < 8; ++i) S[i] = P.st_ssm[(((size_t)(s - 8) * 4 + h) * 128 + j0 + i) * 128 + c];
  }
  const bfu* stream = (const bfu*)(P.ws + OFF_STREAMB) + ((size_t)row0 * 4 + h) * 384;
  const size_t sstride = 4 * 384;
  const float* bg = (const float*)(P.ws + OFF_BG);
  bfu* omix = (bfu*)(P.ws + OFF_OMIX);
  const int nch = (T + CH - 1) / CH;
  u32x4 rg[3];
  float bgr = 0.f;
  {
    int n0 = min(CH, T);
    chunk_gload(rg, stream, sstride, n0);
    if (tid < n0 * 2) bgr = bg[(size_t)(row0 + (tid >> 1)) * 8 + (tid & 1) * 4 + h];
    chunk_lstore<false>(rg, buf0, n0);
    if (tid < n0 * 2) bgb[tid] = bgr;
  }
  __syncthreads();
  for (int ci = 0; ci < nch; ++ci) {
    const int nsteps = min(CH, T - ci * CH);
    const int nnext = (ci + 1 < nch) ? min(CH, T - (ci + 1) * CH) : 0;
    if (nnext > 0) {
      chunk_gload(rg, stream + (size_t)(ci + 1) * CH * sstride, sstride, nnext);
      if (tid < nnext * 2) bgr = bg[(size_t)(row0 + (ci + 1) * CH + (tid >> 1)) * 8 + (tid & 1) * 4 + h];
    }
    const float* buf = buf0 + (ci & 1) * CH * 384;
    const float* bgc = bgb + (ci & 1) * CH * 2;
    for (int st = 0; st < nsteps; ++st) {
      const float* b = buf + st * 384;
      float4 q0 = *(const float4*)(b + j0), q1 = *(const float4*)(b + j0 + 4);
      float4 k0 = *(const float4*)(b + 128 + j0), k1 = *(const float4*)(b + 128 + j0 + 4);
      float vv = b[256 + c];
      float beta = bgc[st * 2], alpha = bgc[st * 2 + 1];
      float p = S[0] * k0.x + S[1] * k0.y + S[2] * k0.z + S[3] * k0.w + S[4] * k1.x + S[5] * k1.y + S[6] * k1.z +
                S[7] * k1.w;
      p = row16_sum(p);
      float vn = beta * (vv - alpha * p);
      S[0] = alpha * S[0] + k0.x * vn;
      S[1] = alpha * S[1] + k0.y * vn;
      S[2] = alpha * S[2] + k0.z * vn;
      S[3] = alpha * S[3] + k0.w * vn;
      S[4] = alpha * S[4] + k1.x * vn;
      S[5] = alpha * S[5] + k1.y * vn;
      S[6] = alpha * S[6] + k1.z * vn;
      S[7] = alpha * S[7] + k1.w * vn;
      float q = S[0] * q0.x + S[1] * q0.y + S[2] * q0.z + S[3] * q0.w + S[4] * q1.x + S[5] * q1.y + S[6] * q1.z +
                S[7] * q1.w;
      q = row16_sum(q);
      if ((lane & 15) == 0) obuf[st * 16 + cl] = q;
    }
    __syncthreads();
    if (tid < nsteps * 16) {
      int st = tid >> 4, r = tid & 15;
      omix[(size_t)(row0 + ci * CH + st) * 1024 + 512 + h * 128 + cg_ * 16 + r] = f2bf(obuf[tid]);
    }
    if (nnext > 0) {
      chunk_lstore<false>(rg, buf0 + ((ci + 1) & 1) * CH * 384, nnext);
      if (tid < nnext * 2) bgb[((ci + 1) & 1) * CH * 2 + tid] = bgr;
    }
    __syncthreads();
  }
  float* o = P.out + (s < 8 ? O_PB_SSM + (((size_t)s * 4 + h) * 128 + j0) * 128 + c
                            : O_SB_SSM + (((size_t)(s - 8) * 4 + h) * 128 + j0) * 128 + c);
#pragma unroll
  for (int i = 0; i < 8; ++i) o[(size_t)i * 128] = S[i];
}

DI void ph_scan(const Params& P, int u, char* smem) {
  if (u < 256) rwkv_unit(P, u, smem);
  else if (u < 512) delta_unit(P, u - 256, smem);
  else if (u < 512 + 4096) rwkv_unit(P, u - 512 + 256, smem);
  else delta_unit(P, u - 512 - 4096 + 256, smem);
}

DI void ph_post(const Params& P, int u, char* smem) {
  const int tid = threadIdx.x, lane = tid & 63, wave = tid >> 6;
  const int m = u / 3;
  const int task = (u - m * 3) * 4 + wave;
  bfu* omix = (bfu*)(P.ws + OFF_OMIX);
  if (task < 8) {
    const int h = task, c = h * 64 + lane;
    float o = bf2f(omix[(size_t)m * 1024 + c]);
    float mean = wave_sum(o) * (1.f / 64.f);
    float d = o - mean;
    float var = wave_sum(d * d) * (1.f / 64.f);
    float on = d * rsqrtf(var + GN_EPS) * P.a_gn_g[c] + P.a_gn_b[c];
    float v = bf2f(((const bfu*)(P.ws + OFF_STREAM))[(size_t)(m * 8 + h) * 384 + 192 + lane]);
    float bonus = ((const float*)(P.ws + OFF_BONUS))[m * 8 + h];
    float g = bf2f(((const bfu*)(P.ws + OFF_G))[(size_t)m * 512 + c]);
    omix[(size_t)m * 1024 + c] = f2bf((on + bonus * v) * g);
  } else {
    const int h = task - 8;
    const int ci = h * 128 + lane * 2;
    unsigned q = *(const unsigned*)(omix + (size_t)m * 1024 + 512 + ci);
    float o0 = lo_bf(q), o1 = hi_bf(q);
    float ms = wave_sum(o0 * o0 + o1 * o1) * (1.f / 128.f);
    float rinv = rsqrtf(ms + RMS_EPS);
    unsigned zq = *(const unsigned*)((const bfu*)P.out + (size_t)m * PB_W + 1536 + ci);
    float z0 = lo_bf(zq), z1 = hi_bf(zq);
    float r0 = o0 * rinv * P.b_norm_g[lane * 2] * siluf_(z0);
    float r1 = o1 * rinv * P.b_norm_g[lane * 2 + 1] * siluf_(z1);
    *(unsigned*)(omix + (size_t)m * 1024 + 512 + ci) = pack2(r0, r1);
  }
}

DI void ph_gemm_o(const Params& P, int u, char* smem) {
  const int mt = u >> 3, nt = u & 7;
  const int m0 = mt * 128, n0 = nt * 128;
  const bfu* A = (const bfu*)(P.ws + OFF_OMIX) + (size_t)m0 * 1024;
  const float* x = (m0 < M_P) ? P.x_p : P.x_s - (size_t)M_P * DM;
  float* y = P.out;
  gemm_tile<false>(A, 1024, (const bfu*)(P.ws + WT_O) + (size_t)n0 * 1024, 1024, m0, n0, (bfu*)smem,
                   [&](int m, int n, f32x4 v) {
                     f32x4 xv = *(const f32x4*)(x + (size_t)m * DM + n);
                     f32x4 r;
#pragma unroll
                     for (int j = 0; j < 4; ++j) r[j] = DN_ALPHA * xv[j] + v[j];
                     *(f32x4*)(y + (size_t)m * DM + n) = r;
                   });
}

DI void ln_row(const float* src, float* dst, const float* g, const float* b, int lane) {
  float4 v[4];
  float s = 0.f;
#pragma unroll
  for (int i = 0; i < 4; ++i) {
    v[i] = *(const float4*)(src + i * 256 + lane * 4);
    s += v[i].x + v[i].y + v[i].z + v[i].w;
  }
  float mean = wave_sum(s) * (1.f / 1024.f);
  float q = 0.f;
#pragma unroll
  for (int i = 0; i < 4; ++i) {
    float a = v[i].x - mean, bb = v[i].y - mean, c = v[i].z - mean, d = v[i].w - mean;
    q += a * a + bb * bb + c * c + d * d;
  }
  float rstd = rsqrtf(wave_sum(q) * (1.f / 1024.f) + LN_EPS);
#pragma unroll
  for (int i = 0; i < 4; ++i) {
    float4 gg = *(const float4*)(g + i * 256 + lane * 4);
    float4 bb = *(const float4*)(b + i * 256 + lane * 4);
    float4 o;
    o.x = (v[i].x - mean) * rstd * gg.x + bb.x;
    o.y = (v[i].y - mean) * rstd * gg.y + bb.y;
    o.z = (v[i].z - mean) * rstd * gg.z + bb.z;
    o.w = (v[i].w - mean) * rstd * gg.w + bb.w;
    *(float4*)(dst + i * 256 + lane * 4) = o;
  }
}

DI void ph_ln1(const Params& P, int u, char* smem) {
  const int lane = threadIdx.x & 63, wave = threadIdx.x >> 6;
  const int m = u * 4 + wave;
  float* row = P.out + (size_t)m * DM;
  ln_row(row, row, P.ln1_g, P.ln1_b, lane);
}

DI void ph_gemm_up(const Params& P, int u, char* smem) {
  const int mt = u / 44, nt = u - mt * 44;
  const int m0 = mt * 128, n0 = nt * 128;
  const float* A = P.out + (size_t)m0 * DM;
  bfu* gu = (bfu*)(P.ws + OFF_GU);
  gemm_tile<true>(A, DM, (const bfu*)(P.ws + WT_UP) + (size_t)n0 * 1024, 1024, m0, n0, (bfu*)smem,
                  [&](int m, int n, f32x4 v) { store_bf4(gu + (size_t)m * 5632 + n, v); });
}

DI void ph_ffnconv(const Params& P, int u, char* smem) {
  const int tid = threadIdx.x;
  const int m0 = u * 8;
  const int s = seq_of_row(m0), t0 = t_of_row(m0);
  const int T = T_of_seq(s);
  bfu* gu = (bfu*)(P.ws + OFF_GU);
  float* ostate = P.out + (s < 8 ? O_PF_CONV + (size_t)s * 2 * DFF : O_SF_CONV + (size_t)(s - 8) * 2 * DFF);
  const bool last = (t0 + 8 == T);
  for (int cp = tid; cp < DFF / 2; cp += 256) {
    const int c = cp * 2;
    float w[3][2];
#pragma unroll
    for (int j = 0; j < 3; ++j) {
      float2 ww = *(const float2*)(P.f_conv_w + j * DFF + c);
      w[j][0] = ww.x;
      w[j][1] = ww.y;
    }
    float2 fb = *(const float2*)(P.f_conv_b + c);
    float g[10][2];
#pragma unroll
    for (int i = 0; i < 10; ++i) {
      int tt = t0 + i - 2;
      if (tt >= 0) {
        unsigned q = *(const unsigned*)(gu + (size_t)(m0 + i - 2) * 5632 + c);
        g[i][0] = lo_bf(q);
        g[i][1] = hi_bf(q);
      } else if (s >= 8) {
        float2 q = *(const float2*)(P.st_fconv + ((size_t)(s - 8) * 2 + i) * DFF + c);
        g[i][0] = q.x;
        g[i][1] = q.y;
      } else {
        g[i][0] = 0.f;
        g[i][1] = 0.f;
      }
    }
#pragma unroll
    for (int i = 0; i < 8; ++i) {
      unsigned uq = *(const unsigned*)(gu + (size_t)(m0 + i) * 5632 + DFF + c);
      float a0 = w[0][0] * g[i][0] + w[1][0] * g[i + 1][0] + w[2][0] * g[i + 2][0] + fb.x;
      float a1 = w[0][1] * g[i][1] + w[1][1] * g[i + 1][1] + w[2][1] * g[i + 2][1] + fb.y;
      float h0 = siluf_(a0) * lo_bf(uq), h1 = siluf_(a1) * hi_bf(uq);
      *(unsigned*)(gu + (size_t)(m0 + i) * 5632 + DFF + c) = pack2(h0, h1);
    }
    if (last) {
      *(float2*)(ostate + c) = float2{g[8][0], g[8][1]};
      *(float2*)(ostate + DFF + c) = float2{g[9][0], g[9][1]};
    }
  }
}

DI void ph_gemm_down(const Params& P, int u, char* smem) {
  const int mt = u >> 3, nt = u & 7;
  const int m0 = mt * 128, n0 = nt * 128;
  const bfu* A = (const bfu*)(P.ws + OFF_GU) + (size_t)m0 * 5632 + DFF;
  float* y = P.out;
  gemm_tile<false>(A, 5632, (const bfu*)(P.ws + WT_DOWN) + (size_t)n0 * DFF, DFF, m0, n0, (bfu*)smem,
                   [&](int m, int n, f32x4 v) {
                     f32x4 xv = *(const f32x4*)(y + (size_t)m * DM + n);
                     f32x4 r;
#pragma unroll
                     for (int j = 0; j < 4; ++j) r[j] = DN_ALPHA * xv[j] + v[j];
                     *(f32x4*)(y + (size_t)m * DM + n) = r;
                   });
}

DI void ph_ln2_ple(const Params& P, int u, char* smem) {
  if (u < M_TOK / 4) {
    const int lane = threadIdx.x & 63, wave = threadIdx.x >> 6;
    const int m = u * 4 + wave;
    ln_row(P.out + (size_t)m * DM, (float*)(P.ws + OFF_X2) + (size_t)m * DM, P.ln2_g, P.ln2_b, lane);
  } else {
    const int r = u - M_TOK / 4;
    const int mt = r >> 3, nt = r & 7;
    const int m0 = mt * 128, n0 = nt * 128;
    const float* A = (m0 < M_P) ? P.p_p + (size_t)m0 * PLE : P.p_s + (size_t)(m0 - M_P) * PLE;
    float* ep = (float*)(P.ws + OFF_EPRE);
    gemm_tile<true>(A, PLE, (const bfu*)(P.ws + WT_PLE) + (size_t)n0 * PLE, PLE, m0, n0, (bfu*)smem,
                    [&](int m, int n, f32x4 v) { *(f32x4*)(ep + (size_t)m * DM + n) = v; });
  }
}

DI void ph_rinv(const Params& P, int u, char* smem) {
  const int lane = threadIdx.x & 63, wave = threadIdx.x >> 6;
  const int m = u * 4 + wave;
  const float* ep = (const float*)(P.ws + OFF_EPRE) + (size_t)m * DM;
  float q = 0.f;
#pragma unroll
  for (int i = 0; i < 4; ++i) {
    float4 v = *(const float4*)(ep + i * 256 + lane * 4);
    q += v.x * v.x + v.y * v.y + v.z * v.z + v.w * v.w;
  }
  q = wave_sum(q);
  if (lane == 0) ((float*)(P.ws + OFF_RINV))[m] = rsqrtf(q * (1.f / 1024.f) + RMS_EPS);
}

DI void ph_gemm_fin(const Params& P, int u, char* smem) {
  const int mt = u >> 3, nt = u & 7;
  const int m0 = mt * 128, n0 = nt * 128;
  const float* x2 = (const float*)(P.ws + OFF_X2);
  const float* ep = (const float*)(P.ws + OFF_EPRE);
  const float* rinv = (const float*)(P.ws + OFF_RINV);
  const float* pg = P.ple_g;
  float* y = P.out;
  gemm_tile<true>(x2 + (size_t)m0 * DM, DM, (const bfu*)(P.ws + WT_GATE) + (size_t)n0 * 1024, 1024, m0, n0,
                  (bfu*)smem, [&](int m, int n, f32x4 v) {
                    f32x4 xv = *(const f32x4*)(x2 + (size_t)m * DM + n);
                    f32x4 ev = *(const f32x4*)(ep + (size_t)m * DM + n);
                    f32x4 gv = *(const f32x4*)(pg + n);
                    float ri = rinv[m];
                    f32x4 r;
#pragma unroll
                    for (int j = 0; j < 4; ++j) r[j] = xv[j] + sigmoidf_(v[j]) * (ev[j] * ri * gv[j]);
                    *(f32x4*)(y + (size_t)m * DM + n) = r;
                  });
}

template <int PH>
DI void run_unit(const Params& P, int u, char* smem) {
  if (PH == PH_WT) ph_wt(P, u, smem);
  else if (PH == PH_GEMM_IN) ph_gemm_in(P, u, smem);
  else if (PH == PH_LORAIN) ph_lorain(P, u, smem);
  else if (PH == PH_LORA) ph_lora(P, u, smem);
  else if (PH == PH_PREPA) ph_prepa(P, u, smem);
  else if (PH == PH_PREPB) ph_prepb(P, u, smem);
  else if (PH == PH_SCAN) ph_scan(P, u, smem);
  else if (PH == PH_POST) ph_post(P, u, smem);
  else if (PH == PH_GEMM_O) ph_gemm_o(P, u, smem);
  else if (PH == PH_LN1) ph_ln1(P, u, smem);
  else if (PH == PH_GEMM_UP) ph_gemm_up(P, u, smem);
  else if (PH == PH_FFNCONV) ph_ffnconv(P, u, smem);
  else if (PH == PH_GEMM_DOWN) ph_gemm_down(P, u, smem);
  else if (PH == PH_LN2_PLE) ph_ln2_ple(P, u, smem);
  else if (PH == PH_RINV) ph_rinv(P, u, smem);
  else if (PH == PH_GEMM_FIN) ph_gemm_fin(P, u, smem);
}

template <int PH>
DI void run_phase(const Params& P, char* smem) {
  const int n = units_of(PH, P.wd_tiles);
  for (int u = blockIdx.x; u < n; u += gridDim.x) run_unit<PH>(P, u, smem);
}

#if MULTI_LAUNCH
template <int PH>
__global__ void __launch_bounds__(256) k_phase(Params P) {
  __shared__ __attribute__((aligned(16))) char smem[SMEM_BYTES];
  run_phase<PH>(P, smem);
}
#else
__global__ void __launch_bounds__(256, 2) k_mega(Params P) {
  __shared__ __attribute__((aligned(16))) char smem[SMEM_BYTES];
  cg::grid_group grid = cg::this_grid();
  run_phase<PH_WT>(P, smem); grid.sync();
  run_phase<PH_GEMM_IN>(P, smem); grid.sync();
  run_phase<PH_LORAIN>(P, smem); grid.sync();
  run_phase<PH_LORA>(P, smem); grid.sync();
  run_phase<PH_PREPA>(P, smem); grid.sync();
  run_phase<PH_PREPB>(P, smem); grid.sync();
  run_phase<PH_SCAN>(P, smem); grid.sync();
  run_phase<PH_POST>(P, smem); grid.sync();
  run_phase<PH_GEMM_O>(P, smem); grid.sync();
  run_phase<PH_LN1>(P, smem); grid.sync();
  run_phase<PH_GEMM_UP>(P, smem); grid.sync();
  run_phase<PH_FFNCONV>(P, smem); grid.sync();
  run_phase<PH_GEMM_DOWN>(P, smem); grid.sync();
  run_phase<PH_LN2_PLE>(P, smem); grid.sync();
  run_phase<PH_RINV>(P, smem); grid.sync();
  run_phase<PH_GEMM_FIN>(P, smem);
}
#endif

#if MULTI_LAUNCH
template <int PH>
static void launch_phase(const Params& P, hipStream_t stream) {
  int n = units_of(PH, P.wd_tiles);
  int grid = (PH == PH_SCAN) ? 512 : (n < 4096 ? n : 4096);
  hipLaunchKernelGGL(k_phase<PH>, dim3(grid), dim3(256), 0, stream, P);
}
#endif

extern "C" void kernel_launch(void* const* d_in, const int* in_sizes, int n_in, void* d_out, int out_size,
                              void* d_ws, size_t ws_size, hipStream_t stream) {
  Params P;
  memset(&P, 0, sizeof(P));
  const float** f = (const float**)&P;
  for (int i = 0; i < 37; ++i) f[i] = (const float*)d_in[i];
  P.out = (float*)d_out;
  P.ws = (char*)d_ws;
  char* ws = (char*)d_ws;
  struct { const float* src; size_t off; int K, N, Npad; } wl[9] = {
      {P.w_in, WT_IN, 1024, INW, INW_PAD},   {P.a_w_w2, WT_W2, 64, 512, 512},   {P.a_w_a2, WT_A2, 64, 512, 512},
      {P.a_w_g2, WT_G2, 128, 512, 512},      {P.w_o, WT_O, 1024, 1024, 1024},   {P.w_up, WT_UP, 1024, 5632, 5632},
      {P.w_down, WT_DOWN, 2816, 1024, 1024}, {P.w_ple, WT_PLE, 256, 1024, 1024}, {P.w_ple_gate, WT_GATE, 1024, 1024, 1024}};
  int t0 = 0;
  for (int i = 0; i < 9; ++i) {
    P.wd[i].src = wl[i].src;
    P.wd[i].dst = (bfu*)(ws + wl[i].off);
    P.wd[i].K = wl[i].K;
    P.wd[i].N = wl[i].N;
    P.wd[i].Npad = wl[i].Npad;
    P.wd[i].t0 = t0;
    t0 += (wl[i].Npad / 64) * (wl[i].K / 64);
  }
  P.wd_tiles = t0;
#if MULTI_LAUNCH
  launch_phase<PH_WT>(P, stream);
  launch_phase<PH_GEMM_IN>(P, stream);
  launch_phase<PH_LORAIN>(P, stream);
  launch_phase<PH_LORA>(P, stream);
  launch_phase<PH_PREPA>(P, stream);
  launch_phase<PH_PREPB>(P, stream);
  launch_phase<PH_SCAN>(P, stream);
  launch_phase<PH_POST>(P, stream);
  launch_phase<PH_GEMM_O>(P, stream);
  launch_phase<PH_LN1>(P, stream);
  launch_phase<PH_GEMM_UP>(P, stream);
  launch_phase<PH_FFNCONV>(P, stream);
  launch_phase<PH_GEMM_DOWN>(P, stream);
  launch_phase<PH_LN2_PLE>(P, stream);
  launch_phase<PH_RINV>(P, stream);
  launch_phase<PH_GEMM_FIN>(P, stream);
#else
  static int grid_blocks = 0;
  if (!grid_blocks) {
    int dev = 0, cus = 0, per_cu = 0;
    hipGetDevice(&dev);
    hipDeviceGetAttribute(&cus, hipDeviceAttributeMultiprocessorCount, dev);
    hipOccupancyMaxActiveBlocksPerMultiprocessor(&per_cu, k_mega, 256, 0);
    if (per_cu > 2) per_cu = 2;
    grid_blocks = cus * per_cu;
  }
  void* args[] = {&P};
  hipError_t e = hipLaunchCooperativeKernel((void*)k_mega, dim3(grid_blocks), dim3(256), args, 0, stream);
  if (e != hipSuccess) fprintf(stderr, "cooperative launch failed: %s (grid %d)\n", hipGetErrorString(e), grid_blocks);
#endif
}
```

```cpp
#include <hip/hip_runtime.h>
#include <hip/hip_bf16.h>
#include <hip/hip_cooperative_groups.h>
#include <cstdio>
#include <cstring>
namespace cg = cooperative_groups;

#ifndef MULTI_LAUNCH
#define MULTI_LAUNCH 0
#endif

#define DI __device__ __forceinline__
#define VT ((int)(threadIdx.x & 255u))
typedef unsigned short bfu;
using bf16x8 = __attribute__((ext_vector_type(8))) short;
using f32x4 = __attribute__((ext_vector_type(4))) float;
using u32x4 = __attribute__((ext_vector_type(4))) unsigned;

constexpr int M_TOK = 17408, M_P = 16384, NSEQ = 136;
constexpr int DM = 1024, AW = 512, ASW = 1792, BQKV = 1536, PB_W = 2048, INW = 3848, INW_PAD = 3968;
constexpr int DFF = 2816, PLE = 256;
constexpr float DN_ALPHA = 1.189207115002721f;
constexpr float LN_EPS = 1e-5f, GN_EPS = 64e-5f, RMS_EPS = 1e-6f, L2_EPS = 1e-12f;

constexpr size_t O_Y = 0;
constexpr size_t O_PA_WKV = (size_t)M_TOK * 1024;
constexpr size_t O_PA_SHIFT = O_PA_WKV + 8 * 8 * 64 * 64;
constexpr size_t O_PB_SSM = O_PA_SHIFT + 8 * 1792;
constexpr size_t O_PB_CONV = O_PB_SSM + 8 * 4 * 128 * 128;
constexpr size_t O_PF_CONV = O_PB_CONV + 8 * 3 * 1536;
constexpr size_t O_SA_WKV = O_PF_CONV + 8 * 2 * 2816;
constexpr size_t O_SA_SHIFT = O_SA_WKV + (size_t)128 * 8 * 64 * 64;
constexpr size_t O_SB_SSM = O_SA_SHIFT + 128 * 1792;
constexpr size_t O_SB_CONV = O_SB_SSM + (size_t)128 * 4 * 128 * 128;
constexpr size_t O_SF_CONV = O_SB_CONV + 128 * 3 * 1536;

constexpr size_t WL_UP = 0;
constexpr size_t WL_DOWN = WL_UP + (size_t)5632 * 1024 * 2;
constexpr size_t WL_PLE = WL_DOWN + (size_t)1024 * 2816 * 2;
constexpr size_t WL_GATE = WL_PLE + 1024 * 256 * 2;
constexpr size_t OFF_PB = WL_GATE + 1024 * 1024 * 2;
constexpr size_t OFF_STREAM = OFF_PB + (size_t)M_TOK * 256 * 2;
constexpr size_t OFF_G = OFF_STREAM + (size_t)M_TOK * 8 * 384 * 2;
constexpr size_t OFF_PROJA = OFF_G + (size_t)M_TOK * 512 * 2;
constexpr size_t OFF_LORAIN = OFF_PROJA + (size_t)M_TOK * 1792 * 2;
constexpr size_t OFF_ABUF = OFF_LORAIN + (size_t)M_TOK * 256 * 2;
constexpr size_t OFF_BA = OFF_ABUF + (size_t)M_TOK * 512 * 2;
constexpr size_t OFF_BG = OFF_BA + (size_t)M_TOK * 8 * 4;
constexpr size_t OFF_BONUS = OFF_BG + (size_t)M_TOK * 8 * 4;
constexpr size_t WT_IN = OFF_BONUS + (size_t)M_TOK * 8 * 4;
constexpr size_t WT_W2 = WT_IN + (size_t)INW_PAD * 1024 * 2;
constexpr size_t WT_A2 = WT_W2 + 512 * 64 * 2;
constexpr size_t WT_G2 = WT_A2 + 512 * 64 * 2;
constexpr size_t WT_O = WT_G2 + 512 * 128 * 2;
constexpr size_t WT_UP = WL_UP, WT_DOWN = WL_DOWN, WT_PLE = WL_PLE, WT_GATE = WL_GATE;
constexpr size_t OFF_WEND = WT_O + 1024 * 1024 * 2;
constexpr size_t OFF_XB = OFF_STREAM;
constexpr size_t OFF_STREAMB = OFF_PROJA;
constexpr size_t OFF_OMIX = OFF_STREAMB + (size_t)M_TOK * 4 * 384 * 2;
constexpr size_t OFF_GU = OFF_STREAM;
constexpr size_t OFF_X1B = OFF_GU + (size_t)M_TOK * 5632 * 2;
constexpr size_t OFF_RINV = OFF_X1B + (size_t)M_TOK * 1024 * 2;
constexpr size_t OFF_GG = OFF_RINV + (size_t)M_TOK * 4;
constexpr size_t OFF_END = OFF_GG + (size_t)M_TOK * 4 * 4;
constexpr size_t OFF_X2 = OFF_STREAM;
constexpr size_t OFF_X2B = OFF_X2 + (size_t)M_TOK * 1024 * 4;
constexpr size_t OFF_FSLAB = OFF_X2 + (size_t)M_TOK * 1024 * 2;
static_assert(OFF_FSLAB + 4ull * 1024 * 1024 * 4 <= OFF_X2B, "fin slabs overlap");
constexpr size_t OFF_EPRE = OFF_X2;
static_assert(OFF_OMIX + (size_t)M_TOK * 1024 * 2 <= OFF_BA, "omix overlap");
static_assert(OFF_X1B >= OFF_ABUF, "x1b overlaps live data");
static_assert(OFF_X1B >= OFF_OMIX + 0 || true, "");
static_assert(OFF_RINV >= OFF_WEND, "rinv overlaps weights");
static_assert(OFF_EPRE + (size_t)M_TOK * 1024 * 2 <= OFF_X2B, "epre overlap");
static_assert(OFF_END + 3456 * 4 <= 256ull * 1024 * 1024, "ws too small");
static_assert(OFF_END % 256 == 0, "barrier word alignment");

struct WD { const float* src; bfu* dst; int K, N, Npad, t0; };

struct Params {
  const float *x_p, *x_s, *p_p, *p_s, *st_wkv, *st_shift, *st_ssm, *st_bconv, *st_fconv;
  const float *w_in, *a_mu, *a_w0, *a_w_w2, *a_a0, *a_w_a2, *a_w_g2, *a_k_k, *a_k_a, *a_r_k, *a_gn_g, *a_gn_b;
  const float *b_conv_w, *b_a_log, *b_dt_bias, *b_norm_g, *w_o, *ln1_g, *ln1_b, *w_up, *f_conv_w, *f_conv_b,
      *w_down, *ln2_g, *ln2_b, *w_ple, *ple_g, *w_ple_gate;
  float* out;
  char* ws;
  WD wd[9];
  int wd_tiles;
  int pad_;
};

typedef __bf16 bf16x2_t __attribute__((ext_vector_type(2)));
typedef float f32x2_t __attribute__((ext_vector_type(2)));
DI unsigned pack2(float a, float b) {
  const f32x2_t v = {a, b};
  const bf16x2_t r = __builtin_convertvector(v, bf16x2_t);
  return __builtin_bit_cast(unsigned, r);
}
DI bfu f2bf(float f) { return (bfu)pack2(f, f); }
DI float bf2f(bfu h) { return __uint_as_float(((unsigned)h) << 16); }
DI float lo_bf(unsigned u) { return __uint_as_float(u << 16); }
DI float hi_bf(unsigned u) { return __uint_as_float(u & 0xffff0000u); }
DI float sigmoidf_(float x) { return __builtin_amdgcn_rcpf(1.f + __builtin_amdgcn_exp2f(x * -1.4426950408889634f)); }
DI float siluf_(float x) { return x * __builtin_amdgcn_rcpf(1.f + __builtin_amdgcn_exp2f(x * -1.4426950408889634f)); }
DI float softplusf_(float x) { return fmaxf(x, 0.f) + log1pf(__expf(-fabsf(x))); }
DI float wave_sum(float v) {
#pragma unroll
  for (int o = 32; o > 0; o >>= 1) v += __shfl_xor(v, o, 64);
  return v;
}
DI float row16_sum(float x) {
  x += __int_as_float(__builtin_amdgcn_update_dpp(0, __float_as_int(x), 0x128, 0xf, 0xf, false));
  x += __int_as_float(__builtin_amdgcn_update_dpp(0, __float_as_int(x), 0x124, 0xf, 0xf, false));
  x += __int_as_float(__builtin_amdgcn_update_dpp(0, __float_as_int(x), 0x122, 0xf, 0xf, false));
  x += __int_as_float(__builtin_amdgcn_update_dpp(0, __float_as_int(x), 0x121, 0xf, 0xf, false));
  return x;
}
DI float sum8(float x) {
  x += __int_as_float(__builtin_amdgcn_update_dpp(0, __float_as_int(x), 0xB1, 0xf, 0xf, false));
  x += __int_as_float(__builtin_amdgcn_update_dpp(0, __float_as_int(x), 0x4E, 0xf, 0xf, false));
  x += __int_as_float(__builtin_amdgcn_update_dpp(0, __float_as_int(x), 0x141, 0xf, 0xf, false));
  return x;
}
DI void unpack8(u32x4 q, float (&f)[8]) {
  f[0] = lo_bf(q.x); f[1] = hi_bf(q.x); f[2] = lo_bf(q.y); f[3] = hi_bf(q.y);
  f[4] = lo_bf(q.z); f[5] = hi_bf(q.z); f[6] = lo_bf(q.w); f[7] = hi_bf(q.w);
}
DI u32x4 pack8(const float (&f)[8]) {
  u32x4 q;
  q.x = pack2(f[0], f[1]); q.y = pack2(f[2], f[3]); q.z = pack2(f[4], f[5]); q.w = pack2(f[6], f[7]);
  return q;
}
DI void load8f(const float* p, float (&f)[8]) {
  f32x4 a = *(const f32x4*)p, b = *(const f32x4*)(p + 4);
  f[0] = a[0]; f[1] = a[1]; f[2] = a[2]; f[3] = a[3]; f[4] = b[0]; f[5] = b[1]; f[6] = b[2]; f[7] = b[3];
}
DI int seq_of_row(int m) { return m < M_P ? (m >> 11) : 8 + ((m - M_P) >> 3); }
DI int t_of_row(int m) { return m < M_P ? (m & 2047) : (m & 7); }
DI int row0_of_seq(int s) { return s < 8 ? s * 2048 : M_P + (s - 8) * 8; }
DI int T_of_seq(int s) { return s < 8 ? 2048 : 8; }

constexpr int SMEM_BYTES = 81904;

constexpr int LDT = 72;
constexpr int TILE_ELEMS = 128 * LDT;
constexpr int GBK = 64;

template <bool AF32>
DI void g_load(const void* __restrict__ Ap, int lda, const bfu* __restrict__ Bp, int K, int kt, int lrow, int lkc,
               u32x4 (&ra)[4], u32x4 (&rb)[4], f32x4 (&fa)[4][2]) {
#pragma unroll
  for (int j = 0; j < 4; ++j) {
    const int row = lrow + 32 * j;
    if constexpr (AF32) {
      const float* ap = (const float*)Ap + (size_t)row * lda + kt * GBK + lkc;
      fa[j][0] = *(const f32x4*)ap;
      fa[j][1] = *(const f32x4*)(ap + 4);
    } else {
      const bfu* ap = (const bfu*)Ap + (size_t)row * lda + kt * GBK + lkc;
      ra[j] = *(const u32x4*)ap;
    }
    rb[j] = *(const u32x4*)(Bp + (size_t)row * K + kt * GBK + lkc);
  }
}
template <bool AF32>
DI void l_store(bfu* As, bfu* Bs, int lrow, int lkc, const u32x4 (&ra)[4], const u32x4 (&rb)[4],
                const f32x4 (&fa)[4][2]) {
#pragma unroll
  for (int j = 0; j < 4; ++j) {
    const int row = lrow + 32 * j;
    u32x4 va;
    if constexpr (AF32) {
      va.x = pack2(fa[j][0].x, fa[j][0].y);
      va.y = pack2(fa[j][0].z, fa[j][0].w);
      va.z = pack2(fa[j][1].x, fa[j][1].y);
      va.w = pack2(fa[j][1].z, fa[j][1].w);
    } else {
      va = ra[j];
    }
    *(u32x4*)(As + row * LDT + lkc) = va;
    *(u32x4*)(Bs + row * LDT + lkc) = rb[j];
  }
}

template <bool AF32, class Epi>
DI void gemm_tile(const void* __restrict__ Ap, int lda, const bfu* __restrict__ Bp, int K, int m0, int n0,
                  bfu* smem, Epi epi) {
  const int tid = VT, lane = tid & 63, wave = tid >> 6;
  const int wm = wave >> 1, wn = wave & 1;
  bfu* As = smem;
  bfu* Bs = smem + TILE_ELEMS;
  f32x4 acc[4][4];
#pragma unroll
  for (int i = 0; i < 4; ++i)
#pragma unroll
    for (int j = 0; j < 4; ++j) acc[i][j] = f32x4{0.f, 0.f, 0.f, 0.f};
  const int lrow = tid >> 3, lkc = (tid & 7) * 8;
  u32x4 ra[4], rb[4];
  f32x4 fa[4][2];
  const int nk = K / GBK;

  g_load<AF32>(Ap, lda, Bp, K, 0, lrow, lkc, ra, rb, fa);
  for (int kt = 0; kt < nk; ++kt) {
    __syncthreads();
    l_store<AF32>(As, Bs, lrow, lkc, ra, rb, fa);
    __syncthreads();
    if (kt + 1 < nk) g_load<AF32>(Ap, lda, Bp, K, kt + 1, lrow, lkc, ra, rb, fa);
#pragma unroll
    for (int ks = 0; ks < 2; ++ks) {
      bf16x8 af[4], bfr[4];
#pragma unroll
      for (int mi = 0; mi < 4; ++mi)
        af[mi] = *(const bf16x8*)(As + (wm * 64 + mi * 16 + (lane & 15)) * LDT + ks * 32 + (lane >> 4) * 8);
#pragma unroll
      for (int ni = 0; ni < 4; ++ni)
        bfr[ni] = *(const bf16x8*)(Bs + (wn * 64 + ni * 16 + (lane & 15)) * LDT + ks * 32 + (lane >> 4) * 8);
#pragma unroll
      for (int mi = 0; mi < 4; ++mi)
#pragma unroll
        for (int ni = 0; ni < 4; ++ni)
          acc[mi][ni] = __builtin_amdgcn_mfma_f32_16x16x32_bf16(bfr[ni], af[mi], acc[mi][ni], 0, 0, 0);
    }
  }
#pragma unroll
  for (int mi = 0; mi < 4; ++mi)
#pragma unroll
    for (int ni = 0; ni < 4; ++ni) {
      int m = m0 + wm * 64 + mi * 16 + (lane & 15);
      int n = n0 + wn * 64 + ni * 16 + (lane >> 4) * 4;
      epi(m, n, acc[mi][ni]);
    }
  __syncthreads();
}

DI void store_bf4(bfu* p, f32x4 v) {
  uint2 u;
  u.x = pack2(v[0], v[1]);
  u.y = pack2(v[2], v[3]);
  *(uint2*)p = u;
}

namespace pg8 {
#define PG8_LAS __attribute__((address_space(3)))
typedef unsigned short bf16_t;
typedef short bf16x8 __attribute__((ext_vector_type(8)));
typedef float f32x4 __attribute__((ext_vector_type(4)));
typedef unsigned u32x4 __attribute__((ext_vector_type(4)));
constexpr int BM = 256, BK = 64, HALF = 128, HTB = HALF * BK * 2  , STAGE_BYTES = 8 * HTB, NXCD = 8, WGM = 8;

__host__ __device__ __forceinline__ int lds_byte(int r, int c) { const int st = (r >> 4) * 2 + (c >> 5), rr = r & 15, cc = c & 31, ob = rr * 64 + cc * 2; return st * 1024 + (ob ^ (((ob >> 9) & 1) << 5)); }
__host__ __device__ __forceinline__ void stage_rc(int b, int& R, int& C) { const int st = b / 1024, sb = b % 1024, swz = sb ^ (((sb >> 9) & 1) << 5); R = (st >> 1) * 16 + swz / 64; C = (st & 1) * 32 + (swz % 64) / 2; }
__host__ __device__ __forceinline__ int perm32(int rho) { const int n = rho >> 4, i = rho & 15; return 8 * (i >> 2) + 4 * n + (i & 3); }

struct Unit { int pm, pn; };
struct Gemm { const bf16_t* A; const bf16_t* Bt; int M, N, K, lda, ldb; };

struct StaticOrder {
    int nM, nN, nwg, G, c;
    __host__ __device__ void init(int M, int N, int G_, int c_) { nM = M / BM; nN = N / BM; nwg = nM * nN; G = G_; c = c_; }
    __host__ __device__ bool next(int i, Unit& u) const {
        const long L = (long)i * G + c; if (L >= nwg) return false;
        int wgid = (int)L; { const int q = nwg / NXCD, r = nwg % NXCD, xcd = wgid % NXCD, off = wgid / NXCD; wgid = (xcd < r ? xcd * (q + 1) : r * (q + 1) + (xcd - r) * q) + off; }
        const int nig = WGM * nN, gid = wgid / nig, fm = gid * WGM, gsz = (nM - fm) < WGM ? (nM - fm) : WGM;
        u.pm = fm + ((wgid % nig) % gsz); u.pn = (wgid % nig) / gsz; return true;
    }
    __device__ __forceinline__ void a_ready(const Unit&) const {}
    __device__ __forceinline__ void done(const Unit&) const {}
};
__device__ __forceinline__ unsigned cvt_pk_bf16(float lo, float hi) { unsigned r; asm volatile("v_cvt_pk_bf16_f32 %0, %1, %2" : "=v"(r) : "v"(lo), "v"(hi)); return r; }
template <class Epi, class Sched, bool STAMP = false>
__device__ __forceinline__ void gemm_phase(PG8_LAS unsigned char* lds, const Gemm g, const Sched& S, const Epi& E, unsigned long long* stamps) {
    int tid_ = threadIdx.x; asm volatile("" : "+v"(tid_));
    const int tid = tid_, wid = __builtin_amdgcn_readfirstlane(tid >> 6), lane = tid & 63, wr = wid >> 2, wc = wid & 3, fr = lane & 15, fq = lane >> 4;
    const int K = g.K, nt = K / BK;
    int ts_lo = 0, ts_hi = 0, nts = 0; const unsigned long long rt_entry = STAMP ? (unsigned long long)wall_clock64() : 0ull;
#define PG8_STAMP() do { if (STAMP && wid == 0 && nts < 64) { const unsigned long long _c = (unsigned long long)clock64(); \
        ts_lo = (lane == nts) ? (int)(unsigned)_c : ts_lo; ts_hi = (lane == nts) ? (int)(unsigned)(_c >> 32) : ts_hi; ++nts; } } while (0)
    PG8_STAMP();
    unsigned voffA[2], voffB[2];
#pragma unroll
    for (int i = 0; i < 2; ++i) { int R, C; stage_rc(tid * 16 + i * 8192, R, C); const int Rb = Epi::PERM ? ((R & ~31) + perm32(R & 31)) : R;
        voffA[i] = (unsigned)(R * g.lda + C) * 2u; voffB[i] = (unsigned)(Rb * g.ldb + C) * 2u; }
    const size_t kstep = (size_t)(BK * 2);
    const size_t hstep = (size_t)HALF * g.ldb * 2; const size_t hstepA = (size_t)HALF * g.lda * 2;
    const size_t tstep = 2 * hstep; const size_t tstepA = 2 * hstepA;
    const unsigned ldsw = (unsigned)wid * 1024u;
    const int aoff = lds_byte(wr * 64 + fr, fq * 8), boff = lds_byte(wc * 32 + fr, fq * 8);
#define PG8_SA(b, h) (((b) * 2 + (h)) * HTB)
#define PG8_SB(b, h) ((4 + (b) * 2 + (h)) * HTB)
#define PG8_STAGE(bufoff, gbase, voff) do { _Pragma("unroll") for (int _i = 0; _i < 2; ++_i) \
        __builtin_amdgcn_global_load_lds((const unsigned*)((const char*)(gbase) + (voff)[_i]), (PG8_LAS unsigned*)(lds + (bufoff) + ldsw + _i * 8192), 16, 0, 0); } while (0)
#define PG8_LDA(dst, b, h) do { _Pragma("unroll") for (int m = 0; m < 4; ++m) _Pragma("unroll") for (int k = 0; k < 2; ++k) dst[m][k] = *(const PG8_LAS bf16x8*)(lds + PG8_SA(b, h) + aoff + m * 2048 + k * 1024); } while (0)
#define PG8_LDB(dst, b, h) do { _Pragma("unroll") for (int n = 0; n < 2; ++n) _Pragma("unroll") for (int k = 0; k < 2; ++k) dst[n][k] = *(const PG8_LAS bf16x8*)(lds + PG8_SB(b, h) + boff + n * 2048 + k * 1024); } while (0)
#define PG8_MMA(ai, bj, At, Bt) do { __builtin_amdgcn_s_setprio(1); _Pragma("unroll") for (int m = 0; m < 4; ++m) _Pragma("unroll") for (int n = 0; n < 2; ++n) _Pragma("unroll") for (int k = 0; k < 2; ++k) \
        acc[ai][bj][m][n] = __builtin_amdgcn_mfma_f32_16x16x32_bf16(Bt[n][k], At[m][k], acc[ai][bj][m][n], 0, 0, 0); __builtin_amdgcn_s_setprio(0); } while (0)
#define PG8_WAIT_V(n) asm volatile("s_waitcnt vmcnt(" #n ")" ::: "memory")
#define PG8_WAIT_L(n) asm volatile("s_waitcnt lgkmcnt(" #n ")" ::: "memory")
#define PG8_BAR __builtin_amdgcn_s_barrier()
#define PG8_SCHED __builtin_amdgcn_sched_barrier(0)
    Unit cur, nxt; int ui = 0;
    if (!S.next(0, cur)) return;
    f32x4 acc[2][2][4][2];
#pragma unroll
    for (int a = 0; a < 2; ++a)
#pragma unroll
        for (int b = 0; b < 2; ++b)
#pragma unroll
            for (int m = 0; m < 4; ++m)
#pragma unroll
                for (int n = 0; n < 2; ++n) acc[a][b][m][n] = (f32x4){0.f, 0.f, 0.f, 0.f};
    bf16x8 At[4][2], B0[2][2], B1[2][2];
    const char* cA = (const char*)g.A + (size_t)cur.pm * tstepA; const char* cB = (const char*)g.Bt + (size_t)cur.pn * tstep;
    S.a_ready(cur);
    PG8_STAGE(PG8_SB(0, 0), cB, voffB); PG8_STAGE(PG8_SA(0, 0), cA, voffA); PG8_STAGE(PG8_SB(0, 1), cB + hstep, voffB); PG8_STAGE(PG8_SA(0, 1), cA + hstepA, voffA);
    if (wr == 1) PG8_BAR;
    PG8_WAIT_V(4); PG8_BAR;
    PG8_STAGE(PG8_SB(1, 0), cB + kstep, voffB); PG8_STAGE(PG8_SA(1, 0), cA + kstep, voffA); PG8_STAGE(PG8_SB(1, 1), cB + hstep + kstep, voffB);
    PG8_WAIT_V(6); PG8_BAR;
    PG8_STAMP();
    for (;;) {
        const bool has_next = S.next(ui + 1, nxt);
        const char* nA = has_next ? (const char*)g.A + (size_t)nxt.pm * tstepA : cA; const char* nB = has_next ? (const char*)g.Bt + (size_t)nxt.pn * tstep : cB;
        for (int t = 0; t < nt; t += 2) {
            const bool last = (t == nt - 2);
            const char* a1 = cA + (size_t)(t + 1) * kstep;
            const char* a2 = last ? nA : cA + (size_t)(t + 2) * kstep; const char* b2 = last ? nB : cB + (size_t)(t + 2) * kstep;
            const char* a3 = a2 + kstep; const char* b3 = b2 + kstep;
            if (last && has_next) S.a_ready(nxt);
            PG8_LDB(B0, 0, 0); PG8_SCHED; PG8_LDA(At, 0, 0); PG8_STAGE(PG8_SA(1, 1), a1 + hstepA, voffA);
            PG8_WAIT_L(8); PG8_BAR; PG8_WAIT_L(0); PG8_MMA(0, 0, At, B0); PG8_BAR; PG8_SCHED;
            PG8_LDB(B1, 0, 1); PG8_STAGE(PG8_SB(0, 0), b2, voffB);
            PG8_BAR; PG8_WAIT_L(0); PG8_MMA(0, 1, At, B1); PG8_BAR;
            PG8_LDA(At, 0, 1); PG8_STAGE(PG8_SA(0, 0), a2, voffA);
            PG8_BAR; PG8_WAIT_L(0); PG8_MMA(1, 0, At, B0); PG8_BAR; PG8_SCHED;
            PG8_STAGE(PG8_SB(0, 1), b2 + hstep, voffB);
            PG8_WAIT_V(6); PG8_BAR; PG8_MMA(1, 1, At, B1); PG8_BAR;
            PG8_LDB(B0, 1, 0); PG8_SCHED; PG8_LDA(At, 1, 0); PG8_STAGE(PG8_SA(0, 1), a2 + hstepA, voffA);
            PG8_WAIT_L(8); PG8_BAR; PG8_WAIT_L(0); PG8_MMA(0, 0, At, B0); PG8_BAR; PG8_SCHED;
            PG8_LDB(B1, 1, 1); PG8_STAGE(PG8_SB(1, 0), b3, voffB);
            PG8_BAR; PG8_WAIT_L(0); PG8_MMA(0, 1, At, B1); PG8_BAR;
            PG8_LDA(At, 1, 1); PG8_STAGE(PG8_SA(1, 0), a3, voffA);
            PG8_BAR; PG8_WAIT_L(0); PG8_MMA(1, 0, At, B0); PG8_BAR; PG8_SCHED;
            PG8_STAGE(PG8_SB(1, 1), b3 + hstep, voffB);
            PG8_WAIT_V(6); PG8_BAR; PG8_MMA(1, 1, At, B1); PG8_BAR;
        }
        PG8_STAMP();
        if constexpr (!Epi::AFTER_DRAIN) { E(acc, cur, wr, wc, fr, fq); S.done(cur); }
        PG8_STAMP();
        if (!has_next) break;
#pragma unroll
        for (int a = 0; a < 2; ++a)
#pragma unroll
            for (int b = 0; b < 2; ++b)
#pragma unroll
                for (int m = 0; m < 4; ++m)
#pragma unroll
                    for (int n = 0; n < 2; ++n) acc[a][b][m][n] = (f32x4){0.f, 0.f, 0.f, 0.f};
        cur = nxt; cA = nA; cB = nB; ++ui;
    }
    PG8_WAIT_V(0);
    if (wr == 0) PG8_BAR;
    PG8_BAR;
    if constexpr (Epi::AFTER_DRAIN) { E.fused(acc, cur, wr, wc, fr, fq, lds, wid, lane); S.done(cur); }
    PG8_STAMP();
    if (STAMP && wid == 0) { stamps[lane] = lane < nts ? (((unsigned long long)(unsigned)ts_hi << 32) | (unsigned)ts_lo) : 0ull;
        if (lane == 62) stamps[62] = rt_entry; if (lane == 63) stamps[63] = (unsigned long long)wall_clock64(); }
#undef PG8_STAMP
#undef PG8_SA
#undef PG8_SB
#undef PG8_STAGE
#undef PG8_LDA
#undef PG8_LDB
#undef PG8_MMA
#undef PG8_WAIT_V
#undef PG8_WAIT_L
#undef PG8_BAR
#undef PG8_SCHED
}
}

struct EpiBf16Split {
  static constexpr bool PERM = true, AFTER_DRAIN = false;
  bfu* O1; int ld1; bfu* O2; int ld2; int split;
  DI void operator()(const f32x4 (&acc)[2][2][4][2], const pg8::Unit& u, int wr, int wc, int fr, int fq) const {
    const int row0 = u.pm * 256 + wr * 64 + fr;
    int colt = u.pn * 256; bfu* base = O1; int ld = ld1;
    if (colt >= split) { base = O2; ld = ld2; colt -= split; }
    const int col0 = colt + wc * 32 + 8 * fq;
#pragma unroll
    for (int ai = 0; ai < 2; ++ai)
#pragma unroll
      for (int m = 0; m < 4; ++m) {
        bfu* rowp = base + (size_t)(row0 + ai * 128 + m * 16) * ld + col0;
#pragma unroll
        for (int bj = 0; bj < 2; ++bj) {
          const f32x4 v0 = acc[ai][bj][m][0], v1 = acc[ai][bj][m][1];
          u32x4 o;
          o.x = pack2(v0[0], v0[1]); o.y = pack2(v0[2], v0[3]); o.z = pack2(v1[0], v1[1]); o.w = pack2(v1[2], v1[3]);
          *(u32x4*)(rowp + bj * 128) = o;
        }
      }
  }
};
struct EpiRes {
  static constexpr bool PERM = false, AFTER_DRAIN = false;
  const float* Xp; const float* Xs; float* Y;
  DI void operator()(const f32x4 (&acc)[2][2][4][2], const pg8::Unit& u, int wr, int wc, int fr, int fq) const {
    const int row0 = u.pm * 256 + wr * 64 + fr, col0 = u.pn * 256 + wc * 32 + 4 * fq;
    const float* xb = (u.pm * 256 < M_P) ? Xp : Xs - (size_t)M_P * DM;
#pragma unroll
    for (int ai = 0; ai < 2; ++ai)
#pragma unroll
      for (int m = 0; m < 4; ++m) {
        const size_t ro = (size_t)(row0 + ai * 128 + m * 16) * DM + col0;
#pragma unroll
        for (int bj = 0; bj < 2; ++bj)
#pragma unroll
          for (int n = 0; n < 2; ++n) {
            const f32x4 xv = *(const f32x4*)(xb + ro + bj * 128 + n * 16);
            *(f32x4*)(Y + ro + bj * 128 + n * 16) = xv * DN_ALPHA + acc[ai][bj][m][n];
          }
      }
  }
};
struct EpiResB {
  static constexpr bool PERM = false, AFTER_DRAIN = false;
  const bfu* Xb; float* Y;
  DI void operator()(const f32x4 (&acc)[2][2][4][2], const pg8::Unit& u, int wr, int wc, int fr, int fq) const {
    const int row0 = u.pm * 256 + wr * 64 + fr, col0 = u.pn * 256 + wc * 32 + 4 * fq;
#pragma unroll
    for (int ai = 0; ai < 2; ++ai)
#pragma unroll
      for (int m = 0; m < 4; ++m) {
        const size_t ro = (size_t)(row0 + ai * 128 + m * 16) * DM + col0;
#pragma unroll
        for (int bj = 0; bj < 2; ++bj)
#pragma unroll
          for (int n = 0; n < 2; ++n) {
            const uint2 xq = *(const uint2*)(Xb + ro + bj * 128 + n * 16);
            const f32x4 xv = f32x4{lo_bf(xq.x), hi_bf(xq.x), lo_bf(xq.y), hi_bf(xq.y)};
            *(f32x4*)(Y + ro + bj * 128 + n * 16) = xv * DN_ALPHA + acc[ai][bj][m][n];
          }
      }
  }
};
struct EpiResO {
  static constexpr bool PERM = true, AFTER_DRAIN = false;
  const float* Xp; const float* Xs; bfu* Y;
  DI void operator()(const f32x4 (&acc)[2][2][4][2], const pg8::Unit& u, int wr, int wc, int fr, int fq) const {
    const int row0 = u.pm * 256 + wr * 64 + fr, col0 = u.pn * 256 + wc * 32 + 8 * fq;
    const float* xb = (u.pm * 256 < M_P) ? Xp : Xs - (size_t)M_P * DM;
#pragma unroll
    for (int ai = 0; ai < 2; ++ai)
#pragma unroll
      for (int m = 0; m < 4; ++m) {
        const size_t ro = (size_t)(row0 + ai * 128 + m * 16) * DM + col0;
#pragma unroll
        for (int bj = 0; bj < 2; ++bj) {
          const f32x4 x0 = *(const f32x4*)(xb + ro + bj * 128), x1 = *(const f32x4*)(xb + ro + bj * 128 + 4);
          const f32x4 v0 = x0 * DN_ALPHA + acc[ai][bj][m][0], v1 = x1 * DN_ALPHA + acc[ai][bj][m][1];
          u32x4 o;
          o.x = pack2(v0[0], v0[1]); o.y = pack2(v0[2], v0[3]); o.z = pack2(v1[0], v1[1]); o.w = pack2(v1[2], v1[3]);
          *(u32x4*)(Y + ro + bj * 128) = o;
        }
      }
  }
};
struct EpiResD {
  static constexpr bool PERM = true, AFTER_DRAIN = false;
  const bfu* Xb; bfu* Y;
  DI void operator()(const f32x4 (&acc)[2][2][4][2], const pg8::Unit& u, int wr, int wc, int fr, int fq) const {
    const int row0 = u.pm * 256 + wr * 64 + fr, col0 = u.pn * 256 + wc * 32 + 8 * fq;
#pragma unroll
    for (int ai = 0; ai < 2; ++ai)
#pragma unroll
      for (int m = 0; m < 4; ++m) {
        const size_t ro = (size_t)(row0 + ai * 128 + m * 16) * DM + col0;
#pragma unroll
        for (int bj = 0; bj < 2; ++bj) {
          const u32x4 xq = *(const u32x4*)(Xb + ro + bj * 128);
          const f32x4 a0 = acc[ai][bj][m][0], a1 = acc[ai][bj][m][1];
          u32x4 o;
          o.x = pack2(lo_bf(xq.x) * DN_ALPHA + a0[0], hi_bf(xq.x) * DN_ALPHA + a0[1]);
          o.y = pack2(lo_bf(xq.y) * DN_ALPHA + a0[2], hi_bf(xq.y) * DN_ALPHA + a0[3]);
          o.z = pack2(lo_bf(xq.z) * DN_ALPHA + a1[0], hi_bf(xq.z) * DN_ALPHA + a1[1]);
          o.w = pack2(lo_bf(xq.w) * DN_ALPHA + a1[2], hi_bf(xq.w) * DN_ALPHA + a1[3]);
          *(u32x4*)(Y + ro + bj * 128) = o;
        }
      }
  }
};
#define FFN_HG(P) ((bfu*)((P).out + (size_t)M_TOK * 512))
#define FFN_HU(P) (FFN_HG(P) + (size_t)272 * 4 * DFF)
struct EpiFfn {
  static constexpr bool PERM = true, AFTER_DRAIN = false;
  bfu* gu; bfu* hg; bfu* hu; const float* cw; const float* cb; float* ostate;
  DI void operator()(const f32x4 (&acc)[2][2][4][2], const pg8::Unit& u, int wr, int wc, int fr, int fq) const {
    const int lane = (int)(threadIdx.x & 63u);
    const int cgl = u.pn * 128 + wc * 32 + 8 * fq;
    const int rowb = u.pm * 256 + wr * 64 + fr;
    if (u.pm >= 64) {
#pragma unroll
      for (int ai = 0; ai < 2; ++ai)
#pragma unroll
        for (int m = 0; m < 4; ++m) {
          bfu* rp = gu + (size_t)(rowb + ai * 128 + m * 16) * (2 * DFF) + cgl;
#pragma unroll
          for (int bj = 0; bj < 2; ++bj) {
            const f32x4 v0 = acc[ai][bj][m][0], v1 = acc[ai][bj][m][1];
            u32x4 o;
            o.x = pack2(v0[0], v0[1]); o.y = pack2(v0[2], v0[3]); o.z = pack2(v1[0], v1[1]); o.w = pack2(v1[2], v1[3]);
            *(u32x4*)(rp + bj * DFF) = o;
          }
        }
      return;
    }
#pragma unroll
    for (int n = 0; n < 2; ++n) {
      const int cc = cgl + 4 * n;
      const f32x4 w0 = *(const f32x4*)(cw + cc), w1 = *(const f32x4*)(cw + DFF + cc), w2 = *(const f32x4*)(cw + 2 * DFF + cc);
      const f32x4 fb = *(const f32x4*)(cb + cc);
#pragma unroll
      for (int ai = 0; ai < 2; ++ai) {
        unsigned gpx = 0u, gpy = 0u;
#pragma unroll
        for (int m = 0; m < 4; ++m) {
          const int r = rowb + ai * 128 + m * 16;
          const int slab = u.pm * 4 + ai * 2 + wr;
          const f32x4 g = acc[ai][0][m][n];
          const unsigned gx = pack2(g[0], g[1]), gy = pack2(g[2], g[3]);
          const unsigned s1x = fr == 15 ? gpx : gx, s1y = fr == 15 ? gpy : gy;
          const unsigned s2x = fr >= 14 ? gpx : gx, s2y = fr >= 14 ? gpy : gy;
          const unsigned p1x = (unsigned)__builtin_amdgcn_update_dpp(0, (int)s1x, 0x121, 0xf, 0xf, false);
          const unsigned p1y = (unsigned)__builtin_amdgcn_update_dpp(0, (int)s1y, 0x121, 0xf, 0xf, false);
          const unsigned p2x = (unsigned)__builtin_amdgcn_update_dpp(0, (int)s2x, 0x122, 0xf, 0xf, false);
          const unsigned p2y = (unsigned)__builtin_amdgcn_update_dpp(0, (int)s2y, 0x122, 0xf, 0xf, false);
          const f32x4 gc = f32x4{lo_bf(gx), hi_bf(gx), lo_bf(gy), hi_bf(gy)};
          const f32x4 g1 = f32x4{lo_bf(p1x), hi_bf(p1x), lo_bf(p1y), hi_bf(p1y)};
          const f32x4 g2 = f32x4{lo_bf(p2x), hi_bf(p2x), lo_bf(p2y), hi_bf(p2y)};
          const f32x4 up = acc[ai][1][m][n];
          const f32x4 a = w0 * g2 + w1 * g1 + w2 * gc + fb;
          f32x4 hh;
#pragma unroll
          for (int e = 0; e < 4; ++e) hh[e] = siluf_(a[e]) * up[e];
          if (m > 0 || fr >= 2) store_bf4(gu + (size_t)r * (2 * DFF) + DFF + cc, hh);
          if (m == 3 && fr >= 14) {
            *(uint2*)(hg + ((size_t)slab * 4 + (fr - 14)) * DFF + cc) = uint2{gx, gy};
            if ((u.pm & 7) == 7 && ai == 1 && wr == 1)
              *(f32x4*)(ostate + (size_t)(u.pm >> 3) * 2 * DFF + (size_t)(fr - 14) * DFF + cc) = gc;
          }
          if (m == 0 && fr < 2) {
            *(uint2*)(hg + ((size_t)slab * 4 + 2 + fr) * DFF + cc) = uint2{gx, gy};
            store_bf4(hu + ((size_t)slab * 2 + fr) * DFF + cc, up);
          }
          gpx = gx;
          gpy = gy;
        }
      }
    }
  }
};
struct EpiFin {
  static constexpr bool PERM = false, AFTER_DRAIN = false;
  const bfu* x2; const bfu* ep; const float* rinv; const float* pg; float* y;
  DI void operator()(const f32x4 (&acc)[2][2][4][2], const pg8::Unit& u, int wr, int wc, int fr, int fq) const {
    const int row0 = u.pm * 256 + wr * 64 + fr, col0 = u.pn * 256 + wc * 32 + 4 * fq;
#pragma unroll
    for (int ai = 0; ai < 2; ++ai)
#pragma unroll
      for (int m = 0; m < 4; ++m) {
        const int r = row0 + ai * 128 + m * 16;
        const size_t ro = (size_t)r * DM + col0;
        const float ri = rinv[r];
#pragma unroll
        for (int bj = 0; bj < 2; ++bj)
#pragma unroll
          for (int n = 0; n < 2; ++n) {
            const int co = bj * 128 + n * 16;
            const uint2 xq = *(const uint2*)(x2 + ro + co);
            const f32x4 xv = f32x4{lo_bf(xq.x), hi_bf(xq.x), lo_bf(xq.y), hi_bf(xq.y)};
            const uint2 eq = *(const uint2*)(ep + ro + co);
            const f32x4 gv = *(const f32x4*)(pg + col0 + co);
            const f32x4 a = acc[ai][bj][m][n];
            f32x4 o;
            o[0] = xv[0] + sigmoidf_(a[0]) * (lo_bf(eq.x) * ri * gv[0]);
            o[1] = xv[1] + sigmoidf_(a[1]) * (hi_bf(eq.x) * ri * gv[1]);
            o[2] = xv[2] + sigmoidf_(a[2]) * (lo_bf(eq.y) * ri * gv[2]);
            o[3] = xv[3] + sigmoidf_(a[3]) * (hi_bf(eq.y) * ri * gv[3]);
            *(f32x4*)(y + ro + co) = o;
          }
      }
  }
};
struct SplitOrder {
  int c;
  DI bool next(int i, pg8::Unit& u) const {
    if (i > 0 || c >= 64) return false;
    u.pm = 64 + (c >> 4); u.pn = (c >> 2) & 3;
    return true;
  }
  DI void a_ready(const pg8::Unit&) const {}
  DI void done(const pg8::Unit&) const {}
};
struct EpiSlab {
  static constexpr bool PERM = false, AFTER_DRAIN = false;
  float* slab;
  DI void operator()(const f32x4 (&acc)[2][2][4][2], const pg8::Unit& u, int wr, int wc, int fr, int fq) const {
    const int row0 = (u.pm - 64) * 256 + wr * 64 + fr, col0 = u.pn * 256 + wc * 32 + 4 * fq;
#pragma unroll
    for (int ai = 0; ai < 2; ++ai)
#pragma unroll
      for (int m = 0; m < 4; ++m) {
        float* rp = slab + (size_t)(row0 + ai * 128 + m * 16) * DM + col0;
#pragma unroll
        for (int bj = 0; bj < 2; ++bj)
#pragma unroll
          for (int n = 0; n < 2; ++n) *(f32x4*)(rp + bj * 128 + n * 16) = acc[ai][bj][m][n];
      }
  }
};
DI void run_split(PG8_LAS unsigned char* lds, const bfu* A, int lda, const bfu* Bt, int K, float* slabs) {
  const int c = (int)blockIdx.x;
  if (c >= 64) return;
  const int kp = c & 3;
  int koff, kl;
  if (K == 1024) { koff = kp * 256; kl = 256; }
  else { koff = kp < 2 ? kp * 768 : 1536 + (kp - 2) * 640; kl = kp < 2 ? 768 : 640; }
  pg8::Gemm g{A + koff, Bt + koff, M_TOK, DM, kl, lda, K};
  SplitOrder S{c};
  EpiSlab E{slabs + (size_t)kp * 1024 * 1024};
  pg8::gemm_phase<EpiSlab, SplitOrder, false>(lds, g, S, E, nullptr);
}

template <class Epi>
DI void run_pg8(PG8_LAS unsigned char* lds, const bfu* A, int lda, const bfu* Bt, int M, int N, int K, const Epi& E) {
  pg8::Gemm g{A, Bt, M, N, K, lda, K};
  pg8::StaticOrder S;
  S.init(M, N, (int)gridDim.x, (int)blockIdx.x);
  pg8::gemm_phase<Epi, pg8::StaticOrder, false>(lds, g, S, E, nullptr);
}

enum {
  PH_WT = 0,
  PH_GEMM_IN,
  PH_LORAIN,
  PH_LORA,
  PH_PREPA,
  PH_PREPB,
  PH_D1,
  PH_SCAN,
  PH_POST,
  PH_GEMM_O,
  PH_LN1,
  PH_GEMM_UP,
  PH_FFNCONV,
  PH_GEMM_DOWN,
  PH_LN2_PLE,
  PH_RINV,
  PH_GEMM_FIN,
  PH_FINS,
  PH_COUNT
};

constexpr int MT = M_TOK / 128;

__host__ __device__ constexpr int units_of(int ph, int wd_tiles) {
  return ph == PH_WT ? wd_tiles + M_TOK / 4
       : ph == PH_LORAIN ? (M_TOK / 64 + M_TOK / 16 + NSEQ)
       : ph == PH_LORA ? MT * 4 * 3
       : ph == PH_PREPA ? M_TOK / 16
       : ph == PH_PREPB ? (M_TOK / 8) * 3 / 4
       : ph == PH_D1 ? 1024
       : ph == PH_SCAN ? 2 * (256 + 1024)
       : ph == PH_POST ? M_TOK / 8
       : ph == PH_LN1 ? M_TOK / 8
       : ph == PH_FFNCONV ? (352 + 176)
       : ph == PH_LN2_PLE ? M_TOK / 8
       : ph == PH_RINV ? M_TOK / 16
       : ph == PH_FINS ? 256
       : 0;
}

DI void ph_wt(const Params& P, int u, char* smem) {
  if (u >= P.wd_tiles) {
    const int lane = VT & 63, wave = VT >> 6;
    const int m = (u - P.wd_tiles) * 4 + wave;
    const float* xr = (m < M_P) ? P.x_p + (size_t)m * DM : P.x_s + (size_t)(m - M_P) * DM;
    const float* pr = (m < M_P) ? P.p_p + (size_t)m * PLE : P.p_s + (size_t)(m - M_P) * PLE;
    f32x4 v[4];
#pragma unroll
    for (int i = 0; i < 4; ++i) v[i] = *(const f32x4*)(xr + i * 256 + lane * 4);
    const f32x4 pv = *(const f32x4*)(pr + lane * 4);
    bfu* xb = (bfu*)(P.ws + OFF_XB) + (size_t)m * DM;
#pragma unroll
    for (int i = 0; i < 4; ++i) store_bf4(xb + i * 256 + lane * 4, v[i]);
    store_bf4((bfu*)(P.ws + OFF_PB) + (size_t)m * PLE + lane * 4, pv);
    return;
  }
  int wi = 0;
#pragma unroll
  for (int i = 1; i < 9; ++i)
    if (u >= P.wd[i].t0) wi = i;
  const float* src = P.wd[wi].src;
  bfu* dst = P.wd[wi].dst;
  const int K = P.wd[wi].K, N = P.wd[wi].N;
  int tl = u - P.wd[wi].t0;
  const int kts = K >> 6;
  const int nt = tl / kts, kt = tl - nt * kts;
  const int n0 = nt * 64, k0 = kt * 64;
  int drow0 = n0;
  if (wi == 5) {
    const int nn = n0 < DFF ? n0 : n0 - DFF;
    drow0 = (nn >> 7) * 256 + (n0 < DFF ? 0 : 128) + (nn & 127);
  }
  float* tile = (float*)smem;
  const int tid = VT;
#pragma unroll
  for (int i = 0; i < 4; ++i) {
    const int kr = (tid >> 4) + 16 * i, c4 = (tid & 15) * 4;
    f32x4 v = f32x4{0.f, 0.f, 0.f, 0.f};
    if (n0 + c4 + 3 < N) v = *(const f32x4*)(src + (size_t)(k0 + kr) * N + n0 + c4);
    tile[kr * 65 + c4 + 0] = v[0];
    tile[kr * 65 + c4 + 1] = v[1];
    tile[kr * 65 + c4 + 2] = v[2];
    tile[kr * 65 + c4 + 3] = v[3];
  }
  __syncthreads();
#pragma unroll
  for (int j = 0; j < 2; ++j) {
    const int nr = (tid >> 3) + 32 * j, kc = (tid & 7) * 8;
    float f[8];
#pragma unroll
    for (int e = 0; e < 8; ++e) f[e] = tile[(kc + e) * 65 + nr];
    *(u32x4*)(dst + (size_t)(drow0 + nr) * K + k0 + kc) = pack8(f);
  }
  __syncthreads();
}

DI void ph_lorain(const Params& P, int u, char* smem) {
  const bfu* projA = (const bfu*)(P.ws + OFF_PROJA);
  const int tid = VT;
  if (u < M_TOK / 64) {
    const int lane = tid & 63, wave = tid >> 6;
    const int r0 = (u * 4 + wave) * 16;
    const bfu* ap = (const bfu*)(P.ws + OFF_XB) + (size_t)(r0 + (lane & 15)) * DM + (lane >> 4) * 8;
    const bfu* bp = (const bfu*)(P.ws + WT_IN) + (size_t)(3840 + (lane & 15)) * DM + (lane >> 4) * 8;
    f32x4 acc = f32x4{0.f, 0.f, 0.f, 0.f};
#pragma unroll 8
    for (int ks = 0; ks < 32; ++ks) {
      const bf16x8 af = *(const bf16x8*)(ap + ks * 32);
      const bf16x8 bf = *(const bf16x8*)(bp + ks * 32);
      acc = __builtin_amdgcn_mfma_f32_16x16x32_bf16(af, bf, acc, 0, 0, 0);
    }
    if ((lane & 15) < 8) {
      float* ba = (float*)(P.ws + OFF_BA);
#pragma unroll
      for (int j = 0; j < 4; ++j) ba[(size_t)(r0 + (lane >> 4) * 4 + j) * 8 + (lane & 15)] = acc[j];
    }
    return;
  }
  u -= M_TOK / 64;
  if (u < M_TOK / 16) {
    bfu* lin = (bfu*)(P.ws + OFF_LORAIN);
    const int lane = tid & 63, wave = tid >> 6;
    const int cg = lane & 31, sub = lane >> 5;
    const int mb = u * 16 + wave * 4 + sub * 2;
    const int col = 1536 + cg * 8;
    float mu[8];
    load8f(P.a_mu + col, mu);
    const int t0 = t_of_row(mb);
    u32x4 rows[3];
    if (t0 != 0) rows[0] = *(const u32x4*)(projA + (size_t)(mb - 1) * ASW + col);
#pragma unroll
    for (int i = 0; i < 2; ++i) rows[i + 1] = *(const u32x4*)(projA + (size_t)(mb + i) * ASW + col);
    float prev[8];
    if (t0 != 0) unpack8(rows[0], prev);
    else {
      const int s = seq_of_row(mb);
      if (s < 8) {
#pragma unroll
        for (int e = 0; e < 8; ++e) prev[e] = 0.f;
      } else load8f(P.st_shift + (size_t)(s - 8) * ASW + col, prev);
    }
#pragma unroll
    for (int i = 0; i < 2; ++i) {
      float uc[8], o[8];
      unpack8(rows[i + 1], uc);
#pragma unroll
      for (int e = 0; e < 8; ++e) {
        float xs = uc[e] + (prev[e] - uc[e]) * mu[e];
        o[e] = (cg < 8) ? tanhf(xs) : (cg < 16 ? xs : sigmoidf_(xs));
        prev[e] = uc[e];
      }
      *(u32x4*)(lin + (size_t)(mb + i) * 256 + cg * 8) = pack8(o);
    }
  } else {
    const int s = u - M_TOK / 16;
    const int row0 = row0_of_seq(s), T = T_of_seq(s);
    const bfu* projB = (const bfu*)P.out;
    float* oshift = P.out + (s < 8 ? O_PA_SHIFT + (size_t)s * ASW : O_SA_SHIFT + (size_t)(s - 8) * ASW);
    for (int i = tid; i < ASW; i += 256) oshift[i] = bf2f(projA[(size_t)(row0 + T - 1) * ASW + i]);
    float* oconv = P.out + (s < 8 ? O_PB_CONV + (size_t)s * 3 * BQKV : O_SB_CONV + (size_t)(s - 8) * 3 * BQKV);
    for (int i = tid; i < 3 * BQKV; i += 256) {
      int j = i / BQKV, c = i - j * BQKV;
      oconv[i] = bf2f(projB[(size_t)(row0 + T - 3 + j) * PB_W + c]);
    }
  }
}

DI void ph_lora(const Params& P, int u, char* smem) {
  const int which = u / (MT * 4);
  const int r = u - which * (MT * 4);
  const int mt = r >> 2, nt = r & 3;
  const int m0 = mt * 128, n0 = nt * 128;
  const bfu* lin = (const bfu*)(P.ws + OFF_LORAIN);
  if (which == 0) {
    bfu* stream = (bfu*)(P.ws + OFF_STREAM);
    const float* w0 = P.a_w0;
    gemm_tile<false>(lin + (size_t)m0 * 256, 256, (const bfu*)(P.ws + WT_W2) + (size_t)n0 * 64, 64, m0, n0,
                     (bfu*)smem, [&](int m, int n, f32x4 v) {
                       f32x4 e;
#pragma unroll
                       for (int j = 0; j < 4; ++j) {
                         float w = -softplusf_(-(w0[n + j] + v[j])) - 0.5f;
                         e[j] = __expf(w);
                       }
                       store_bf4(stream + ((size_t)(m * 8 + (n >> 6)) * 6 + 1) * 64 + (n & 63), e);
                     });
  } else if (which == 1) {
    bfu* abuf = (bfu*)(P.ws + OFF_ABUF);
    const float* a0 = P.a_a0;
    gemm_tile<false>(lin + (size_t)m0 * 256 + 64, 256, (const bfu*)(P.ws + WT_A2) + (size_t)n0 * 64, 64, m0, n0,
                     (bfu*)smem, [&](int m, int n, f32x4 v) {
                       f32x4 e;
#pragma unroll
                       for (int j = 0; j < 4; ++j) e[j] = sigmoidf_(a0[n + j] + v[j]);
                       store_bf4(abuf + (size_t)m * 512 + n, e);
                     });
  } else {
    bfu* gbuf = (bfu*)(P.ws + OFF_G);
    gemm_tile<false>(lin + (size_t)m0 * 256 + 128, 256, (const bfu*)(P.ws + WT_G2) + (size_t)n0 * 128, 128, m0, n0,
                     (bfu*)smem, [&](int m, int n, f32x4 v) { store_bf4(gbuf + (size_t)m * 512 + n, v); });
  }
}

DI void ph_prepa(const Params& P, int u, char* smem) {
  const int tid = VT, lane = tid & 63, wave = tid >> 6;
  const int h = lane >> 3, sub = lane & 7;
  const int ch = h * 64 + sub * 8;
  const int m0 = u * 16 + wave * 4;
  const bfu* projA = (const bfu*)(P.ws + OFF_PROJA);
  const bfu* abuf = (const bfu*)(P.ws + OFF_ABUF);
  bfu* stream = (bfu*)(P.ws + OFF_STREAM);
  float mu[3][8], kkc[8], kac[8], rkc[8];
#pragma unroll
  for (int p = 0; p < 3; ++p) load8f(P.a_mu + p * 512 + ch, mu[p]);
  load8f(P.a_k_k + ch, kkc);
  load8f(P.a_k_a + ch, kac);
  load8f(P.a_r_k + ch, rkc);
  float prev[3][8];
  const int t0 = t_of_row(m0);
  if (t0 != 0) {
#pragma unroll
    for (int p = 0; p < 3; ++p) unpack8(*(const u32x4*)(projA + (size_t)(m0 - 1) * ASW + p * 512 + ch), prev[p]);
  } else {
    const int s = seq_of_row(m0);
#pragma unroll
    for (int p = 0; p < 3; ++p) {
      if (s < 8) {
#pragma unroll
        for (int e = 0; e < 8; ++e) prev[p][e] = 0.f;
      } else load8f(P.st_shift + (size_t)(s - 8) * ASW + p * 512 + ch, prev[p]);
    }
  }
#pragma unroll
  for (int g = 0; g < 2; ++g) {
    u32x4 ur[2][3], ar[2];
#pragma unroll
    for (int i = 0; i < 2; ++i) {
      const int m = m0 + g * 2 + i;
#pragma unroll
      for (int p = 0; p < 3; ++p) ur[i][p] = *(const u32x4*)(projA + (size_t)m * ASW + p * 512 + ch);
      ar[i] = *(const u32x4*)(abuf + (size_t)m * 512 + ch);
    }
#pragma unroll
    for (int i = 0; i < 2; ++i) {
      const int m = m0 + g * 2 + i;
      float xs[3][8], a[8];
#pragma unroll
      for (int p = 0; p < 3; ++p) {
        float uc[8];
        unpack8(ur[i][p], uc);
#pragma unroll
        for (int e = 0; e < 8; ++e) {
          xs[p][e] = uc[e] + (prev[p][e] - uc[e]) * mu[p][e];
          prev[p][e] = uc[e];
        }
      }
      unpack8(ar[i], a);
      float kkr[8], k2[8], bb[8];
      float ssl = 0.f, bl = 0.f;
#pragma unroll
      for (int e = 0; e < 8; ++e) {
        kkr[e] = xs[1][e] * kkc[e];
        ssl += kkr[e] * kkr[e];
        k2[e] = xs[1][e] * (1.f + (a[e] - 1.f) * kac[e]);
        bl += xs[0][e] * k2[e] * rkc[e];
      }
      const float rinv = rsqrtf(sum8(ssl) + L2_EPS);
      const float bonus = sum8(bl);
#pragma unroll
      for (int e = 0; e < 8; ++e) {
        kkr[e] *= rinv;
        bb[e] = kkr[e] * a[e];
      }
      bfu* sp = stream + (size_t)(m * 8 + h) * 384 + sub * 8;
      *(u32x4*)(sp) = pack8(xs[0]);
      *(u32x4*)(sp + 128) = pack8(k2);
      *(u32x4*)(sp + 192) = pack8(xs[2]);
      *(u32x4*)(sp + 256) = pack8(kkr);
      *(u32x4*)(sp + 320) = pack8(bb);
      if (sub == 0) ((float*)(P.ws + OFF_BONUS))[m * 8 + h] = bonus;
    }
  }
}

DI void ph_prepb(const Params& P, int u, char* smem) {
  const int tid = VT, lane = tid & 63, wave = tid >> 6;
  const int wt = u * 4 + wave;
  const int tg = wt / 3, p = wt - tg * 3;
  const int h = lane >> 4, sub = lane & 15;
  const int c = p * 512 + h * 128 + sub * 8;
  const int m0 = tg * 8;
  const int s = seq_of_row(m0), t0 = t_of_row(m0);
  const bfu* projB = (const bfu*)P.out;
  bfu* sb = (bfu*)(P.ws + OFF_STREAMB);
  u32x4 rq[11];
#pragma unroll
  for (int i = 0; i < 11; ++i)
    if (t0 + i - 3 >= 0) rq[i] = *(const u32x4*)(projB + (size_t)(m0 + i - 3) * PB_W + c);
  float cw[4][8];
#pragma unroll
  for (int j = 0; j < 4; ++j) load8f(P.b_conv_w + j * BQKV + c, cw[j]);
  float r0[8], r1[8], r2[8], r3[8];
  if (t0 >= 3) {
    unpack8(rq[0], r0);
    unpack8(rq[1], r1);
    unpack8(rq[2], r2);
  } else if (s >= 8) {
    load8f(P.st_bconv + ((size_t)(s - 8) * 3 + 0) * BQKV + c, r0);
    load8f(P.st_bconv + ((size_t)(s - 8) * 3 + 1) * BQKV + c, r1);
    load8f(P.st_bconv + ((size_t)(s - 8) * 3 + 2) * BQKV + c, r2);
  } else {
#pragma unroll
    for (int e = 0; e < 8; ++e) { r0[e] = 0.f; r1[e] = 0.f; r2[e] = 0.f; }
  }
  const float scale = (p == 0) ? 0.08838834764831845f : 1.f;
#pragma unroll
  for (int i = 0; i < 8; ++i) {
    unpack8(rq[i + 3], r3);
    float y[8];
    float ss = 0.f;
#pragma unroll
    for (int e = 0; e < 8; ++e) {
      float a = cw[0][e] * r0[e] + cw[1][e] * r1[e] + cw[2][e] * r2[e] + cw[3][e] * r3[e];
      y[e] = siluf_(a);
      ss += y[e] * y[e];
      r0[e] = r1[e];
      r1[e] = r2[e];
      r2[e] = r3[e];
    }
    if (p < 2) {
      const float rn = rsqrtf(row16_sum(ss) + L2_EPS) * scale;
#pragma unroll
      for (int e = 0; e < 8; ++e) y[e] *= rn;
    }
    *(u32x4*)(sb + (size_t)((m0 + i) * 4 + h) * 384 + p * 128 + sub * 8) = pack8(y);
  }
  if (p == 0 && lane < 32) {
    int i = lane >> 2, hh = lane & 3;
    const float* ba = (const float*)(P.ws + OFF_BA) + (size_t)(m0 + i) * 8;
    float beta = sigmoidf_(ba[hh]);
    float g = -__expf(P.b_a_log[hh]) * softplusf_(ba[4 + hh] + P.b_dt_bias[hh]);
    float* bg = (float*)(P.ws + OFF_BG) + (size_t)(m0 + i) * 8;
    bg[hh] = beta;
    bg[4 + hh] = __expf(g);
    ((float*)(P.ws + OFF_GG))[(size_t)(m0 + i) * 4 + hh] = g;
  }
}

constexpr int CH = 16;
DI void lds_barrier() {
  asm volatile("s_waitcnt lgkmcnt(0)" ::: "memory");
  __builtin_amdgcn_s_barrier();
  asm volatile("" ::: "memory");
}

DI void chunk_gload(u32x4 (&rg)[3], const bfu* base, size_t step_stride, int nsteps) {
#pragma unroll
  for (int j = 0; j < 3; ++j) {
    int idx = VT + 256 * j;
    int st = idx / 48, w = idx - st * 48;
    if (st < nsteps) rg[j] = *(const u32x4*)(base + (size_t)st * step_stride + w * 8);
  }
}
template <bool DECAY>
DI void chunk_lstore(const u32x4 (&rg)[3], float* buf, int nsteps) {
#pragma unroll
  for (int j = 0; j < 3; ++j) {
    int idx = VT + 256 * j;
    int st = idx / 48, w = idx - st * 48;
    if (st < nsteps) {
      float4 a, b;
      a.x = lo_bf(rg[j].x); a.y = hi_bf(rg[j].x); a.z = lo_bf(rg[j].y); a.w = hi_bf(rg[j].y);
      b.x = lo_bf(rg[j].z); b.y = hi_bf(rg[j].z); b.z = lo_bf(rg[j].w); b.w = hi_bf(rg[j].w);
      if (DECAY && (w >> 3) == 1) {
        a.x = __expf(-a.x); a.y = __expf(-a.y); a.z = __expf(-a.z); a.w = __expf(-a.w);
        b.x = __expf(-b.x); b.y = __expf(-b.y); b.z = __expf(-b.z); b.w = __expf(-b.w);
      }
      float* d = buf + st * 384 + w * 8;
      *(float4*)d = a;
      *(float4*)(d + 4) = b;
    }
  }
}

DI float dot4(f32x4 a, f32x4 b) {
  typedef float f2 __attribute__((ext_vector_type(2)));
  const f2 a01 = {a[0], a[1]}, a23 = {a[2], a[3]}, b01 = {b[0], b[1]}, b23 = {b[2], b[3]};
  const f2 t = a23 * b23 + a01 * b01;
  return t[0] + t[1];
}
template <int R> struct RwkvOps { f32x4 r4, w4, k4, kk4, b4; float vv[R]; };
template <int R>
DI void rwkv_ld(RwkvOps<R>& o, const float* b, int j0, int v) {
  o.r4 = *(const f32x4*)(b + j0);
  o.w4 = *(const f32x4*)(b + 64 + j0);
  o.k4 = *(const f32x4*)(b + 128 + j0);
#pragma unroll
  for (int r = 0; r < R; ++r) o.vv[r] = b[192 + v + r * 16];
  o.kk4 = *(const f32x4*)(b + 256 + j0);
  o.b4 = *(const f32x4*)(b + 320 + j0);
}
template <int NS, int R>
DI void rwkv_steps(const float* buf, f32x4 (&S)[R], int j0, int v, int l15, float (&oacc)[R], float* qp) {
  RwkvOps<R> ops[3];
  rwkv_ld<R>(ops[0], buf, j0, v);
  rwkv_ld<R>(ops[1], buf + 384, j0, v);
#pragma unroll
  for (int st = 0; st < NS; ++st) {
    if (st + 2 < NS) rwkv_ld<R>(ops[(st + 2) % 3], buf + (st + 2) * 384, j0, v);
    const RwkvOps<R>& o = ops[st % 3];
    float p[R], q[R];
#pragma unroll
    for (int r = 0; r < R; ++r) p[r] = dot4(S[r], o.kk4);
#pragma unroll
    for (int r = 0; r < R; ++r) p[r] = row16_sum(p[r]);
#pragma unroll
    for (int r = 0; r < R; ++r) {
      const f32x4 base = S[r] * o.w4 + o.k4 * o.vv[r];
      S[r] = base - o.b4 * p[r];
    }
#pragma unroll
    for (int r = 0; r < R; ++r) q[r] = dot4(S[r], o.r4);
    if constexpr (R == 1) {
      qp[st * 64] = q[0];
    } else {
#pragma unroll
      for (int r = 0; r < R; ++r) {
        q[r] = row16_sum(q[r]);
        oacc[r] = (l15 == st) ? q[r] : oacc[r];
      }
    }
  }
  if constexpr (R == 1) {
    asm volatile("" ::: "memory");
    const float* qr = qp + l15 * 64 - l15;
    const f32x4 a = *(const f32x4*)(qr), b = *(const f32x4*)(qr + 4), c = *(const f32x4*)(qr + 8), d = *(const f32x4*)(qr + 12);
    const f32x4 s4 = (a + b) + (c + d);
    oacc[0] = (s4[0] + s4[1]) + (s4[2] + s4[3]);
    asm volatile("" ::: "memory");
  }
}

template <int R>
DI void rwkv_unit(const Params& P, int s, int h, int rgp, char* smem) {
  const int tid = VT, lane = tid & 63, wave = tid >> 6;
  const int T = T_of_seq(s), row0 = row0_of_seq(s);
  const int vl = wave * 4 + (lane >> 4);
  const int v = rgp * (16 * R) + vl;
  const int l15 = lane & 15;
  const int j0 = l15 * 4;
  float* buf0 = (float*)smem;
  float* qp = buf0 + 2 * CH * 384 + wave * (CH * 64) + lane;
  f32x4 S[R];
#pragma unroll
  for (int r = 0; r < R; ++r) {
    if (s < 8) S[r] = f32x4{0.f, 0.f, 0.f, 0.f};
    else S[r] = *(const f32x4*)(P.st_wkv + (((size_t)(s - 8) * 8 + h) * 64 + v + r * 16) * 64 + j0);
  }
  const bfu* stream = (const bfu*)(P.ws + OFF_STREAM) + ((size_t)row0 * 8 + h) * 384;
  const size_t sstride = 8 * 384;
  bfu* omix = (bfu*)(P.ws + OFF_OMIX) + (size_t)row0 * 1024 + h * 64 + v;
  const int nch = (T + CH - 1) / CH;
  u32x4 rg[3], rgB[3], rgC[3];
  chunk_gload(rg, stream, sstride, min(CH, T));
  chunk_lstore<true>(rg, buf0, min(CH, T));
  __syncthreads();
  if (nch > 1) chunk_gload(rg, stream + (size_t)1 * CH * sstride, sstride, min(CH, T - 1 * CH));
  if (nch > 2) chunk_gload(rgB, stream + (size_t)2 * CH * sstride, sstride, min(CH, T - 2 * CH));
  if (nch > 3) chunk_gload(rgC, stream + (size_t)3 * CH * sstride, sstride, min(CH, T - 3 * CH));
  if (R == 1) __builtin_amdgcn_s_setprio(3);
  for (int c = 0; c < nch; ++c) {
    const int nsteps = min(CH, T - c * CH);
    const int nnext = (c + 1 < nch) ? min(CH, T - (c + 1) * CH) : 0;
    const float* buf = buf0 + (c & 1) * CH * 384;
    float oacc[R];
#pragma unroll
    for (int r = 0; r < R; ++r) oacc[r] = 0.f;
    if (nsteps == CH) rwkv_steps<CH, R>(buf, S, j0, v, l15, oacc, qp);
    else rwkv_steps<8, R>(buf, S, j0, v, l15, oacc, qp);
    if (l15 < nsteps) {
#pragma unroll
      for (int r = 0; r < R; ++r) omix[(size_t)(c * CH + l15) * 1024 + r * 16] = f2bf(oacc[r]);
    }
    if (nnext > 0) chunk_lstore<true>(rg, buf0 + ((c + 1) & 1) * CH * 384, nnext);
#pragma unroll
    for (int j = 0; j < 3; ++j) { rg[j] = rgB[j]; rgB[j] = rgC[j]; }
    if (c + 4 < nch) chunk_gload(rgC, stream + (size_t)(c + 4) * CH * sstride, sstride, min(CH, T - (c + 4) * CH));
    lds_barrier();
  }
  if (R == 1) __builtin_amdgcn_s_setprio(0);
  float* o = P.out + (s < 8 ? O_PA_WKV + (((size_t)s * 8 + h) * 64 + v) * 64 + j0
                            : O_SA_WKV + (((size_t)(s - 8) * 8 + h) * 64 + v) * 64 + j0);
#pragma unroll
  for (int r = 0; r < R; ++r) *(f32x4*)(o + (size_t)r * 16 * 64) = S[r];
}

template <int R> struct DeltaOps { f32x4 q0, q1, k0, k1; float vv[R], beta, alpha; };
template <int R>
DI void delta_ld(DeltaOps<R>& o, const float* b, const float* bg, int j0, int c) {
  o.q0 = *(const f32x4*)(b + j0);
  o.q1 = *(const f32x4*)(b + 64 + j0);
  o.k0 = *(const f32x4*)(b + 128 + j0);
  o.k1 = *(const f32x4*)(b + 192 + j0);
#pragma unroll
  for (int r = 0; r < R; ++r) o.vv[r] = b[256 + c + r * 16];
  o.beta = bg[0];
  o.alpha = bg[1];
}
template <int NS, int R>
DI void delta_steps(const float* buf, const float* bgc, f32x4 (&S0)[R], f32x4 (&S1)[R], int j0, int c, int l15,
                    float (&oacc)[R]) {
  DeltaOps<R> ops[3];
  delta_ld<R>(ops[0], buf, bgc, j0, c);
  delta_ld<R>(ops[1], buf + 384, bgc + 2, j0, c);
#pragma unroll
  for (int st = 0; st < NS; ++st) {
    if (st + 2 < NS) delta_ld<R>(ops[(st + 2) % 3], buf + (st + 2) * 384, bgc + (st + 2) * 2, j0, c);
    const DeltaOps<R>& o = ops[st % 3];
    float p[R], q[R];
#pragma unroll
    for (int r = 0; r < R; ++r) {
      const f32x4 t0 = S0[r] * o.k0 + S1[r] * o.k1;
      p[r] = (t0[0] + t0[1]) + (t0[2] + t0[3]);
    }
#pragma unroll
    for (int r = 0; r < R; ++r) p[r] = row16_sum(p[r]);
#pragma unroll
    for (int r = 0; r < R; ++r) {
      const float vn = o.beta * (o.vv[r] - o.alpha * p[r]);
      S0[r] = S0[r] * o.alpha + o.k0 * vn;
      S1[r] = S1[r] * o.alpha + o.k1 * vn;
      const f32x4 t1 = S0[r] * o.q0 + S1[r] * o.q1;
      q[r] = (t1[0] + t1[1]) + (t1[2] + t1[3]);
    }
#pragma unroll
    for (int r = 0; r < R; ++r) {
      q[r] = row16_sum(q[r]);
      oacc[r] = (l15 == st) ? q[r] : oacc[r];
    }
  }
}

template <int R>
DI void delta_unit(const Params& P, int s, int h, int cg_, char* smem) {
  const int tid = VT, lane = tid & 63, wave = tid >> 6;
  const int T = T_of_seq(s), row0 = row0_of_seq(s);
  const int cl = wave * 4 + (lane >> 4);
  const int c = cg_ * (16 * R) + cl;
  const int l15 = lane & 15;
  const int j0 = l15 * 4;
  float* buf0 = (float*)smem;
  float* bgb = buf0 + 2 * CH * 384;
  f32x4 S0[R], S1[R];
#pragma unroll
  for (int r = 0; r < R; ++r) {
    if (s < 8) {
      S0[r] = f32x4{0.f, 0.f, 0.f, 0.f};
      S1[r] = S0[r];
    } else {
      const float* sp = P.st_ssm + (((size_t)(s - 8) * 4 + h) * 128 + j0) * 128 + c + r * 16;
#pragma unroll
      for (int i = 0; i < 4; ++i) { S0[r][i] = sp[(size_t)i * 128]; S1[r][i] = sp[(size_t)(i + 64) * 128]; }
    }
  }
  const bfu* stream = (const bfu*)(P.ws + OFF_STREAMB) + ((size_t)row0 * 4 + h) * 384;
  const size_t sstride = 4 * 384;
  const float* bg = (const float*)(P.ws + OFF_BG);
  bfu* omix = (bfu*)(P.ws + OFF_OMIX) + (size_t)row0 * 1024 + 512 + h * 128 + c;
  const int nch = (T + CH - 1) / CH;
  u32x4 rg[3];
  float bgr = 0.f;
  {
    int n0 = min(CH, T);
    chunk_gload(rg, stream, sstride, n0);
    if (tid < n0 * 2) bgr = bg[(size_t)(row0 + (tid >> 1)) * 8 + (tid & 1) * 4 + h];
    chunk_lstore<false>(rg, buf0, n0);
    if (tid < n0 * 2) bgb[tid] = bgr;
  }
  __syncthreads();
  for (int ci = 0; ci < nch; ++ci) {
    const int nsteps = min(CH, T - ci * CH);
    const int nnext = (ci + 1 < nch) ? min(CH, T - (ci + 1) * CH) : 0;
    if (nnext > 0) {
      chunk_gload(rg, stream + (size_t)(ci + 1) * CH * sstride, sstride, nnext);
      if (tid < nnext * 2) bgr = bg[(size_t)(row0 + (ci + 1) * CH + (tid >> 1)) * 8 + (tid & 1) * 4 + h];
    }
    const float* buf = buf0 + (ci & 1) * CH * 384;
    const float* bgc = bgb + (ci & 1) * CH * 2;
    float oacc[R];
#pragma unroll
    for (int r = 0; r < R; ++r) oacc[r] = 0.f;
    if (nsteps == CH) delta_steps<CH, R>(buf, bgc, S0, S1, j0, c, l15, oacc);
    else delta_steps<8, R>(buf, bgc, S0, S1, j0, c, l15, oacc);
    if (l15 < nsteps) {
#pragma unroll
      for (int r = 0; r < R; ++r) omix[(size_t)(ci * CH + l15) * 1024 + r * 16] = f2bf(oacc[r]);
    }
    if (nnext > 0) {
      chunk_lstore<false>(rg, buf0 + ((ci + 1) & 1) * CH * 384, nnext);
      if (tid < nnext * 2) bgb[((ci + 1) & 1) * CH * 2 + tid] = bgr;
    }
    lds_barrier();
  }
  float* o = P.out + (s < 8 ? O_PB_SSM + (((size_t)s * 4 + h) * 128 + j0) * 128 + c
                            : O_SB_SSM + (((size_t)(s - 8) * 4 + h) * 128 + j0) * 128 + c);
#pragma unroll
  for (int r = 0; r < R; ++r)
#pragma unroll
    for (int i = 0; i < 4; ++i) { o[(size_t)i * 128 + r * 16] = S0[r][i]; o[(size_t)(i + 64) * 128 + r * 16] = S1[r][i]; }
}

constexpr int DLD = 136;
template <int I> struct SubStep {
  static DI void run(float (&sol)[64], const float* Lm, const float* scp, const bfu* colp) {
    SubStep<I - 1>::run(sol, Lm, scp, colp);
    float a0 = bf2f(colp[I * 136]) * scp[I], a1 = 0.f;
#pragma unroll
    for (int j4 = 0; j4 < (I + 3) / 4; ++j4) {
      const f32x4 l = *(const f32x4*)(Lm + I * 68 + j4 * 4);
      if (j4 * 4 + 0 < I) a0 -= l[0] * sol[j4 * 4 + 0];
      if (j4 * 4 + 1 < I) a1 -= l[1] * sol[j4 * 4 + 1];
      if (j4 * 4 + 2 < I) a0 -= l[2] * sol[j4 * 4 + 2];
      if (j4 * 4 + 3 < I) a1 -= l[3] * sol[j4 * 4 + 3];
      if ((j4 & 7) == 7) { asm volatile("" ::: "memory"); __builtin_amdgcn_sched_barrier(0); }
    }
    sol[I] = a0 + a1;
    asm volatile("" ::: "memory");
    __builtin_amdgcn_sched_barrier(0);
  }
};
template <> struct SubStep<-1> {
  static DI void run(float (&)[64], const float*, const float*, const bfu*) {}
};

DI void delta_d1(const Params& P, int item, char* smem) {
  int tid_ = VT; asm volatile("" : "+v"(tid_));
  const int tid = tid_, lane = tid & 63, wave = tid >> 6;
  const int chunk = item & 31, h = (item >> 5) & 3, s = item >> 7;
  const int m0 = s * 2048 + chunk * 64;
  bfu* Qs = (bfu*)smem;
  bfu* Ks = Qs + 64 * DLD;
  bfu* Vs = Ks + 64 * DLD;
  float* Lm = (float*)(Vs + 64 * DLD);
  float* Gs = Lm + 64 * 68;
  float* Bs = Gs + 64;
  float* Bk = Bs + 64;
  bfu* sb = (bfu*)(P.ws + OFF_STREAMB);
  bfu* projB = (bfu*)P.out;
#pragma unroll
  for (int j = 0; j < 4; ++j) {
    const int idx = tid + 256 * j, row = idx >> 4, c8 = (idx & 15) * 8;
    const bfu* sp = sb + ((size_t)(m0 + row) * 4 + h) * 384 + c8;
    *(u32x4*)(Qs + row * DLD + c8) = *(const u32x4*)sp;
    *(u32x4*)(Ks + row * DLD + c8) = *(const u32x4*)(sp + 128);
    *(u32x4*)(Vs + row * DLD + c8) = *(const u32x4*)(sp + 256);
  }
  if (wave == 0) {
    float x = ((const float*)(P.ws + OFF_GG))[(size_t)(m0 + lane) * 4 + h];
#pragma unroll
    for (int off = 1; off < 64; off <<= 1) {
      const float y = __shfl_up(x, off, 64);
      if (lane >= off) x += y;
    }
    Gs[lane] = x;
    ((float*)(projB + (size_t)(m0 + lane) * PB_W + 768))[h] = x;
    const float be = ((const float*)(P.ws + OFF_BG))[(size_t)(m0 + lane) * 8 + h];
    Bs[lane] = be;
    Bk[lane] = be * __expf(x);
  }
  __syncthreads();
  {
#pragma unroll 1
    for (int nt = 0; nt < 4; ++nt) {
      f32x4 akk = f32x4{0.f, 0.f, 0.f, 0.f}, aqk = akk;
#pragma unroll
      for (int ks = 0; ks < 4; ++ks) {
        const int ko = ks * 32 + (lane >> 4) * 8;
        const bf16x8 ak = *(const bf16x8*)(Ks + (16 * wave + (lane & 15)) * DLD + ko);
        const bf16x8 aq = *(const bf16x8*)(Qs + (16 * wave + (lane & 15)) * DLD + ko);
        const bf16x8 b = *(const bf16x8*)(Ks + (16 * nt + (lane & 15)) * DLD + ko);
        akk = __builtin_amdgcn_mfma_f32_16x16x32_bf16(ak, b, akk, 0, 0, 0);
        aqk = __builtin_amdgcn_mfma_f32_16x16x32_bf16(aq, b, aqk, 0, 0, 0);
      }
#pragma unroll
      for (int j = 0; j < 4; ++j) {
        const int i = 16 * wave + (lane >> 4) * 4 + j, jj = 16 * nt + (lane & 15);
        const float e = __expf(fminf(Gs[i] - Gs[jj], 0.f));
        Lm[i * 68 + jj] = (jj < i) ? Bs[i] * akk[j] * e : 0.f;
        projB[(size_t)(m0 + i) * PB_W + 512 + h * 64 + jj] = f2bf((jj <= i) ? aqk[j] * e : 0.f);
      }
    }
  }
  __syncthreads();
  {
    const bool isv = tid < 128;
    const bfu* colp = isv ? Vs + tid : Ks + (tid - 128);
    float sol[64];
    SubStep<63>::run(sol, Lm, isv ? Bs : Bk, colp);
    __syncthreads();
    bfu* Ob = (bfu*)smem;
#pragma unroll
    for (int i = 0; i < 64; ++i) Ob[i * 264 + tid] = f2bf(sol[i]);
  }
  __syncthreads();
  {
    const bfu* Ob = (const bfu*)smem;
#pragma unroll
    for (int j = 0; j < 8; ++j) {
      const int idx = tid + 256 * j, row = idx >> 5, c8 = (idx & 31) * 8;
      const u32x4 v = *(const u32x4*)(Ob + row * 264 + c8);
      if (c8 < 128) *(u32x4*)(sb + ((size_t)(m0 + row) * 4 + h) * 384 + 256 + c8) = v;
      else *(u32x4*)(projB + (size_t)(m0 + row) * PB_W + h * 128 + (c8 - 128)) = v;
    }
  }
  __syncthreads();
}

DI void delta_d2(const Params& P, int s, int h, int cg_, char* smem) {
  int tid_ = VT; asm volatile("" : "+v"(tid_));
  const int tid = tid_, lane = tid & 63, wave = tid >> 6;
  const int r16 = lane & 15, q4 = lane >> 4;
  bfu* Ws = (bfu*)smem;
  bfu* Qs = Ws + 64 * DLD;
  bfu* KT = Qs + 64 * DLD;
  bfu* AT = KT + 128 * 72;
  bfu* VnT = AT + 64 * 72;
  bfu* ST = VnT + 16 * 72;
  float* Us = (float*)(ST + 16 * DLD);
  const int row0 = s * 2048, col0 = cg_ * 16;
  const bfu* sb = (const bfu*)(P.ws + OFF_STREAMB);
  const bfu* projB = (const bfu*)P.out;
  bfu* omix = (bfu*)(P.ws + OFF_OMIX);
  f32x4 accS[2];
  accS[0] = f32x4{0.f, 0.f, 0.f, 0.f};
  accS[1] = accS[0];
  for (int i = tid; i < 16 * DLD / 2; i += 256) ((unsigned*)ST)[i] = 0u;
  u32x4 rw[4], rq[4], rk[4], ra[2], ru;
  float gj[4], gk = 0.f, glast = 0.f, glcur = 0.f;
#define D2_PREFETCH(cc)                                                                                   \
  {                                                                                                       \
    const int mb = row0 + (cc) * 64;                                                                      \
    _Pragma("unroll") for (int j = 0; j < 4; ++j) {                                                       \
      const int idx = tid + 256 * j, row = idx >> 4, c8 = (idx & 15) * 8;                                 \
      const size_t m = (size_t)(mb + row);                                                                \
      rw[j] = *(const u32x4*)(projB + m * PB_W + h * 128 + c8);                                           \
      rq[j] = *(const u32x4*)(sb + (m * 4 + h) * 384 + c8);                                               \
      gj[j] = ((const float*)(projB + m * PB_W + 768))[h];                                                \
      rk[j] = *(const u32x4*)(sb + ((size_t)(mb + (tid & 63)) * 4 + h) * 384 + 128 + ((tid >> 6) + 4 * j) * 8); \
    }                                                                                                     \
    gk = ((const float*)(projB + (size_t)(mb + (tid & 63)) * PB_W + 768))[h];                             \
    _Pragma("unroll") for (int j = 0; j < 2; ++j) {                                                       \
      const int idx = tid + 256 * j, row = idx >> 3, c8 = (idx & 7) * 8;                                  \
      ra[j] = *(const u32x4*)(projB + (size_t)(mb + row) * PB_W + 512 + h * 64 + c8);                     \
    }                                                                                                     \
    if (tid < 128) ru = *(const u32x4*)(sb + ((size_t)(mb + (tid >> 1)) * 4 + h) * 384 + 256 + col0 + (tid & 1) * 8); \
    glast = ((const float*)(projB + (size_t)(mb + 63) * PB_W + 768))[h];                                  \
  }
#define D2_STAGE1()                                                                                       \
  {                                                                                                       \
    const float ek = __expf(glast - gk);                                                                  \
    _Pragma("unroll") for (int j = 0; j < 4; ++j) {                                                       \
      const int c8 = ((tid >> 6) + 4 * j) * 8;                                                            \
      float f[8];                                                                                         \
      unpack8(rk[j], f);                                                                                  \
      _Pragma("unroll") for (int e = 0; e < 8; ++e) KT[(c8 + e) * 72 + (tid & 63)] = f2bf(f[e] * ek);     \
    }                                                                                                     \
  }
#define D2_STAGE2()                                                                                       \
  {                                                                                                       \
    _Pragma("unroll") for (int j = 0; j < 4; ++j) {                                                       \
      const int idx = tid + 256 * j, row = idx >> 4, c8 = (idx & 15) * 8;                                 \
      *(u32x4*)(Ws + row * DLD + c8) = rw[j];                                                             \
      const float eq = __expf(gj[j]);                                                                     \
      float f[8];                                                                                         \
      unpack8(rq[j], f);                                                                                  \
      _Pragma("unroll") for (int e = 0; e < 8; ++e) f[e] *= eq;                                           \
      *(u32x4*)(Qs + row * DLD + c8) = pack8(f);                                                          \
    }                                                                                                     \
    _Pragma("unroll") for (int j = 0; j < 2; ++j) {                                                       \
      const int idx = tid + 256 * j, row = idx >> 3, c8 = (idx & 7) * 8;                                  \
      *(u32x4*)(AT + row * 72 + c8) = ra[j];                                                              \
    }                                                                                                     \
    if (tid < 128) {                                                                                      \
      float f[8];                                                                                         \
      unpack8(ru, f);                                                                                     \
      float* up = Us + (tid >> 1) * 16 + (tid & 1) * 8;                                                   \
      *(f32x4*)up = f32x4{f[0], f[1], f[2], f[3]};                                                        \
      *(f32x4*)(up + 4) = f32x4{f[4], f[5], f[6], f[7]};                                                  \
    }                                                                                                     \
    glcur = glast;                                                                                        \
  }
  D2_PREFETCH(0);
  D2_STAGE1();
  D2_STAGE2();
  D2_PREFETCH(1);
  __syncthreads();
  for (int c = 0; c < 32; ++c) {
    f32x4 av = f32x4{0.f, 0.f, 0.f, 0.f}, ao = av;
#pragma unroll
    for (int ks = 0; ks < 4; ++ks) {
      const int ko = ks * 32 + q4 * 8;
      const bf16x8 bw = *(const bf16x8*)(Ws + (16 * wave + r16) * DLD + ko);
      const bf16x8 bq = *(const bf16x8*)(Qs + (16 * wave + r16) * DLD + ko);
      const bf16x8 bs = *(const bf16x8*)(ST + r16 * DLD + ko);
      av = __builtin_amdgcn_mfma_f32_16x16x32_bf16(bw, bs, av, 0, 0, 0);
      ao = __builtin_amdgcn_mfma_f32_16x16x32_bf16(bq, bs, ao, 0, 0, 0);
    }
    {
      const int tk = 16 * wave + q4 * 4;
      float vn[4];
#pragma unroll
      for (int j = 0; j < 4; ++j) vn[j] = Us[(tk + j) * 16 + r16] - av[j];
      *(uint2*)(VnT + r16 * 72 + tk) = uint2{pack2(vn[0], vn[1]), pack2(vn[2], vn[3])};
    }
    lds_barrier();
    bf16x8 bv[2];
#pragma unroll
    for (int ks = 0; ks < 2; ++ks) {
      bv[ks] = *(const bf16x8*)(VnT + r16 * 72 + ks * 32 + q4 * 8);
      const bf16x8 ba = *(const bf16x8*)(AT + (16 * wave + r16) * 72 + ks * 32 + q4 * 8);
      ao = __builtin_amdgcn_mfma_f32_16x16x32_bf16(ba, bv[ks], ao, 0, 0, 0);
    }
    {
      bfu* op = omix + (size_t)(row0 + c * 64 + 16 * wave + q4 * 4) * 1024 + 512 + h * 128 + col0 + r16;
#pragma unroll
      for (int j = 0; j < 4; ++j) op[(size_t)j * 1024] = f2bf(ao[j]);
    }
    {
      const float gl = __expf(glcur);
#pragma unroll
      for (int t = 0; t < 2; ++t) {
        accS[t] = accS[t] * gl;
#pragma unroll
        for (int ks = 0; ks < 2; ++ks) {
          const bf16x8 bk = *(const bf16x8*)(KT + (16 * (2 * wave + t) + r16) * 72 + ks * 32 + q4 * 8);
          accS[t] = __builtin_amdgcn_mfma_f32_16x16x32_bf16(bv[ks], bk, accS[t], 0, 0, 0);
        }
      }
    }
    lds_barrier();
#pragma unroll
    for (int t = 0; t < 2; ++t)
#pragma unroll
      for (int j = 0; j < 4; ++j) ST[(q4 * 4 + j) * DLD + 16 * (2 * wave + t) + r16] = f2bf(accS[t][j]);
    if (c + 1 < 32) D2_STAGE1();
    lds_barrier();
    if (c + 1 < 32) D2_STAGE2();
    if (c + 2 < 32) D2_PREFETCH(c + 2);
    lds_barrier();
  }
#undef D2_PREFETCH
#undef D2_STAGE1
#undef D2_STAGE2
  float* o = P.out + O_PB_SSM + ((size_t)(s * 4 + h) * 128) * 128 + col0;
#pragma unroll
  for (int t = 0; t < 2; ++t)
#pragma unroll
    for (int j = 0; j < 4; ++j) o[(size_t)(16 * (2 * wave + t) + r16) * 128 + q4 * 4 + j] = accS[t][j];
}

DI void ph_d1(const Params& P, int u, char* smem) { delta_d1(P, u, smem); }

DI void ph_scan(const Params& P, int u, char* smem) {
  const int k = u >> 1;
  if (k < 256) {
    if (u & 1) delta_d2(P, k >> 5, (k >> 3) & 3, k & 7, smem);
    else rwkv_unit<1>(P, k >> 5, (k >> 2) & 7, k & 3, smem);
  } else {
    const int j = k - 256;
    if (u & 1) delta_unit<4>(P, 8 + (j >> 3), (j >> 1) & 3, j & 1, smem);
    else rwkv_unit<4>(P, 8 + (j >> 3), j & 7, 0, smem);
  }
}

DI void ph_post(const Params& P, int u, char* smem) {
  const int tid = VT, lane = tid & 63, wave = tid >> 6;
  const int m0 = u * 8 + wave * 2;
  bfu* omix = (bfu*)(P.ws + OFF_OMIX);
  {
    const int h = lane >> 3, sub = lane & 7, ch = h * 64 + sub * 8;
    float gng[8], gnb[8];
    load8f(P.a_gn_g + ch, gng);
    load8f(P.a_gn_b + ch, gnb);
    u32x4 oq[2], vq[2], gq[2];
    float bon[2];
#pragma unroll
    for (int i = 0; i < 2; ++i) {
      const int m = m0 + i;
      oq[i] = *(const u32x4*)(omix + (size_t)m * 1024 + ch);
      vq[i] = *(const u32x4*)((const bfu*)(P.ws + OFF_STREAM) + (size_t)(m * 8 + h) * 384 + 192 + sub * 8);
      gq[i] = *(const u32x4*)((const bfu*)(P.ws + OFF_G) + (size_t)m * 512 + ch);
      bon[i] = ((const float*)(P.ws + OFF_BONUS))[m * 8 + h];
    }
#pragma unroll
    for (int i = 0; i < 2; ++i) {
      float o[8], v[8], g[8], r[8];
      unpack8(oq[i], o);
      unpack8(vq[i], v);
      unpack8(gq[i], g);
      float s = 0.f;
#pragma unroll
      for (int e = 0; e < 8; ++e) s += o[e];
      const float mean = sum8(s) * (1.f / 64.f);
      float q = 0.f;
#pragma unroll
      for (int e = 0; e < 8; ++e) {
        o[e] -= mean;
        q += o[e] * o[e];
      }
      const float rs = rsqrtf(sum8(q) * (1.f / 64.f) + GN_EPS);
#pragma unroll
      for (int e = 0; e < 8; ++e) r[e] = ((o[e] * rs * gng[e] + gnb[e]) + bon[i] * v[e]) * g[e];
      *(u32x4*)(omix + (size_t)(m0 + i) * 1024 + ch) = pack8(r);
    }
  }
  {
    const int h = lane >> 4, sub = lane & 15, ch = h * 128 + sub * 8;
    float ng[8];
    load8f(P.b_norm_g + sub * 8, ng);
    u32x4 oq[2], zq[2];
#pragma unroll
    for (int i = 0; i < 2; ++i) {
      const int m = m0 + i;
      oq[i] = *(const u32x4*)(omix + (size_t)m * 1024 + 512 + ch);
      zq[i] = *(const u32x4*)((const bfu*)P.out + (size_t)m * PB_W + 1536 + ch);
    }
#pragma unroll
    for (int i = 0; i < 2; ++i) {
      float o[8], z[8], r[8];
      unpack8(oq[i], o);
      unpack8(zq[i], z);
      float q = 0.f;
#pragma unroll
      for (int e = 0; e < 8; ++e) q += o[e] * o[e];
      const float rinv = rsqrtf(row16_sum(q) * (1.f / 128.f) + RMS_EPS);
#pragma unroll
      for (int e = 0; e < 8; ++e) r[e] = o[e] * rinv * ng[e] * siluf_(z[e]);
      *(u32x4*)(omix + (size_t)(m0 + i) * 1024 + 512 + ch) = pack8(r);
    }
  }
}

DI void ln_rows4(const float* src, float* dst, bfu* dstb, const float* g, const float* b, int lane) {
  f32x4 v[4][4];
#pragma unroll
  for (int r = 0; r < 4; ++r)
#pragma unroll
    for (int i = 0; i < 4; ++i) v[r][i] = *(const f32x4*)(src + (size_t)r * DM + i * 256 + lane * 4);
  f32x4 gg[4], bb[4];
#pragma unroll
  for (int i = 0; i < 4; ++i) {
    gg[i] = *(const f32x4*)(g + i * 256 + lane * 4);
    bb[i] = *(const f32x4*)(b + i * 256 + lane * 4);
  }
#pragma unroll
  for (int r = 0; r < 4; ++r) {
    float s = 0.f;
#pragma unroll
    for (int i = 0; i < 4; ++i) s += (v[r][i][0] + v[r][i][1]) + (v[r][i][2] + v[r][i][3]);
    const float mean = wave_sum(s) * (1.f / 1024.f);
    float q = 0.f;
#pragma unroll
    for (int i = 0; i < 4; ++i) {
      v[r][i] = v[r][i] - mean;
      q += (v[r][i][0] * v[r][i][0] + v[r][i][1] * v[r][i][1]) + (v[r][i][2] * v[r][i][2] + v[r][i][3] * v[r][i][3]);
    }
    const float rstd = rsqrtf(wave_sum(q) * (1.f / 1024.f) + LN_EPS);
#pragma unroll
    for (int i = 0; i < 4; ++i) {
      const f32x4 o = v[r][i] * rstd * gg[i] + bb[i];
      if (dst) *(f32x4*)(dst + (size_t)r * DM + i * 256 + lane * 4) = o;
      store_bf4(dstb + (size_t)r * DM + i * 256 + lane * 4, o);
    }
  }
}

template <int NR>
DI void ln_rowsb(const bfu* src, bfu* dst, const float* g, const float* b, int lane) {
  u32x4 q[NR][2];
#pragma unroll
  for (int r = 0; r < NR; ++r)
#pragma unroll
    for (int i = 0; i < 2; ++i) q[r][i] = *(const u32x4*)(src + (size_t)r * DM + i * 512 + lane * 8);
  float gg[2][8], bb[2][8];
#pragma unroll
  for (int i = 0; i < 2; ++i) {
    load8f(g + i * 512 + lane * 8, gg[i]);
    load8f(b + i * 512 + lane * 8, bb[i]);
  }
#pragma unroll
  for (int r = 0; r < NR; ++r) {
    float v[2][8];
    unpack8(q[r][0], v[0]);
    unpack8(q[r][1], v[1]);
    float s = 0.f;
#pragma unroll
    for (int i = 0; i < 2; ++i)
#pragma unroll
      for (int e = 0; e < 8; ++e) s += v[i][e];
    const float mean = wave_sum(s) * (1.f / 1024.f);
    float sq = 0.f;
#pragma unroll
    for (int i = 0; i < 2; ++i)
#pragma unroll
      for (int e = 0; e < 8; ++e) {
        v[i][e] -= mean;
        sq += v[i][e] * v[i][e];
      }
    const float rstd = rsqrtf(wave_sum(sq) * (1.f / 1024.f) + LN_EPS);
#pragma unroll
    for (int i = 0; i < 2; ++i) {
      float o[8];
#pragma unroll
      for (int e = 0; e < 8; ++e) o[e] = v[i][e] * rstd * gg[i][e] + bb[i][e];
      *(u32x4*)(dst + (size_t)r * DM + i * 512 + lane * 8) = pack8(o);
    }
  }
}

template <bool RESF>
DI void ln_row_slabs(const float* slabrow, const void* res, bfu* dst, const float* g, const float* b, int lane) {
  f32x4 v[4];
#pragma unroll
  for (int i = 0; i < 4; ++i) {
    const int co = i * 256 + lane * 4;
    f32x4 r;
    if constexpr (RESF) r = *(const f32x4*)((const float*)res + co);
    else {
      const uint2 q = *(const uint2*)((const bfu*)res + co);
      r = f32x4{lo_bf(q.x), hi_bf(q.x), lo_bf(q.y), hi_bf(q.y)};
    }
    const f32x4 s0 = *(const f32x4*)(slabrow + co), s1 = *(const f32x4*)(slabrow + (size_t)1024 * 1024 + co);
    const f32x4 s2 = *(const f32x4*)(slabrow + (size_t)2 * 1024 * 1024 + co), s3 = *(const f32x4*)(slabrow + (size_t)3 * 1024 * 1024 + co);
    v[i] = r * DN_ALPHA + ((s0 + s1) + (s2 + s3));
  }
  float s = 0.f;
#pragma unroll
  for (int i = 0; i < 4; ++i) s += (v[i][0] + v[i][1]) + (v[i][2] + v[i][3]);
  const float mean = wave_sum(s) * (1.f / 1024.f);
  float q = 0.f;
#pragma unroll
  for (int i = 0; i < 4; ++i) {
    v[i] = v[i] - mean;
    q += (v[i][0] * v[i][0] + v[i][1] * v[i][1]) + (v[i][2] * v[i][2] + v[i][3] * v[i][3]);
  }
  const float rstd = rsqrtf(wave_sum(q) * (1.f / 1024.f) + LN_EPS);
#pragma unroll
  for (int i = 0; i < 4; ++i) {
    const int co = i * 256 + lane * 4;
    const f32x4 gg = *(const f32x4*)(g + co), bb = *(const f32x4*)(b + co);
    store_bf4(dst + co, v[i] * rstd * gg + bb);
  }
}
#define SLABS(P) ((P).out + (size_t)M_TOK * 512)

DI void ph_ln1(const Params& P, int u, char* smem) {
  const int lane = VT & 63, wave = VT >> 6;
  const int m = u * 8 + wave * 2;
  if (m >= M_P) {
    for (int r = 0; r < 2; ++r) {
      const int rs = m - M_P + r;
      ln_row_slabs<true>(SLABS(P) + (size_t)rs * DM, P.x_s + (size_t)rs * DM, (bfu*)(P.ws + OFF_X1B) + (size_t)(m + r) * DM,
                         P.ln1_g, P.ln1_b, lane);
    }
    return;
  }
  ln_rowsb<2>((const bfu*)P.out + (size_t)m * DM, (bfu*)(P.ws + OFF_X1B) + (size_t)m * DM, P.ln1_g, P.ln1_b, lane);
}

DI void ffnconv_slot(const Params& P, int slot) {
  const int tg = slot / 352, cs = slot - tg * 352;
  const int m0 = tg * 8, c = cs * 8;
  const int s = seq_of_row(m0), t0 = t_of_row(m0);
  const int T = T_of_seq(s);
  bfu* gu = (bfu*)(P.ws + OFF_GU);
  u32x4 gq[10], uq[8];
#pragma unroll
  for (int i = 0; i < 10; ++i)
    if (t0 + i - 2 >= 0) gq[i] = *(const u32x4*)(gu + (size_t)(m0 + i - 2) * 5632 + c);
#pragma unroll
  for (int i = 0; i < 8; ++i) uq[i] = *(const u32x4*)(gu + (size_t)(m0 + i) * 5632 + DFF + c);
  float w[3][8], fb[8];
#pragma unroll
  for (int j = 0; j < 3; ++j) load8f(P.f_conv_w + j * DFF + c, w[j]);
  load8f(P.f_conv_b + c, fb);
  float g0[8], g1[8], g2[8];
  if (t0 >= 2) {
    unpack8(gq[0], g0);
    unpack8(gq[1], g1);
  } else if (s >= 8) {
    load8f(P.st_fconv + ((size_t)(s - 8) * 2 + 0) * DFF + c, g0);
    load8f(P.st_fconv + ((size_t)(s - 8) * 2 + 1) * DFF + c, g1);
  } else {
#pragma unroll
    for (int e = 0; e < 8; ++e) { g0[e] = 0.f; g1[e] = 0.f; }
  }
#pragma unroll
  for (int i = 0; i < 8; ++i) {
    float up[8], hh[8];
    unpack8(gq[i + 2], g2);
    unpack8(uq[i], up);
#pragma unroll
    for (int e = 0; e < 8; ++e) {
      float a = w[0][e] * g0[e] + w[1][e] * g1[e] + w[2][e] * g2[e] + fb[e];
      hh[e] = siluf_(a) * up[e];
      g0[e] = g1[e];
      g1[e] = g2[e];
    }
    *(u32x4*)(gu + (size_t)(m0 + i) * 5632 + DFF + c) = pack8(hh);
  }
  if (t0 + 8 == T) {
    float* ostate = P.out + (s < 8 ? O_PF_CONV + (size_t)s * 2 * DFF : O_SF_CONV + (size_t)(s - 8) * 2 * DFF);
    *(f32x4*)(ostate + c) = f32x4{g0[0], g0[1], g0[2], g0[3]};
    *(f32x4*)(ostate + c + 4) = f32x4{g0[4], g0[5], g0[6], g0[7]};
    *(f32x4*)(ostate + DFF + c) = f32x4{g1[0], g1[1], g1[2], g1[3]};
    *(f32x4*)(ostate + DFF + c + 4) = f32x4{g1[4], g1[5], g1[6], g1[7]};
  }
}

DI void ph_ffnconv(const Params& P, int u, char* smem) {
  if (u >= 352) {
    ffnconv_slot(P, 2048 * 352 + (u - 352) * 256 + VT);
    return;
  }
  const int slot = u * 256 + VT;
  const int slab = slot / 352, c = (slot - slab * 352) * 8;
  const bfu* hg = FFN_HG(P);
  const bfu* hu = FFN_HU(P);
  bfu* gu = (bfu*)(P.ws + OFF_GU);
  float w0[8], w1[8], w2[8], fb[8];
  load8f(P.f_conv_w + c, w0);
  load8f(P.f_conv_w + DFF + c, w1);
  load8f(P.f_conv_w + 2 * DFF + c, w2);
  load8f(P.f_conv_b + c, fb);
  float a2[8], a1[8], c0[8], c1[8], u0[8], u1[8];
  if ((slab & 31) != 0) {
    unpack8(*(const u32x4*)(hg + ((size_t)(slab - 1) * 4 + 0) * DFF + c), a2);
    unpack8(*(const u32x4*)(hg + ((size_t)(slab - 1) * 4 + 1) * DFF + c), a1);
  } else {
#pragma unroll
    for (int e = 0; e < 8; ++e) { a2[e] = 0.f; a1[e] = 0.f; }
  }
  unpack8(*(const u32x4*)(hg + ((size_t)slab * 4 + 2) * DFF + c), c0);
  unpack8(*(const u32x4*)(hg + ((size_t)slab * 4 + 3) * DFF + c), c1);
  unpack8(*(const u32x4*)(hu + ((size_t)slab * 2 + 0) * DFF + c), u0);
  unpack8(*(const u32x4*)(hu + ((size_t)slab * 2 + 1) * DFF + c), u1);
  float h0[8], h1[8];
#pragma unroll
  for (int e = 0; e < 8; ++e) {
    h0[e] = siluf_(w0[e] * a2[e] + w1[e] * a1[e] + w2[e] * c0[e] + fb[e]) * u0[e];
    h1[e] = siluf_(w0[e] * a1[e] + w1[e] * c0[e] + w2[e] * c1[e] + fb[e]) * u1[e];
  }
  *(u32x4*)(gu + (size_t)(slab * 64) * (2 * DFF) + DFF + c) = pack8(h0);
  *(u32x4*)(gu + (size_t)(slab * 64 + 1) * (2 * DFF) + DFF + c) = pack8(h1);
}

DI void ph_ln2_ple(const Params& P, int u, char* smem) {
  const int lane = VT & 63, wave = VT >> 6;
  const int m = u * 8 + wave * 2;
  if (m >= M_P) {
    for (int r = 0; r < 2; ++r) {
      const int rs = m - M_P + r;
      ln_row_slabs<false>(SLABS(P) + (size_t)rs * DM, (const bfu*)(P.ws + OFF_X1B) + (size_t)(m + r) * DM,
                          (bfu*)(P.ws + OFF_X2B) + (size_t)(m + r) * DM, P.ln2_g, P.ln2_b, lane);
    }
    return;
  }
  ln_rowsb<2>((const bfu*)P.out + (size_t)m * DM, (bfu*)(P.ws + OFF_X2B) + (size_t)m * DM, P.ln2_g, P.ln2_b, lane);
}

DI void ph_rinv(const Params& P, int u, char* smem) {
  const int lane = VT & 63, wave = VT >> 6;
  const int m = u * 16 + wave * 4;
  const bfu* ep = (const bfu*)(P.ws + OFF_EPRE) + (size_t)m * DM;
  u32x4 v[4][2];
#pragma unroll
  for (int r = 0; r < 4; ++r)
#pragma unroll
    for (int i = 0; i < 2; ++i) v[r][i] = *(const u32x4*)(ep + (size_t)r * DM + i * 512 + lane * 8);
#pragma unroll
  for (int r = 0; r < 4; ++r) {
    float q = 0.f;
#pragma unroll
    for (int i = 0; i < 2; ++i) {
      float a[8];
      unpack8(v[r][i], a);
#pragma unroll
      for (int e = 0; e < 8; ++e) q += a[e] * a[e];
    }
    q = wave_sum(q);
    if (lane == 0) ((float*)(P.ws + OFF_RINV))[m + r] = rsqrtf(q * (1.f / 1024.f) + RMS_EPS);
  }
}

DI void ph_fins(const Params& P, int u, char* smem) {
  const int lane = VT & 63, wave = VT >> 6;
  const int rs = u * 4 + wave, m = M_P + rs;
  const float* sl = (const float*)(P.ws + OFF_FSLAB) + (size_t)rs * DM;
  const bfu* x2 = (const bfu*)(P.ws + OFF_X2B) + (size_t)m * DM;
  const bfu* ep = (const bfu*)(P.ws + OFF_EPRE) + (size_t)m * DM;
  const float ri = ((const float*)(P.ws + OFF_RINV))[m];
#pragma unroll
  for (int i = 0; i < 4; ++i) {
    const int co = i * 256 + lane * 4;
    const f32x4 s0 = *(const f32x4*)(sl + co), s1 = *(const f32x4*)(sl + (size_t)1024 * 1024 + co);
    const f32x4 s2 = *(const f32x4*)(sl + (size_t)2 * 1024 * 1024 + co), s3 = *(const f32x4*)(sl + (size_t)3 * 1024 * 1024 + co);
    const f32x4 a = (s0 + s1) + (s2 + s3);
    const uint2 xq = *(const uint2*)(x2 + co);
    const uint2 eq = *(const uint2*)(ep + co);
    const f32x4 gv = *(const f32x4*)(P.ple_g + co);
    f32x4 o;
    o[0] = lo_bf(xq.x) + sigmoidf_(a[0]) * (lo_bf(eq.x) * ri * gv[0]);
    o[1] = hi_bf(xq.x) + sigmoidf_(a[1]) * (hi_bf(eq.x) * ri * gv[1]);
    o[2] = lo_bf(xq.y) + sigmoidf_(a[2]) * (lo_bf(eq.y) * ri * gv[2]);
    o[3] = hi_bf(xq.y) + sigmoidf_(a[3]) * (hi_bf(eq.y) * ri * gv[3]);
    *(f32x4*)(P.out + (size_t)m * DM + co) = o;
  }
}

template <int PH>
DI void run_unit(const Params& P, int u, char* smem) {
  if (PH == PH_WT) ph_wt(P, u, smem);
  else if (PH == PH_LORAIN) ph_lorain(P, u, smem);
  else if (PH == PH_LORA) ph_lora(P, u, smem);
  else if (PH == PH_PREPA) ph_prepa(P, u, smem);
  else if (PH == PH_PREPB) ph_prepb(P, u, smem);
  else if (PH == PH_D1) ph_d1(P, u, smem);
  else if (PH == PH_SCAN) ph_scan(P, u, smem);
  else if (PH == PH_POST) ph_post(P, u, smem);
  else if (PH == PH_LN1) ph_ln1(P, u, smem);
  else if (PH == PH_FFNCONV) ph_ffnconv(P, u, smem);
  else if (PH == PH_LN2_PLE) ph_ln2_ple(P, u, smem);
  else if (PH == PH_RINV) ph_rinv(P, u, smem);
  else if (PH == PH_FINS) ph_fins(P, u, smem);
}

template <int PH>
DI void run_phase(const Params& P, char* lds) {
  const int half = (int)(threadIdx.x >> 8);
  char* smem = lds + half * SMEM_BYTES;
  const int n = units_of(PH, P.wd_tiles);
  for (int u = (int)blockIdx.x * 2 + half; u < n; u += 2 * (int)gridDim.x) run_unit<PH>(P, u, smem);
}

#define XB_TMO      128
#define XB_XCNT(j)  (256  + 64 * (j))
#define XB_XSUB(j)  (1280 + 64 * (j))
#define XB_XGEN(j)  (2304 + 64 * (j))
#define XB_TOP      3328
#define XB_TOPGEN   3392
#define XCD_BAR_WORDS 3456
#define XB_SPIN_CAP (1u << 18)
#define XLAS __attribute__((address_space(3)))

__device__ __forceinline__ unsigned xb_ld(unsigned* p)              { return __hip_atomic_load(p, __ATOMIC_RELAXED, __HIP_MEMORY_SCOPE_AGENT); }
__device__ __forceinline__ unsigned xb_add(unsigned* p, unsigned v) { return __hip_atomic_fetch_add(p, v, __ATOMIC_RELAXED, __HIP_MEMORY_SCOPE_AGENT); }
__device__ __forceinline__ unsigned xb_xcc_id() { return (unsigned)__builtin_amdgcn_s_getreg((3 << 11) | 20) & 0xFu; }
#define XB_SPIN(cond, bar) do { unsigned _sp = 0; while (cond) { __builtin_amdgcn_s_sleep(1); \
    if ((++_sp & 255u) == 0u) { if (xb_ld(&(bar)[XB_TMO])) break; if (_sp > XB_SPIN_CAP) { atomicAdd(&(bar)[XB_TMO], 1u); break; } } } } while (0)

struct XcdBarrier {
    unsigned* bar; unsigned x;
    volatile XLAS unsigned* st;
};

__device__ __forceinline__ XcdBarrier xcd_barrier_post(unsigned* bar, volatile XLAS unsigned* st) {
    XcdBarrier b; b.bar = bar; b.x = xb_xcc_id(); b.st = st;
    if (threadIdx.x == 0) (void)xb_add(&bar[XB_XCNT(b.x)], 1u);
    return b;
}
__device__ __forceinline__ void xcd_barrier_complete(unsigned* bar, unsigned x, unsigned& nloc, unsigned& nx) {
    const unsigned G = gridDim.x * gridDim.y * gridDim.z;
    unsigned sum, cnt, mine, sp = 0u;
    for (;;) {
        sum = 0u; cnt = 0u; mine = 0u;
#pragma unroll
        for (unsigned j = 0; j < 16; ++j) { const unsigned c = xb_ld(&bar[XB_XCNT(j)]); sum += c; cnt += (c > 0u) ? 1u : 0u; mine = (j == x) ? c : mine; }
        if (sum == G) break;
        __builtin_amdgcn_s_sleep(1);
        if ((++sp & 255u) == 0u) { if (xb_ld(&bar[XB_TMO])) break; if (sp > XB_SPIN_CAP) { atomicAdd(&bar[XB_TMO], 1u); break; } }
    }
    nloc = mine > 0u ? mine : 1u; nx = cnt > 0u ? cnt : 1u;
}

__device__ __forceinline__ void xcd_barrier(const XcdBarrier& b) {
    asm volatile("s_waitcnt vmcnt(0)" ::: "memory");
    __syncthreads();
    if (threadIdx.x == 0) {
        unsigned* bar = b.bar;
        __builtin_amdgcn_s_waitcnt(0);
        unsigned nloc = b.st[0], nx = b.st[1];
        if (nloc == 0u) { xcd_barrier_complete(bar, b.x, nloc, nx); b.st[0] = nloc; b.st[1] = nx; }
        const unsigned old = xb_add(&bar[XB_XSUB(b.x)], 1u);
        const unsigned gen = old / nloc;
        if (old + 1u == (gen + 1u) * nloc) {
            __builtin_amdgcn_fence(__ATOMIC_RELEASE, "agent");
            asm volatile("s_waitcnt vmcnt(0)" ::: "memory");
            const unsigned og = xb_add(&bar[XB_TOP], 1u);
            const unsigned tg = og / nx;
            if (og + 1u == (tg + 1u) * nx) xb_add(&bar[XB_TOPGEN], 1u);
            else XB_SPIN(xb_ld(&bar[XB_TOPGEN]) == tg, bar);
            __builtin_amdgcn_fence(__ATOMIC_ACQUIRE, "agent");
            xb_add(&bar[XB_XGEN(b.x)], 1u);
            asm volatile("s_waitcnt vmcnt(0)" ::: "memory");
        } else {
            XB_SPIN(xb_ld(&bar[XB_XGEN(b.x)]) == gen, bar);
            __builtin_amdgcn_fence(__ATOMIC_ACQUIRE, "agent");
            asm volatile("s_waitcnt vmcnt(0)" ::: "memory");
        }
    }
    __syncthreads();
}


constexpr int DYN_LDS = 2 * SMEM_BYTES + 16;

__global__ void __launch_bounds__(512, 2) k_mega(Params P) {
  extern __shared__ __attribute__((aligned(16))) unsigned char dyn_lds[];
  cg::grid_group grid = cg::this_grid();
  PG8_LAS unsigned char* lds3 = (PG8_LAS unsigned char*)dyn_lds;
  char* lds = (char*)dyn_lds;
  char* ws = P.ws;
  volatile XLAS unsigned* xst = (volatile XLAS unsigned*)((PG8_LAS unsigned char*)dyn_lds + 2 * SMEM_BYTES);
  if (threadIdx.x == 0) { xst[0] = 0u; xst[1] = 0u; xst[2] = 0u; xst[3] = 0u; }
  __syncthreads();
  const XcdBarrier xbar = xcd_barrier_post((unsigned*)(ws + OFF_END), xst);
  run_phase<PH_WT>(P, lds);
  if (P.pad_ != 0) grid.sync();
  xcd_barrier(xbar);
  {
    EpiBf16Split E{(bfu*)(ws + OFF_PROJA), ASW, (bfu*)P.out, PB_W, ASW};
    run_pg8(lds3, (const bfu*)(ws + OFF_XB), DM, (const bfu*)(ws + WT_IN), M_TOK, 3840, DM, E);
  }
  xcd_barrier(xbar);
  run_phase<PH_LORAIN>(P, lds);
  xcd_barrier(xbar);
  run_phase<PH_LORA>(P, lds);
  xcd_barrier(xbar);
  run_phase<PH_PREPA>(P, lds);
  xcd_barrier(xbar);
  run_phase<PH_PREPB>(P, lds);
  xcd_barrier(xbar);
  run_phase<PH_D1>(P, lds);
  xcd_barrier(xbar);
  run_phase<PH_SCAN>(P, lds);
  xcd_barrier(xbar);
  run_phase<PH_POST>(P, lds);
  xcd_barrier(xbar);
  {
    EpiResO E{P.x_p, P.x_s, (bfu*)P.out};
    run_pg8(lds3, (const bfu*)(ws + OFF_OMIX), DM, (const bfu*)(ws + WT_O), M_P, DM, DM, E);
  }
  run_split(lds3, (const bfu*)(ws + OFF_OMIX), DM, (const bfu*)(ws + WT_O), DM, SLABS(P));
  xcd_barrier(xbar);
  run_phase<PH_LN1>(P, lds);
  xcd_barrier(xbar);
  {
    EpiFfn E{(bfu*)(ws + OFF_GU), FFN_HG(P), FFN_HU(P), P.f_conv_w, P.f_conv_b, P.out + O_PF_CONV};
    run_pg8(lds3, (const bfu*)(ws + OFF_X1B), DM, (const bfu*)(ws + WT_UP), M_TOK, 2 * DFF, DM, E);
  }
  xcd_barrier(xbar);
  run_phase<PH_FFNCONV>(P, lds);
  xcd_barrier(xbar);
  {
    EpiResD E{(const bfu*)(ws + OFF_X1B), (bfu*)P.out};
    run_pg8(lds3, (const bfu*)(ws + OFF_GU) + DFF, 2 * DFF, (const bfu*)(ws + WT_DOWN), M_P, DM, DFF, E);
  }
  run_split(lds3, (const bfu*)(ws + OFF_GU) + DFF, 2 * DFF, (const bfu*)(ws + WT_DOWN), DFF, SLABS(P));
  xcd_barrier(xbar);
  {
    EpiBf16Split E{(bfu*)(ws + OFF_EPRE), DM, (bfu*)(ws + OFF_EPRE), DM, 1 << 30};
    run_pg8(lds3, (const bfu*)(ws + OFF_PB), PLE, (const bfu*)(ws + WT_PLE), M_TOK, DM, PLE, E);
  }
  run_phase<PH_LN2_PLE>(P, lds);
  xcd_barrier(xbar);
  run_phase<PH_RINV>(P, lds);
  xcd_barrier(xbar);
  {
    EpiFin E{(const bfu*)(ws + OFF_X2B), (const bfu*)(ws + OFF_EPRE), (const float*)(ws + OFF_RINV), P.ple_g, P.out};
    run_pg8(lds3, (const bfu*)(ws + OFF_X2B), DM, (const bfu*)(ws + WT_GATE), M_P, DM, DM, E);
  }
  run_split(lds3, (const bfu*)(ws + OFF_X2B), DM, (const bfu*)(ws + WT_GATE), DM, (float*)(ws + OFF_FSLAB));
  xcd_barrier(xbar);
  run_phase<PH_FINS>(P, lds);
}

extern "C" void kernel_launch(void* const* d_in, const int* in_sizes, int n_in, void* d_out, int out_size,
                              void* d_ws, size_t ws_size, hipStream_t stream) {
  Params P;
  memset(&P, 0, sizeof(P));
  const float** f = (const float**)&P;
  for (int i = 0; i < 37; ++i) f[i] = (const float*)d_in[i];
  P.out = (float*)d_out;
  P.ws = (char*)d_ws;
  char* ws = (char*)d_ws;
  struct { const float* src; size_t off; int K, N, Npad; } wl[9] = {
      {P.w_in, WT_IN, 1024, INW, INW_PAD},   {P.a_w_w2, WT_W2, 64, 512, 512},   {P.a_w_a2, WT_A2, 64, 512, 512},
      {P.a_w_g2, WT_G2, 128, 512, 512},      {P.w_o, WT_O, 1024, 1024, 1024},   {P.w_up, WT_UP, 1024, 5632, 5632},
      {P.w_down, WT_DOWN, 2816, 1024, 1024}, {P.w_ple, WT_PLE, 256, 1024, 1024}, {P.w_ple_gate, WT_GATE, 1024, 1024, 1024}};
  int t0 = 0;
  for (int i = 0; i < 9; ++i) {
    P.wd[i].src = wl[i].src;
    P.wd[i].dst = (bfu*)(ws + wl[i].off);
    P.wd[i].K = wl[i].K;
    P.wd[i].N = wl[i].N;
    P.wd[i].Npad = wl[i].Npad;
    P.wd[i].t0 = t0;
    t0 += (wl[i].Npad / 64) * (wl[i].K / 64);
  }
  P.wd_tiles = t0;
  static int grid_blocks = 0;
  if (!grid_blocks) {
    int dev = 0, cus = 0, per_cu = 0;
    hipGetDevice(&dev);
    hipDeviceGetAttribute(&cus, hipDeviceAttributeMultiprocessorCount, dev);
    hipFuncSetAttribute((const void*)k_mega, hipFuncAttributeMaxDynamicSharedMemorySize, DYN_LDS);
    hipOccupancyMaxActiveBlocksPerMultiprocessor(&per_cu, (const void*)k_mega, 512, DYN_LDS);
    if (per_cu < 1) per_cu = 1;
    if (per_cu > 1) per_cu = 1;
    grid_blocks = cus * per_cu;
  }
  hipMemsetAsync((char*)d_ws + OFF_END, 0, XCD_BAR_WORDS * 4, stream);
  void* args[] = {&P};
  hipError_t e = hipLaunchCooperativeKernel((void*)k_mega, dim3(grid_blocks), dim3(512), args, DYN_LDS, stream);
  if (e != hipSuccess) fprintf(stderr, "cooperative launch failed: %s (grid %d)\n", hipGetErrorString(e), grid_blocks);
}
```

```cpp
#include <hip/hip_runtime.h>
#include <hip/hip_bf16.h>
#include <hip/hip_cooperative_groups.h>
#include <cstdio>
#include <cstring>
namespace cg = cooperative_groups;

#ifndef MULTI_LAUNCH
#define MULTI_LAUNCH 0
#endif

#define DI __device__ __forceinline__
#define VT ((int)(threadIdx.x & 255u))
typedef unsigned short bfu;
using bf16x8 = __attribute__((ext_vector_type(8))) short;
using f32x4 = __attribute__((ext_vector_type(4))) float;
using u32x4 = __attribute__((ext_vector_type(4))) unsigned;

constexpr int M_TOK = 17408, M_P = 16384, NSEQ = 136;
constexpr int DM = 1024, AW = 512, ASW = 1792, BQKV = 1536, PB_W = 2048, INW = 3848, INW_PAD = 3968;
constexpr int DFF = 2816, PLE = 256;
constexpr float DN_ALPHA = 1.189207115002721f;
constexpr float LN_EPS = 1e-5f, GN_EPS = 64e-5f, RMS_EPS = 1e-6f, L2_EPS = 1e-12f;

constexpr size_t O_Y = 0;
constexpr size_t O_PA_WKV = (size_t)M_TOK * 1024;
constexpr size_t O_PA_SHIFT = O_PA_WKV + 8 * 8 * 64 * 64;
constexpr size_t O_PB_SSM = O_PA_SHIFT + 8 * 1792;
constexpr size_t O_PB_CONV = O_PB_SSM + 8 * 4 * 128 * 128;
constexpr size_t O_PF_CONV = O_PB_CONV + 8 * 3 * 1536;
constexpr size_t O_SA_WKV = O_PF_CONV + 8 * 2 * 2816;
constexpr size_t O_SA_SHIFT = O_SA_WKV + (size_t)128 * 8 * 64 * 64;
constexpr size_t O_SB_SSM = O_SA_SHIFT + 128 * 1792;
constexpr size_t O_SB_CONV = O_SB_SSM + (size_t)128 * 4 * 128 * 128;
constexpr size_t O_SF_CONV = O_SB_CONV + 128 * 3 * 1536;

constexpr size_t WL_UP = 0;
constexpr size_t WL_DOWN = WL_UP + (size_t)5632 * 1024 * 2;
constexpr size_t WL_PLE = WL_DOWN + (size_t)1024 * 2816 * 2;
constexpr size_t WL_GATE = WL_PLE + 1024 * 256 * 2;
constexpr size_t OFF_PB = WL_GATE + 1024 * 1024 * 2;
constexpr size_t OFF_STREAM = OFF_PB + (size_t)M_TOK * 256 * 2;
constexpr size_t OFF_G = OFF_STREAM + (size_t)M_TOK * 8 * 384 * 2;
constexpr size_t OFF_PROJA = OFF_G + (size_t)M_TOK * 512 * 2;
constexpr size_t OFF_LORAIN = OFF_PROJA + (size_t)M_TOK * 1792 * 2;
constexpr size_t OFF_ABUF = OFF_LORAIN + (size_t)M_TOK * 256 * 2;
constexpr size_t OFF_BA = OFF_ABUF + (size_t)M_TOK * 512 * 2;
constexpr size_t OFF_BG = OFF_BA + (size_t)M_TOK * 8 * 4;
constexpr size_t OFF_BONUS = OFF_BG + (size_t)M_TOK * 8 * 4;
constexpr size_t WT_IN = OFF_BONUS + (size_t)M_TOK * 8 * 4;
constexpr size_t WT_W2 = WT_IN + (size_t)INW_PAD * 1024 * 2;
constexpr size_t WT_A2 = WT_W2 + 512 * 64 * 2;
constexpr size_t WT_G2 = WT_A2 + 512 * 64 * 2;
constexpr size_t WT_O = WT_G2 + 512 * 128 * 2;
constexpr size_t WT_UP = WL_UP, WT_DOWN = WL_DOWN, WT_PLE = WL_PLE, WT_GATE = WL_GATE;
constexpr size_t OFF_WEND = WT_O + 1024 * 1024 * 2;
constexpr size_t OFF_XB = OFF_STREAM;
constexpr size_t OFF_STREAMB = OFF_PROJA;
constexpr size_t OFF_OMIX = OFF_STREAMB + (size_t)M_TOK * 4 * 384 * 2;
constexpr size_t OFF_GU = OFF_STREAM;
constexpr size_t OFF_X1B = OFF_GU + (size_t)M_TOK * 5632 * 2;
constexpr size_t OFF_RINV = OFF_X1B + (size_t)M_TOK * 1024 * 2;
constexpr size_t OFF_GG = OFF_RINV + (size_t)M_TOK * 4;
constexpr size_t OFF_END = OFF_GG + (size_t)M_TOK * 4 * 4;
constexpr size_t OFF_X2 = OFF_STREAM;
constexpr size_t OFF_X2B = OFF_X2 + (size_t)M_TOK * 1024 * 4;
constexpr size_t OFF_FSLAB = OFF_X2 + (size_t)M_TOK * 1024 * 2;
static_assert(OFF_FSLAB + 4ull * 1024 * 1024 * 4 <= OFF_X2B, "fin slabs overlap");
constexpr size_t OFF_EPRE = OFF_X2;
static_assert(OFF_OMIX + (size_t)M_TOK * 1024 * 2 <= OFF_BA, "omix overlap");
static_assert(OFF_X1B >= OFF_ABUF, "x1b overlaps live data");
static_assert(OFF_X1B >= OFF_OMIX + 0 || true, "");
static_assert(OFF_RINV >= OFF_WEND, "rinv overlaps weights");
static_assert(OFF_EPRE + (size_t)M_TOK * 1024 * 2 <= OFF_X2B, "epre overlap");
static_assert(OFF_END + 3456 * 4 <= 256ull * 1024 * 1024, "ws too small");
static_assert(OFF_END % 256 == 0, "barrier word alignment");

struct WD { const float* src; bfu* dst; int K, N, Npad, t0; };

struct Params {
  const float *x_p, *x_s, *p_p, *p_s, *st_wkv, *st_shift, *st_ssm, *st_bconv, *st_fconv;
  const float *w_in, *a_mu, *a_w0, *a_w_w2, *a_a0, *a_w_a2, *a_w_g2, *a_k_k, *a_k_a, *a_r_k, *a_gn_g, *a_gn_b;
  const float *b_conv_w, *b_a_log, *b_dt_bias, *b_norm_g, *w_o, *ln1_g, *ln1_b, *w_up, *f_conv_w, *f_conv_b,
      *w_down, *ln2_g, *ln2_b, *w_ple, *ple_g, *w_ple_gate;
  float* out;
  char* ws;
  WD wd[9];
  int wd_tiles;
  int pad_;
};

typedef __bf16 bf16x2_t __attribute__((ext_vector_type(2)));
typedef float f32x2_t __attribute__((ext_vector_type(2)));
DI unsigned pack2(float a, float b) {
  const f32x2_t v = {a, b};
  const bf16x2_t r = __builtin_convertvector(v, bf16x2_t);
  return __builtin_bit_cast(unsigned, r);
}
DI bfu f2bf(float f) { return (bfu)pack2(f, f); }
DI float bf2f(bfu h) { return __uint_as_float(((unsigned)h) << 16); }
DI float lo_bf(unsigned u) { return __uint_as_float(u << 16); }
DI float hi_bf(unsigned u) { return __uint_as_float(u & 0xffff0000u); }
DI float sigmoidf_(float x) { return __builtin_amdgcn_rcpf(1.f + __builtin_amdgcn_exp2f(x * -1.4426950408889634f)); }
DI float siluf_(float x) { return x * __builtin_amdgcn_rcpf(1.f + __builtin_amdgcn_exp2f(x * -1.4426950408889634f)); }
DI float softplusf_(float x) { return fmaxf(x, 0.f) + log1pf(__expf(-fabsf(x))); }
DI float wave_sum(float v) {
#pragma unroll
  for (int o = 32; o > 0; o >>= 1) v += __shfl_xor(v, o, 64);
  return v;
}
DI float row16_sum(float x) {
  x += __int_as_float(__builtin_amdgcn_update_dpp(0, __float_as_int(x), 0x128, 0xf, 0xf, false));
  x += __int_as_float(__builtin_amdgcn_update_dpp(0, __float_as_int(x), 0x124, 0xf, 0xf, false));
  x += __int_as_float(__builtin_amdgcn_update_dpp(0, __float_as_int(x), 0x122, 0xf, 0xf, false));
  x += __int_as_float(__builtin_amdgcn_update_dpp(0, __float_as_int(x), 0x121, 0xf, 0xf, false));
  return x;
}
DI float sum8(float x) {
  x += __int_as_float(__builtin_amdgcn_update_dpp(0, __float_as_int(x), 0xB1, 0xf, 0xf, false));
  x += __int_as_float(__builtin_amdgcn_update_dpp(0, __float_as_int(x), 0x4E, 0xf, 0xf, false));
  x += __int_as_float(__builtin_amdgcn_update_dpp(0, __float_as_int(x), 0x141, 0xf, 0xf, false));
  return x;
}
DI void unpack8(u32x4 q, float (&f)[8]) {
  f[0] = lo_bf(q.x); f[1] = hi_bf(q.x); f[2] = lo_bf(q.y); f[3] = hi_bf(q.y);
  f[4] = lo_bf(q.z); f[5] = hi_bf(q.z); f[6] = lo_bf(q.w); f[7] = hi_bf(q.w);
}
DI u32x4 pack8(const float (&f)[8]) {
  u32x4 q;
  q.x = pack2(f[0], f[1]); q.y = pack2(f[2], f[3]); q.z = pack2(f[4], f[5]); q.w = pack2(f[6], f[7]);
  return q;
}
DI void load8f(const float* p, float (&f)[8]) {
  f32x4 a = *(const f32x4*)p, b = *(const f32x4*)(p + 4);
  f[0] = a[0]; f[1] = a[1]; f[2] = a[2]; f[3] = a[3]; f[4] = b[0]; f[5] = b[1]; f[6] = b[2]; f[7] = b[3];
}
DI int seq_of_row(int m) { return m < M_P ? (m >> 11) : 8 + ((m - M_P) >> 3); }
DI int t_of_row(int m) { return m < M_P ? (m & 2047) : (m & 7); }
DI int row0_of_seq(int s) { return s < 8 ? s * 2048 : M_P + (s - 8) * 8; }
DI int T_of_seq(int s) { return s < 8 ? 2048 : 8; }

constexpr int SMEM_BYTES = 81904;

constexpr int LDT = 72;
constexpr int TILE_ELEMS = 128 * LDT;
constexpr int GBK = 64;

template <bool AF32>
DI void g_load(const void* __restrict__ Ap, int lda, const bfu* __restrict__ Bp, int K, int kt, int lrow, int lkc,
               u32x4 (&ra)[4], u32x4 (&rb)[4], f32x4 (&fa)[4][2]) {
#pragma unroll
  for (int j = 0; j < 4; ++j) {
    const int row = lrow + 32 * j;
    if constexpr (AF32) {
      const float* ap = (const float*)Ap + (size_t)row * lda + kt * GBK + lkc;
      fa[j][0] = *(const f32x4*)ap;
      fa[j][1] = *(const f32x4*)(ap + 4);
    } else {
      const bfu* ap = (const bfu*)Ap + (size_t)row * lda + kt * GBK + lkc;
      ra[j] = *(const u32x4*)ap;
    }
    rb[j] = *(const u32x4*)(Bp + (size_t)row * K + kt * GBK + lkc);
  }
}
template <bool AF32>
DI void l_store(bfu* As, bfu* Bs, int lrow, int lkc, const u32x4 (&ra)[4], const u32x4 (&rb)[4],
                const f32x4 (&fa)[4][2]) {
#pragma unroll
  for (int j = 0; j < 4; ++j) {
    const int row = lrow + 32 * j;
    u32x4 va;
    if constexpr (AF32) {
      va.x = pack2(fa[j][0].x, fa[j][0].y);
      va.y = pack2(fa[j][0].z, fa[j][0].w);
      va.z = pack2(fa[j][1].x, fa[j][1].y);
      va.w = pack2(fa[j][1].z, fa[j][1].w);
    } else {
      va = ra[j];
    }
    *(u32x4*)(As + row * LDT + lkc) = va;
    *(u32x4*)(Bs + row * LDT + lkc) = rb[j];
  }
}

template <bool AF32, class Epi>
DI void gemm_tile(const void* __restrict__ Ap, int lda, const bfu* __restrict__ Bp, int K, int m0, int n0,
                  bfu* smem, Epi epi) {
  const int tid = VT, lane = tid & 63, wave = tid >> 6;
  const int wm = wave >> 1, wn = wave & 1;
  bfu* As = smem;
  bfu* Bs = smem + TILE_ELEMS;
  f32x4 acc[4][4];
#pragma unroll
  for (int i = 0; i < 4; ++i)
#pragma unroll
    for (int j = 0; j < 4; ++j) acc[i][j] = f32x4{0.f, 0.f, 0.f, 0.f};
  const int lrow = tid >> 3, lkc = (tid & 7) * 8;
  u32x4 ra[4], rb[4];
  f32x4 fa[4][2];
  const int nk = K / GBK;

  g_load<AF32>(Ap, lda, Bp, K, 0, lrow, lkc, ra, rb, fa);
  for (int kt = 0; kt < nk; ++kt) {
    __syncthreads();
    l_store<AF32>(As, Bs, lrow, lkc, ra, rb, fa);
    __syncthreads();
    if (kt + 1 < nk) g_load<AF32>(Ap, lda, Bp, K, kt + 1, lrow, lkc, ra, rb, fa);
#pragma unroll
    for (int ks = 0; ks < 2; ++ks) {
      bf16x8 af[4], bfr[4];
#pragma unroll
      for (int mi = 0; mi < 4; ++mi)
        af[mi] = *(const bf16x8*)(As + (wm * 64 + mi * 16 + (lane & 15)) * LDT + ks * 32 + (lane >> 4) * 8);
#pragma unroll
      for (int ni = 0; ni < 4; ++ni)
        bfr[ni] = *(const bf16x8*)(Bs + (wn * 64 + ni * 16 + (lane & 15)) * LDT + ks * 32 + (lane >> 4) * 8);
#pragma unroll
      for (int mi = 0; mi < 4; ++mi)
#pragma unroll
        for (int ni = 0; ni < 4; ++ni)
          acc[mi][ni] = __builtin_amdgcn_mfma_f32_16x16x32_bf16(bfr[ni], af[mi], acc[mi][ni], 0, 0, 0);
    }
  }
#pragma unroll
  for (int mi = 0; mi < 4; ++mi)
#pragma unroll
    for (int ni = 0; ni < 4; ++ni) {
      int m = m0 + wm * 64 + mi * 16 + (lane & 15);
      int n = n0 + wn * 64 + ni * 16 + (lane >> 4) * 4;
      epi(m, n, acc[mi][ni]);
    }
  __syncthreads();
}

DI void store_bf4(bfu* p, f32x4 v) {
  uint2 u;
  u.x = pack2(v[0], v[1]);
  u.y = pack2(v[2], v[3]);
  *(uint2*)p = u;
}

namespace pg8 {
#define PG8_LAS __attribute__((address_space(3)))
typedef unsigned short bf16_t;
typedef short bf16x8 __attribute__((ext_vector_type(8)));
typedef float f32x4 __attribute__((ext_vector_type(4)));
typedef unsigned u32x4 __attribute__((ext_vector_type(4)));
constexpr int BM = 256, BK = 64, HALF = 128, HTB = HALF * BK * 2  , STAGE_BYTES = 8 * HTB, NXCD = 8, WGM = 8;

__host__ __device__ __forceinline__ int lds_byte(int r, int c) { const int st = (r >> 4) * 2 + (c >> 5), rr = r & 15, cc = c & 31, ob = rr * 64 + cc * 2; return st * 1024 + (ob ^ (((ob >> 9) & 1) << 5)); }
__host__ __device__ __forceinline__ void stage_rc(int b, int& R, int& C) { const int st = b / 1024, sb = b % 1024, swz = sb ^ (((sb >> 9) & 1) << 5); R = (st >> 1) * 16 + swz / 64; C = (st & 1) * 32 + (swz % 64) / 2; }
__host__ __device__ __forceinline__ int perm32(int rho) { const int n = rho >> 4, i = rho & 15; return 8 * (i >> 2) + 4 * n + (i & 3); }

struct Unit { int pm, pn; };
struct Gemm { const bf16_t* A; const bf16_t* Bt; int M, N, K, lda, ldb; };

struct StaticOrder {
    int nM, nN, nwg, G, c;
    __host__ __device__ void init(int M, int N, int G_, int c_) { nM = M / BM; nN = N / BM; nwg = nM * nN; G = G_; c = c_; }
    __host__ __device__ bool next(int i, Unit& u) const {
        const long L = (long)i * G + c; if (L >= nwg) return false;
        int wgid = (int)L; { const int q = nwg / NXCD, r = nwg % NXCD, xcd = wgid % NXCD, off = wgid / NXCD; wgid = (xcd < r ? xcd * (q + 1) : r * (q + 1) + (xcd - r) * q) + off; }
        const int nig = WGM * nN, gid = wgid / nig, fm = gid * WGM, gsz = (nM - fm) < WGM ? (nM - fm) : WGM;
        u.pm = fm + ((wgid % nig) % gsz); u.pn = (wgid % nig) / gsz; return true;
    }
    __device__ __forceinline__ void a_ready(const Unit&) const {}
    __device__ __forceinline__ void done(const Unit&) const {}
};
__device__ __forceinline__ unsigned cvt_pk_bf16(float lo, float hi) { unsigned r; asm volatile("v_cvt_pk_bf16_f32 %0, %1, %2" : "=v"(r) : "v"(lo), "v"(hi)); return r; }
template <class Epi, class Sched, bool STAMP = false>
__device__ __forceinline__ void gemm_phase(PG8_LAS unsigned char* lds, const Gemm g, const Sched& S, const Epi& E, unsigned long long* stamps) {
    int tid_ = threadIdx.x; asm volatile("" : "+v"(tid_));
    const int tid = tid_, wid = __builtin_amdgcn_readfirstlane(tid >> 6), lane = tid & 63, wr = wid >> 2, wc = wid & 3, fr = lane & 15, fq = lane >> 4;
    const int K = g.K, nt = K / BK;
    int ts_lo = 0, ts_hi = 0, nts = 0; const unsigned long long rt_entry = STAMP ? (unsigned long long)wall_clock64() : 0ull;
#define PG8_STAMP() do { if (STAMP && wid == 0 && nts < 64) { const unsigned long long _c = (unsigned long long)clock64(); \
        ts_lo = (lane == nts) ? (int)(unsigned)_c : ts_lo; ts_hi = (lane == nts) ? (int)(unsigned)(_c >> 32) : ts_hi; ++nts; } } while (0)
    PG8_STAMP();
    unsigned voffA[2], voffB[2];
#pragma unroll
    for (int i = 0; i < 2; ++i) { int R, C; stage_rc(tid * 16 + i * 8192, R, C); const int Rb = Epi::PERM ? ((R & ~31) + perm32(R & 31)) : R;
        voffA[i] = (unsigned)(R * g.lda + C) * 2u; voffB[i] = (unsigned)(Rb * g.ldb + C) * 2u; }
    const size_t kstep = (size_t)(BK * 2);
    const size_t hstep = (size_t)HALF * g.ldb * 2; const size_t hstepA = (size_t)HALF * g.lda * 2;
    const size_t tstep = 2 * hstep; const size_t tstepA = 2 * hstepA;
    const unsigned ldsw = (unsigned)wid * 1024u;
    const int aoff = lds_byte(wr * 64 + fr, fq * 8), boff = lds_byte(wc * 32 + fr, fq * 8);
#define PG8_SA(b, h) (((b) * 2 + (h)) * HTB)
#define PG8_SB(b, h) ((4 + (b) * 2 + (h)) * HTB)
#define PG8_STAGE(bufoff, gbase, voff) do { _Pragma("unroll") for (int _i = 0; _i < 2; ++_i) \
        __builtin_amdgcn_global_load_lds((const unsigned*)((const char*)(gbase) + (voff)[_i]), (PG8_LAS unsigned*)(lds + (bufoff) + ldsw + _i * 8192), 16, 0, 0); } while (0)
#define PG8_LDA(dst, b, h) do { _Pragma("unroll") for (int m = 0; m < 4; ++m) _Pragma("unroll") for (int k = 0; k < 2; ++k) dst[m][k] = *(const PG8_LAS bf16x8*)(lds + PG8_SA(b, h) + aoff + m * 2048 + k * 1024); } while (0)
#define PG8_LDB(dst, b, h) do { _Pragma("unroll") for (int n = 0; n < 2; ++n) _Pragma("unroll") for (int k = 0; k < 2; ++k) dst[n][k] = *(const PG8_LAS bf16x8*)(lds + PG8_SB(b, h) + boff + n * 2048 + k * 1024); } while (0)
#define PG8_MMA(ai, bj, At, Bt) do { __builtin_amdgcn_s_setprio(1); _Pragma("unroll") for (int m = 0; m < 4; ++m) _Pragma("unroll") for (int n = 0; n < 2; ++n) _Pragma("unroll") for (int k = 0; k < 2; ++k) \
        acc[ai][bj][m][n] = __builtin_amdgcn_mfma_f32_16x16x32_bf16(Bt[n][k], At[m][k], acc[ai][bj][m][n], 0, 0, 0); __builtin_amdgcn_s_setprio(0); } while (0)
#define PG8_WAIT_V(n) asm volatile("s_waitcnt vmcnt(" #n ")" ::: "memory")
#define PG8_WAIT_L(n) asm volatile("s_waitcnt lgkmcnt(" #n ")" ::: "memory")
#define PG8_BAR __builtin_amdgcn_s_barrier()
#define PG8_SCHED __builtin_amdgcn_sched_barrier(0)
    Unit cur, nxt; int ui = 0;
    if (!S.next(0, cur)) return;
    f32x4 acc[2][2][4][2];
#pragma unroll
    for (int a = 0; a < 2; ++a)
#pragma unroll
        for (int b = 0; b < 2; ++b)
#pragma unroll
            for (int m = 0; m < 4; ++m)
#pragma unroll
                for (int n = 0; n < 2; ++n) acc[a][b][m][n] = (f32x4){0.f, 0.f, 0.f, 0.f};
    bf16x8 At[4][2], B0[2][2], B1[2][2];
    const char* cA = (const char*)g.A + (size_t)cur.pm * tstepA; const char* cB = (const char*)g.Bt + (size_t)cur.pn * tstep;
    S.a_ready(cur);
    PG8_STAGE(PG8_SB(0, 0), cB, voffB); PG8_STAGE(PG8_SA(0, 0), cA, voffA); PG8_STAGE(PG8_SB(0, 1), cB + hstep, voffB); PG8_STAGE(PG8_SA(0, 1), cA + hstepA, voffA);
    if (wr == 1) PG8_BAR;
    PG8_WAIT_V(4); PG8_BAR;
    PG8_STAGE(PG8_SB(1, 0), cB + kstep, voffB); PG8_STAGE(PG8_SA(1, 0), cA + kstep, voffA); PG8_STAGE(PG8_SB(1, 1), cB + hstep + kstep, voffB);
    PG8_WAIT_V(6); PG8_BAR;
    PG8_STAMP();
    for (;;) {
        const bool has_next = S.next(ui + 1, nxt);
        const char* nA = has_next ? (const char*)g.A + (size_t)nxt.pm * tstepA : cA; const char* nB = has_next ? (const char*)g.Bt + (size_t)nxt.pn * tstep : cB;
        for (int t = 0; t < nt; t += 2) {
            const bool last = (t == nt - 2);
            const char* a1 = cA + (size_t)(t + 1) * kstep;
            const char* a2 = last ? nA : cA + (size_t)(t + 2) * kstep; const char* b2 = last ? nB : cB + (size_t)(t + 2) * kstep;
            const char* a3 = a2 + kstep; const char* b3 = b2 + kstep;
            if (last && has_next) S.a_ready(nxt);
            PG8_LDB(B0, 0, 0); PG8_SCHED; PG8_LDA(At, 0, 0); PG8_STAGE(PG8_SA(1, 1), a1 + hstepA, voffA);
            PG8_WAIT_L(8); PG8_BAR; PG8_WAIT_L(0); PG8_MMA(0, 0, At, B0); PG8_BAR; PG8_SCHED;
            PG8_LDB(B1, 0, 1); PG8_STAGE(PG8_SB(0, 0), b2, voffB);
            PG8_BAR; PG8_WAIT_L(0); PG8_MMA(0, 1, At, B1); PG8_BAR;
            PG8_LDA(At, 0, 1); PG8_STAGE(PG8_SA(0, 0), a2, voffA);
            PG8_BAR; PG8_WAIT_L(0); PG8_MMA(1, 0, At, B0); PG8_BAR; PG8_SCHED;
            PG8_STAGE(PG8_SB(0, 1), b2 + hstep, voffB);
            PG8_WAIT_V(6); PG8_BAR; PG8_MMA(1, 1, At, B1); PG8_BAR;
            PG8_LDB(B0, 1, 0); PG8_SCHED; PG8_LDA(At, 1, 0); PG8_STAGE(PG8_SA(0, 1), a2 + hstepA, voffA);
            PG8_WAIT_L(8); PG8_BAR; PG8_WAIT_L(0); PG8_MMA(0, 0, At, B0); PG8_BAR; PG8_SCHED;
            PG8_LDB(B1, 1, 1); PG8_STAGE(PG8_SB(1, 0), b3, voffB);
            PG8_BAR; PG8_WAIT_L(0); PG8_MMA(0, 1, At, B1); PG8_BAR;
            PG8_LDA(At, 1, 1); PG8_STAGE(PG8_SA(1, 0), a3, voffA);
            PG8_BAR; PG8_WAIT_L(0); PG8_MMA(1, 0, At, B0); PG8_BAR; PG8_SCHED;
            PG8_STAGE(PG8_SB(1, 1), b3 + hstep, voffB);
            PG8_WAIT_V(6); PG8_BAR; PG8_MMA(1, 1, At, B1); PG8_BAR;
        }
        PG8_STAMP();
        if constexpr (!Epi::AFTER_DRAIN) { E(acc, cur, wr, wc, fr, fq); S.done(cur); }
        PG8_STAMP();
        if (!has_next) break;
#pragma unroll
        for (int a = 0; a < 2; ++a)
#pragma unroll
            for (int b = 0; b < 2; ++b)
#pragma unroll
                for (int m = 0; m < 4; ++m)
#pragma unroll
                    for (int n = 0; n < 2; ++n) acc[a][b][m][n] = (f32x4){0.f, 0.f, 0.f, 0.f};
        cur = nxt; cA = nA; cB = nB; ++ui;
    }
    PG8_WAIT_V(0);
    if (wr == 0) PG8_BAR;
    PG8_BAR;
    if constexpr (Epi::AFTER_DRAIN) { E.fused(acc, cur, wr, wc, fr, fq, lds, wid, lane); S.done(cur); }
    PG8_STAMP();
    if (STAMP && wid == 0) { stamps[lane] = lane < nts ? (((unsigned long long)(unsigned)ts_hi << 32) | (unsigned)ts_lo) : 0ull;
        if (lane == 62) stamps[62] = rt_entry; if (lane == 63) stamps[63] = (unsigned long long)wall_clock64(); }
#undef PG8_STAMP
#undef PG8_SA
#undef PG8_SB
#undef PG8_STAGE
#undef PG8_LDA
#undef PG8_LDB
#undef PG8_MMA
#undef PG8_WAIT_V
#undef PG8_WAIT_L
#undef PG8_BAR
#undef PG8_SCHED
}
}

struct EpiBf16Split {
  static constexpr bool PERM = true, AFTER_DRAIN = false;
  bfu* O1; int ld1; bfu* O2; int ld2; int split;
  DI void operator()(const f32x4 (&acc)[2][2][4][2], const pg8::Unit& u, int wr, int wc, int fr, int fq) const {
    const int row0 = u.pm * 256 + wr * 64 + fr;
    int colt = u.pn * 256; bfu* base = O1; int ld = ld1;
    if (colt >= split) { base = O2; ld = ld2; colt -= split; }
    const int col0 = colt + wc * 32 + 8 * fq;
#pragma unroll
    for (int ai = 0; ai < 2; ++ai)
#pragma unroll
      for (int m = 0; m < 4; ++m) {
        bfu* rowp = base + (size_t)(row0 + ai * 128 + m * 16) * ld + col0;
#pragma unroll
        for (int bj = 0; bj < 2; ++bj) {
          const f32x4 v0 = acc[ai][bj][m][0], v1 = acc[ai][bj][m][1];
          u32x4 o;
          o.x = pack2(v0[0], v0[1]); o.y = pack2(v0[2], v0[3]); o.z = pack2(v1[0], v1[1]); o.w = pack2(v1[2], v1[3]);
          *(u32x4*)(rowp + bj * 128) = o;
        }
      }
  }
};
struct EpiRes {
  static constexpr bool PERM = false, AFTER_DRAIN = false;
  const float* Xp; const float* Xs; float* Y;
  DI void operator()(const f32x4 (&acc)[2][2][4][2], const pg8::Unit& u, int wr, int wc, int fr, int fq) const {
    const int row0 = u.pm * 256 + wr * 64 + fr, col0 = u.pn * 256 + wc * 32 + 4 * fq;
    const float* xb = (u.pm * 256 < M_P) ? Xp : Xs - (size_t)M_P * DM;
#pragma unroll
    for (int ai = 0; ai < 2; ++ai)
#pragma unroll
      for (int m = 0; m < 4; ++m) {
        const size_t ro = (size_t)(row0 + ai * 128 + m * 16) * DM + col0;
#pragma unroll
        for (int bj = 0; bj < 2; ++bj)
#pragma unroll
          for (int n = 0; n < 2; ++n) {
            const f32x4 xv = *(const f32x4*)(xb + ro + bj * 128 + n * 16);
            *(f32x4*)(Y + ro + bj * 128 + n * 16) = xv * DN_ALPHA + acc[ai][bj][m][n];
          }
      }
  }
};
struct EpiResB {
  static constexpr bool PERM = false, AFTER_DRAIN = false;
  const bfu* Xb; float* Y;
  DI void operator()(const f32x4 (&acc)[2][2][4][2], const pg8::Unit& u, int wr, int wc, int fr, int fq) const {
    const int row0 = u.pm * 256 + wr * 64 + fr, col0 = u.pn * 256 + wc * 32 + 4 * fq;
#pragma unroll
    for (int ai = 0; ai < 2; ++ai)
#pragma unroll
      for (int m = 0; m < 4; ++m) {
        const size_t ro = (size_t)(row0 + ai * 128 + m * 16) * DM + col0;
#pragma unroll
        for (int bj = 0; bj < 2; ++bj)
#pragma unroll
          for (int n = 0; n < 2; ++n) {
            const uint2 xq = *(const uint2*)(Xb + ro + bj * 128 + n * 16);
            const f32x4 xv = f32x4{lo_bf(xq.x), hi_bf(xq.x), lo_bf(xq.y), hi_bf(xq.y)};
            *(f32x4*)(Y + ro + bj * 128 + n * 16) = xv * DN_ALPHA + acc[ai][bj][m][n];
          }
      }
  }
};
struct EpiResO {
  static constexpr bool PERM = true, AFTER_DRAIN = false;
  const float* Xp; const float* Xs; bfu* Y;
  DI void operator()(const f32x4 (&acc)[2][2][4][2], const pg8::Unit& u, int wr, int wc, int fr, int fq) const {
    const int row0 = u.pm * 256 + wr * 64 + fr, col0 = u.pn * 256 + wc * 32 + 8 * fq;
    const float* xb = (u.pm * 256 < M_P) ? Xp : Xs - (size_t)M_P * DM;
#pragma unroll
    for (int ai = 0; ai < 2; ++ai)
#pragma unroll
      for (int m = 0; m < 4; ++m) {
        const size_t ro = (size_t)(row0 + ai * 128 + m * 16) * DM + col0;
#pragma unroll
        for (int bj = 0; bj < 2; ++bj) {
          const f32x4 x0 = *(const f32x4*)(xb + ro + bj * 128), x1 = *(const f32x4*)(xb + ro + bj * 128 + 4);
          const f32x4 v0 = x0 * DN_ALPHA + acc[ai][bj][m][0], v1 = x1 * DN_ALPHA + acc[ai][bj][m][1];
          u32x4 o;
          o.x = pack2(v0[0], v0[1]); o.y = pack2(v0[2], v0[3]); o.z = pack2(v1[0], v1[1]); o.w = pack2(v1[2], v1[3]);
          *(u32x4*)(Y + ro + bj * 128) = o;
        }
      }
  }
};
struct EpiResD {
  static constexpr bool PERM = true, AFTER_DRAIN = false;
  const bfu* Xb; bfu* Y;
  DI void operator()(const f32x4 (&acc)[2][2][4][2], const pg8::Unit& u, int wr, int wc, int fr, int fq) const {
    const int row0 = u.pm * 256 + wr * 64 + fr, col0 = u.pn * 256 + wc * 32 + 8 * fq;
#pragma unroll
    for (int ai = 0; ai < 2; ++ai)
#pragma unroll
      for (int m = 0; m < 4; ++m) {
        const size_t ro = (size_t)(row0 + ai * 128 + m * 16) * DM + col0;
#pragma unroll
        for (int bj = 0; bj < 2; ++bj) {
          const u32x4 xq = *(const u32x4*)(Xb + ro + bj * 128);
          const f32x4 a0 = acc[ai][bj][m][0], a1 = acc[ai][bj][m][1];
          u32x4 o;
          o.x = pack2(lo_bf(xq.x) * DN_ALPHA + a0[0], hi_bf(xq.x) * DN_ALPHA + a0[1]);
          o.y = pack2(lo_bf(xq.y) * DN_ALPHA + a0[2], hi_bf(xq.y) * DN_ALPHA + a0[3]);
          o.z = pack2(lo_bf(xq.z) * DN_ALPHA + a1[0], hi_bf(xq.z) * DN_ALPHA + a1[1]);
          o.w = pack2(lo_bf(xq.w) * DN_ALPHA + a1[2], hi_bf(xq.w) * DN_ALPHA + a1[3]);
          *(u32x4*)(Y + ro + bj * 128) = o;
        }
      }
  }
};
#define FFN_HG(P) ((bfu*)((P).out + (size_t)M_TOK * 512))
#define FFN_HU(P) (FFN_HG(P) + (size_t)272 * 4 * DFF)
struct EpiFfn {
  static constexpr bool PERM = true, AFTER_DRAIN = false;
  bfu* gu; bfu* hg; bfu* hu; const float* cw; const float* cb; float* ostate;
  DI void operator()(const f32x4 (&acc)[2][2][4][2], const pg8::Unit& u, int wr, int wc, int fr, int fq) const {
    const int lane = (int)(threadIdx.x & 63u);
    const int cgl = u.pn * 128 + wc * 32 + 8 * fq;
    const int rowb = u.pm * 256 + wr * 64 + fr;
    if (u.pm >= 64) {
#pragma unroll
      for (int ai = 0; ai < 2; ++ai)
#pragma unroll
        for (int m = 0; m < 4; ++m) {
          bfu* rp = gu + (size_t)(rowb + ai * 128 + m * 16) * (2 * DFF) + cgl;
#pragma unroll
          for (int bj = 0; bj < 2; ++bj) {
            const f32x4 v0 = acc[ai][bj][m][0], v1 = acc[ai][bj][m][1];
            u32x4 o;
            o.x = pack2(v0[0], v0[1]); o.y = pack2(v0[2], v0[3]); o.z = pack2(v1[0], v1[1]); o.w = pack2(v1[2], v1[3]);
            *(u32x4*)(rp + bj * DFF) = o;
          }
        }
      return;
    }
#pragma unroll
    for (int n = 0; n < 2; ++n) {
      const int cc = cgl + 4 * n;
      const f32x4 w0 = *(const f32x4*)(cw + cc), w1 = *(const f32x4*)(cw + DFF + cc), w2 = *(const f32x4*)(cw + 2 * DFF + cc);
      const f32x4 fb = *(const f32x4*)(cb + cc);
#pragma unroll
      for (int ai = 0; ai < 2; ++ai) {
        unsigned gpx = 0u, gpy = 0u;
#pragma unroll
        for (int m = 0; m < 4; ++m) {
          const int r = rowb + ai * 128 + m * 16;
          const int slab = u.pm * 4 + ai * 2 + wr;
          const f32x4 g = acc[ai][0][m][n];
          const unsigned gx = pack2(g[0], g[1]), gy = pack2(g[2], g[3]);
          const unsigned s1x = fr == 15 ? gpx : gx, s1y = fr == 15 ? gpy : gy;
          const unsigned s2x = fr >= 14 ? gpx : gx, s2y = fr >= 14 ? gpy : gy;
          const unsigned p1x = (unsigned)__builtin_amdgcn_update_dpp(0, (int)s1x, 0x121, 0xf, 0xf, false);
          const unsigned p1y = (unsigned)__builtin_amdgcn_update_dpp(0, (int)s1y, 0x121, 0xf, 0xf, false);
          const unsigned p2x = (unsigned)__builtin_amdgcn_update_dpp(0, (int)s2x, 0x122, 0xf, 0xf, false);
          const unsigned p2y = (unsigned)__builtin_amdgcn_update_dpp(0, (int)s2y, 0x122, 0xf, 0xf, false);
          const f32x4 gc = f32x4{lo_bf(gx), hi_bf(gx), lo_bf(gy), hi_bf(gy)};
          const f32x4 g1 = f32x4{lo_bf(p1x), hi_bf(p1x), lo_bf(p1y), hi_bf(p1y)};
          const f32x4 g2 = f32x4{lo_bf(p2x), hi_bf(p2x), lo_bf(p2y), hi_bf(p2y)};
          const f32x4 up = acc[ai][1][m][n];
          const f32x4 a = w0 * g2 + w1 * g1 + w2 * gc + fb;
          f32x4 hh;
#pragma unroll
          for (int e = 0; e < 4; ++e) hh[e] = siluf_(a[e]) * up[e];
          if (m > 0 || fr >= 2) store_bf4(gu + (size_t)r * (2 * DFF) + DFF + cc, hh);
          if (m == 3 && fr >= 14) {
            *(uint2*)(hg + ((size_t)slab * 4 + (fr - 14)) * DFF + cc) = uint2{gx, gy};
            if ((u.pm & 7) == 7 && ai == 1 && wr == 1)
              *(f32x4*)(ostate + (size_t)(u.pm >> 3) * 2 * DFF + (size_t)(fr - 14) * DFF + cc) = gc;
          }
          if (m == 0 && fr < 2) {
            *(uint2*)(hg + ((size_t)slab * 4 + 2 + fr) * DFF + cc) = uint2{gx, gy};
            store_bf4(hu + ((size_t)slab * 2 + fr) * DFF + cc, up);
          }
          gpx = gx;
          gpy = gy;
        }
      }
    }
  }
};
struct EpiFin {
  static constexpr bool PERM = false, AFTER_DRAIN = false;
  const bfu* x2; const bfu* ep; const float* rinv; const float* pg; float* y;
  DI void operator()(const f32x4 (&acc)[2][2][4][2], const pg8::Unit& u, int wr, int wc, int fr, int fq) const {
    const int row0 = u.pm * 256 + wr * 64 + fr, col0 = u.pn * 256 + wc * 32 + 4 * fq;
#pragma unroll
    for (int ai = 0; ai < 2; ++ai)
#pragma unroll
      for (int m = 0; m < 4; ++m) {
        const int r = row0 + ai * 128 + m * 16;
        const size_t ro = (size_t)r * DM + col0;
        const float ri = rinv[r];
#pragma unroll
        for (int bj = 0; bj < 2; ++bj)
#pragma unroll
          for (int n = 0; n < 2; ++n) {
            const int co = bj * 128 + n * 16;
            const uint2 xq = *(const uint2*)(x2 + ro + co);
            const f32x4 xv = f32x4{lo_bf(xq.x), hi_bf(xq.x), lo_bf(xq.y), hi_bf(xq.y)};
            const uint2 eq = *(const uint2*)(ep + ro + co);
            const f32x4 gv = *(const f32x4*)(pg + col0 + co);
            const f32x4 a = acc[ai][bj][m][n];
            f32x4 o;
            o[0] = xv[0] + sigmoidf_(a[0]) * (lo_bf(eq.x) * ri * gv[0]);
            o[1] = xv[1] + sigmoidf_(a[1]) * (hi_bf(eq.x) * ri * gv[1]);
            o[2] = xv[2] + sigmoidf_(a[2]) * (lo_bf(eq.y) * ri * gv[2]);
            o[3] = xv[3] + sigmoidf_(a[3]) * (hi_bf(eq.y) * ri * gv[3]);
            *(f32x4*)(y + ro + co) = o;
          }
      }
  }
};
struct SplitOrder {
  int c;
  DI bool next(int i, pg8::Unit& u) const {
    if (i > 0 || c >= 64) return false;
    u.pm = 64 + (c >> 4); u.pn = (c >> 2) & 3;
    return true;
  }
  DI void a_ready(const pg8::Unit&) const {}
  DI void done(const pg8::Unit&) const {}
};
struct EpiSlab {
  static constexpr bool PERM = false, AFTER_DRAIN = false;
  float* slab;
  DI void operator()(const f32x4 (&acc)[2][2][4][2], const pg8::Unit& u, int wr, int wc, int fr, int fq) const {
    const int row0 = (u.pm - 64) * 256 + wr * 64 + fr, col0 = u.pn * 256 + wc * 32 + 4 * fq;
#pragma unroll
    for (int ai = 0; ai < 2; ++ai)
#pragma unroll
      for (int m = 0; m < 4; ++m) {
        float* rp = slab + (size_t)(row0 + ai * 128 + m * 16) * DM + col0;
#pragma unroll
        for (int bj = 0; bj < 2; ++bj)
#pragma unroll
          for (int n = 0; n < 2; ++n) *(f32x4*)(rp + bj * 128 + n * 16) = acc[ai][bj][m][n];
      }
  }
};
DI void run_split(PG8_LAS unsigned char* lds, const bfu* A, int lda, const bfu* Bt, int K, float* slabs) {
  const int c = (int)blockIdx.x;
  if (c >= 64) return;
  const int kp = c & 3;
  int koff, kl;
  if (K == 1024) { koff = kp * 256; kl = 256; }
  else { koff = kp < 2 ? kp * 768 : 1536 + (kp - 2) * 640; kl = kp < 2 ? 768 : 640; }
  pg8::Gemm g{A + koff, Bt + koff, M_TOK, DM, kl, lda, K};
  SplitOrder S{c};
  EpiSlab E{slabs + (size_t)kp * 1024 * 1024};
  pg8::gemm_phase<EpiSlab, SplitOrder, false>(lds, g, S, E, nullptr);
}

template <class Epi>
DI void run_pg8(PG8_LAS unsigned char* lds, const bfu* A, int lda, const bfu* Bt, int M, int N, int K, const Epi& E) {
  pg8::Gemm g{A, Bt, M, N, K, lda, K};
  pg8::StaticOrder S;
  S.init(M, N, (int)gridDim.x, (int)blockIdx.x);
  pg8::gemm_phase<Epi, pg8::StaticOrder, false>(lds, g, S, E, nullptr);
}

enum {
  PH_WT = 0,
  PH_GEMM_IN,
  PH_LORAIN,
  PH_LORA,
  PH_PREPA,
  PH_PREPB,
  PH_D1,
  PH_SCAN,
  PH_POST,
  PH_GEMM_O,
  PH_LN1,
  PH_GEMM_UP,
  PH_FFNCONV,
  PH_GEMM_DOWN,
  PH_LN2_PLE,
  PH_RINV,
  PH_GEMM_FIN,
  PH_FINS,
  PH_COUNT
};

constexpr int MT = M_TOK / 128;

__host__ __device__ constexpr int units_of(int ph, int wd_tiles) {
  return ph == PH_WT ? 1280 + M_TOK / 4
       : ph == PH_LORAIN ? (M_TOK / 64 + M_TOK / 16 + NSEQ)
       : ph == PH_LORA ? MT * 4 * 3
       : ph == PH_PREPA ? M_TOK / 16
       : ph == PH_PREPB ? (M_TOK / 8) * 3 / 4
       : ph == PH_D1 ? 1024
       : ph == PH_SCAN ? 2 * (256 + 1024)
       : ph == PH_POST ? M_TOK / 8
       : ph == PH_LN1 ? M_TOK / 8
       : ph == PH_FFNCONV ? (352 + 176)
       : ph == PH_LN2_PLE ? M_TOK / 8
       : ph == PH_RINV ? M_TOK / 16
       : ph == PH_FINS ? 256
       : 0;
}

constexpr int WT_EARLY = 1280;
DI void ph_wt_impl(const Params& P, int u, char* smem) {
  if (u >= P.wd_tiles) {
    const int lane = VT & 63, wave = VT >> 6;
    const int m = (u - P.wd_tiles) * 4 + wave;
    const float* xr = (m < M_P) ? P.x_p + (size_t)m * DM : P.x_s + (size_t)(m - M_P) * DM;
    const float* pr = (m < M_P) ? P.p_p + (size_t)m * PLE : P.p_s + (size_t)(m - M_P) * PLE;
    f32x4 v[4];
#pragma unroll
    for (int i = 0; i < 4; ++i) v[i] = *(const f32x4*)(xr + i * 256 + lane * 4);
    const f32x4 pv = *(const f32x4*)(pr + lane * 4);
    bfu* xb = (bfu*)(P.ws + OFF_XB) + (size_t)m * DM;
#pragma unroll
    for (int i = 0; i < 4; ++i) store_bf4(xb + i * 256 + lane * 4, v[i]);
    store_bf4((bfu*)(P.ws + OFF_PB) + (size_t)m * PLE + lane * 4, pv);
    return;
  }
  int wi = 0;
#pragma unroll
  for (int i = 1; i < 9; ++i)
    if (u >= P.wd[i].t0) wi = i;
  const float* src = P.wd[wi].src;
  bfu* dst = P.wd[wi].dst;
  const int K = P.wd[wi].K, N = P.wd[wi].N;
  int tl = u - P.wd[wi].t0;
  const int kts = K >> 6;
  const int nt = tl / kts, kt = tl - nt * kts;
  const int n0 = nt * 64, k0 = kt * 64;
  int drow0 = n0;
  if (wi == 5) {
    const int nn = n0 < DFF ? n0 : n0 - DFF;
    drow0 = (nn >> 7) * 256 + (n0 < DFF ? 0 : 128) + (nn & 127);
  }
  float* tile = (float*)smem;
  const int tid = VT;
#pragma unroll
  for (int i = 0; i < 4; ++i) {
    const int kr = (tid >> 4) + 16 * i, c4 = (tid & 15) * 4;
    f32x4 v = f32x4{0.f, 0.f, 0.f, 0.f};
    if (n0 + c4 + 3 < N) v = *(const f32x4*)(src + (size_t)(k0 + kr) * N + n0 + c4);
    tile[kr * 65 + c4 + 0] = v[0];
    tile[kr * 65 + c4 + 1] = v[1];
    tile[kr * 65 + c4 + 2] = v[2];
    tile[kr * 65 + c4 + 3] = v[3];
  }
  __syncthreads();
#pragma unroll
  for (int j = 0; j < 2; ++j) {
    const int nr = (tid >> 3) + 32 * j, kc = (tid & 7) * 8;
    float f[8];
#pragma unroll
    for (int e = 0; e < 8; ++e) f[e] = tile[(kc + e) * 65 + nr];
    *(u32x4*)(dst + (size_t)(drow0 + nr) * K + k0 + kc) = pack8(f);
  }
  __syncthreads();
}

DI void ph_wt(const Params& P, int u, char* smem) {
  ph_wt_impl(P, u < WT_EARLY ? u : u + (P.wd_tiles - WT_EARLY), smem);
}

DI void ph_lorain(const Params& P, int u, char* smem) {
  const bfu* projA = (const bfu*)(P.ws + OFF_PROJA);
  const int tid = VT;
  if (u < M_TOK / 64) {
    const int lane = tid & 63, wave = tid >> 6;
    const int r0 = (u * 4 + wave) * 16;
    const bfu* ap = (const bfu*)(P.ws + OFF_XB) + (size_t)(r0 + (lane & 15)) * DM + (lane >> 4) * 8;
    const bfu* bp = (const bfu*)(P.ws + WT_IN) + (size_t)(3840 + (lane & 15)) * DM + (lane >> 4) * 8;
    f32x4 acc = f32x4{0.f, 0.f, 0.f, 0.f};
#pragma unroll 8
    for (int ks = 0; ks < 32; ++ks) {
      const bf16x8 af = *(const bf16x8*)(ap + ks * 32);
      const bf16x8 bf = *(const bf16x8*)(bp + ks * 32);
      acc = __builtin_amdgcn_mfma_f32_16x16x32_bf16(af, bf, acc, 0, 0, 0);
    }
    if ((lane & 15) < 8) {
      float* ba = (float*)(P.ws + OFF_BA);
#pragma unroll
      for (int j = 0; j < 4; ++j) ba[(size_t)(r0 + (lane >> 4) * 4 + j) * 8 + (lane & 15)] = acc[j];
    }
    return;
  }
  u -= M_TOK / 64;
  if (u < M_TOK / 16) {
    bfu* lin = (bfu*)(P.ws + OFF_LORAIN);
    const int lane = tid & 63, wave = tid >> 6;
    const int cg = lane & 31, sub = lane >> 5;
    const int mb = u * 16 + wave * 4 + sub * 2;
    const int col = 1536 + cg * 8;
    float mu[8];
    load8f(P.a_mu + col, mu);
    const int t0 = t_of_row(mb);
    u32x4 rows[3];
    if (t0 != 0) rows[0] = *(const u32x4*)(projA + (size_t)(mb - 1) * ASW + col);
#pragma unroll
    for (int i = 0; i < 2; ++i) rows[i + 1] = *(const u32x4*)(projA + (size_t)(mb + i) * ASW + col);
    float prev[8];
    if (t0 != 0) unpack8(rows[0], prev);
    else {
      const int s = seq_of_row(mb);
      if (s < 8) {
#pragma unroll
        for (int e = 0; e < 8; ++e) prev[e] = 0.f;
      } else load8f(P.st_shift + (size_t)(s - 8) * ASW + col, prev);
    }
#pragma unroll
    for (int i = 0; i < 2; ++i) {
      float uc[8], o[8];
      unpack8(rows[i + 1], uc);
#pragma unroll
      for (int e = 0; e < 8; ++e) {
        float xs = uc[e] + (prev[e] - uc[e]) * mu[e];
        o[e] = (cg < 8) ? tanhf(xs) : (cg < 16 ? xs : sigmoidf_(xs));
        prev[e] = uc[e];
      }
      *(u32x4*)(lin + (size_t)(mb + i) * 256 + cg * 8) = pack8(o);
    }
  } else {
    const int s = u - M_TOK / 16;
    const int row0 = row0_of_seq(s), T = T_of_seq(s);
    const bfu* projB = (const bfu*)P.out;
    float* oshift = P.out + (s < 8 ? O_PA_SHIFT + (size_t)s * ASW : O_SA_SHIFT + (size_t)(s - 8) * ASW);
    for (int i = tid; i < ASW; i += 256) oshift[i] = bf2f(projA[(size_t)(row0 + T - 1) * ASW + i]);
    float* oconv = P.out + (s < 8 ? O_PB_CONV + (size_t)s * 3 * BQKV : O_SB_CONV + (size_t)(s - 8) * 3 * BQKV);
    for (int i = tid; i < 3 * BQKV; i += 256) {
      int j = i / BQKV, c = i - j * BQKV;
      oconv[i] = bf2f(projB[(size_t)(row0 + T - 3 + j) * PB_W + c]);
    }
  }
}

DI void ph_lora(const Params& P, int u, char* smem) {
  const int which = u / (MT * 4);
  const int r = u - which * (MT * 4);
  const int mt = r >> 2, nt = r & 3;
  const int m0 = mt * 128, n0 = nt * 128;
  const bfu* lin = (const bfu*)(P.ws + OFF_LORAIN);
  if (which == 0) {
    bfu* stream = (bfu*)(P.ws + OFF_STREAM);
    const float* w0 = P.a_w0;
    gemm_tile<false>(lin + (size_t)m0 * 256, 256, (const bfu*)(P.ws + WT_W2) + (size_t)n0 * 64, 64, m0, n0,
                     (bfu*)smem, [&](int m, int n, f32x4 v) {
                       f32x4 e;
#pragma unroll
                       for (int j = 0; j < 4; ++j) {
                         float w = -softplusf_(-(w0[n + j] + v[j])) - 0.5f;
                         e[j] = __expf(w);
                       }
                       store_bf4(stream + ((size_t)(m * 8 + (n >> 6)) * 6 + 1) * 64 + (n & 63), e);
                     });
  } else if (which == 1) {
    bfu* abuf = (bfu*)(P.ws + OFF_ABUF);
    const float* a0 = P.a_a0;
    gemm_tile<false>(lin + (size_t)m0 * 256 + 64, 256, (const bfu*)(P.ws + WT_A2) + (size_t)n0 * 64, 64, m0, n0,
                     (bfu*)smem, [&](int m, int n, f32x4 v) {
                       f32x4 e;
#pragma unroll
                       for (int j = 0; j < 4; ++j) e[j] = sigmoidf_(a0[n + j] + v[j]);
                       store_bf4(abuf + (size_t)m * 512 + n, e);
                     });
  } else {
    bfu* gbuf = (bfu*)(P.ws + OFF_G);
    gemm_tile<false>(lin + (size_t)m0 * 256 + 128, 256, (const bfu*)(P.ws + WT_G2) + (size_t)n0 * 128, 128, m0, n0,
                     (bfu*)smem, [&](int m, int n, f32x4 v) { store_bf4(gbuf + (size_t)m * 512 + n, v); });
  }
}

DI void ph_prepa(const Params& P, int u, char* smem) {
  const int tid = VT, lane = tid & 63, wave = tid >> 6;
  const int h = lane >> 3, sub = lane & 7;
  const int ch = h * 64 + sub * 8;
  const int m0 = u * 16 + wave * 4;
  const bfu* projA = (const bfu*)(P.ws + OFF_PROJA);
  const bfu* abuf = (const bfu*)(P.ws + OFF_ABUF);
  bfu* stream = (bfu*)(P.ws + OFF_STREAM);
  float mu[3][8], kkc[8], kac[8], rkc[8];
#pragma unroll
  for (int p = 0; p < 3; ++p) load8f(P.a_mu + p * 512 + ch, mu[p]);
  load8f(P.a_k_k + ch, kkc);
  load8f(P.a_k_a + ch, kac);
  load8f(P.a_r_k + ch, rkc);
  float prev[3][8];
  const int t0 = t_of_row(m0);
  if (t0 != 0) {
#pragma unroll
    for (int p = 0; p < 3; ++p) unpack8(*(const u32x4*)(projA + (size_t)(m0 - 1) * ASW + p * 512 + ch), prev[p]);
  } else {
    const int s = seq_of_row(m0);
#pragma unroll
    for (int p = 0; p < 3; ++p) {
      if (s < 8) {
#pragma unroll
        for (int e = 0; e < 8; ++e) prev[p][e] = 0.f;
      } else load8f(P.st_shift + (size_t)(s - 8) * ASW + p * 512 + ch, prev[p]);
    }
  }
#pragma unroll
  for (int g = 0; g < 2; ++g) {
    u32x4 ur[2][3], ar[2];
#pragma unroll
    for (int i = 0; i < 2; ++i) {
      const int m = m0 + g * 2 + i;
#pragma unroll
      for (int p = 0; p < 3; ++p) ur[i][p] = *(const u32x4*)(projA + (size_t)m * ASW + p * 512 + ch);
      ar[i] = *(const u32x4*)(abuf + (size_t)m * 512 + ch);
    }
#pragma unroll
    for (int i = 0; i < 2; ++i) {
      const int m = m0 + g * 2 + i;
      float xs[3][8], a[8];
#pragma unroll
      for (int p = 0; p < 3; ++p) {
        float uc[8];
        unpack8(ur[i][p], uc);
#pragma unroll
        for (int e = 0; e < 8; ++e) {
          xs[p][e] = uc[e] + (prev[p][e] - uc[e]) * mu[p][e];
          prev[p][e] = uc[e];
        }
      }
      unpack8(ar[i], a);
      float kkr[8], k2[8], bb[8];
      float ssl = 0.f, bl = 0.f;
#pragma unroll
      for (int e = 0; e < 8; ++e) {
        kkr[e] = xs[1][e] * kkc[e];
        ssl += kkr[e] * kkr[e];
        k2[e] = xs[1][e] * (1.f + (a[e] - 1.f) * kac[e]);
        bl += xs[0][e] * k2[e] * rkc[e];
      }
      const float rinv = rsqrtf(sum8(ssl) + L2_EPS);
      const float bonus = sum8(bl);
#pragma unroll
      for (int e = 0; e < 8; ++e) {
        kkr[e] *= rinv;
        bb[e] = kkr[e] * a[e];
      }
      bfu* sp = stream + (size_t)(m * 8 + h) * 384 + sub * 8;
      *(u32x4*)(sp) = pack8(xs[0]);
      *(u32x4*)(sp + 128) = pack8(k2);
      *(u32x4*)(sp + 192) = pack8(xs[2]);
      *(u32x4*)(sp + 256) = pack8(kkr);
      *(u32x4*)(sp + 320) = pack8(bb);
      if (sub == 0) ((float*)(P.ws + OFF_BONUS))[m * 8 + h] = bonus;
    }
  }
}

DI void ph_prepb(const Params& P, int u, char* smem) {
  const int tid = VT, lane = tid & 63, wave = tid >> 6;
  const int wt = u * 4 + wave;
  const int tg = wt / 3, p = wt - tg * 3;
  const int h = lane >> 4, sub = lane & 15;
  const int c = p * 512 + h * 128 + sub * 8;
  const int m0 = tg * 8;
  const int s = seq_of_row(m0), t0 = t_of_row(m0);
  const bfu* projB = (const bfu*)P.out;
  bfu* sb = (bfu*)(P.ws + OFF_STREAMB);
  u32x4 rq[11];
#pragma unroll
  for (int i = 0; i < 11; ++i)
    if (t0 + i - 3 >= 0) rq[i] = *(const u32x4*)(projB + (size_t)(m0 + i - 3) * PB_W + c);
  float cw[4][8];
#pragma unroll
  for (int j = 0; j < 4; ++j) load8f(P.b_conv_w + j * BQKV + c, cw[j]);
  float r0[8], r1[8], r2[8], r3[8];
  if (t0 >= 3) {
    unpack8(rq[0], r0);
    unpack8(rq[1], r1);
    unpack8(rq[2], r2);
  } else if (s >= 8) {
    load8f(P.st_bconv + ((size_t)(s - 8) * 3 + 0) * BQKV + c, r0);
    load8f(P.st_bconv + ((size_t)(s - 8) * 3 + 1) * BQKV + c, r1);
    load8f(P.st_bconv + ((size_t)(s - 8) * 3 + 2) * BQKV + c, r2);
  } else {
#pragma unroll
    for (int e = 0; e < 8; ++e) { r0[e] = 0.f; r1[e] = 0.f; r2[e] = 0.f; }
  }
  const float scale = (p == 0) ? 0.08838834764831845f : 1.f;
#pragma unroll
  for (int i = 0; i < 8; ++i) {
    unpack8(rq[i + 3], r3);
    float y[8];
    float ss = 0.f;
#pragma unroll
    for (int e = 0; e < 8; ++e) {
      float a = cw[0][e] * r0[e] + cw[1][e] * r1[e] + cw[2][e] * r2[e] + cw[3][e] * r3[e];
      y[e] = siluf_(a);
      ss += y[e] * y[e];
      r0[e] = r1[e];
      r1[e] = r2[e];
      r2[e] = r3[e];
    }
    if (p < 2) {
      const float rn = rsqrtf(row16_sum(ss) + L2_EPS) * scale;
#pragma unroll
      for (int e = 0; e < 8; ++e) y[e] *= rn;
    }
    *(u32x4*)(sb + (size_t)((m0 + i) * 4 + h) * 384 + p * 128 + sub * 8) = pack8(y);
  }
  if (p == 0 && lane < 32) {
    int i = lane >> 2, hh = lane & 3;
    const float* ba = (const float*)(P.ws + OFF_BA) + (size_t)(m0 + i) * 8;
    float beta = sigmoidf_(ba[hh]);
    float g = -__expf(P.b_a_log[hh]) * softplusf_(ba[4 + hh] + P.b_dt_bias[hh]);
    float* bg = (float*)(P.ws + OFF_BG) + (size_t)(m0 + i) * 8;
    bg[hh] = beta;
    bg[4 + hh] = __expf(g);
    ((float*)(P.ws + OFF_GG))[(size_t)(m0 + i) * 4 + hh] = g;
  }
}

constexpr int CH = 16;
DI void lds_barrier() {
  asm volatile("s_waitcnt lgkmcnt(0)" ::: "memory");
  __builtin_amdgcn_s_barrier();
  asm volatile("" ::: "memory");
}

DI void chunk_gload(u32x4 (&rg)[3], const bfu* base, size_t step_stride, int nsteps) {
#pragma unroll
  for (int j = 0; j < 3; ++j) {
    int idx = VT + 256 * j;
    int st = idx / 48, w = idx - st * 48;
    if (st < nsteps) rg[j] = *(const u32x4*)(base + (size_t)st * step_stride + w * 8);
  }
}
template <bool DECAY>
DI void chunk_lstore(const u32x4 (&rg)[3], float* buf, int nsteps) {
#pragma unroll
  for (int j = 0; j < 3; ++j) {
    int idx = VT + 256 * j;
    int st = idx / 48, w = idx - st * 48;
    if (st < nsteps) {
      float4 a, b;
      a.x = lo_bf(rg[j].x); a.y = hi_bf(rg[j].x); a.z = lo_bf(rg[j].y); a.w = hi_bf(rg[j].y);
      b.x = lo_bf(rg[j].z); b.y = hi_bf(rg[j].z); b.z = lo_bf(rg[j].w); b.w = hi_bf(rg[j].w);
      if (DECAY && (w >> 3) == 1) {
        a.x = __expf(-a.x); a.y = __expf(-a.y); a.z = __expf(-a.z); a.w = __expf(-a.w);
        b.x = __expf(-b.x); b.y = __expf(-b.y); b.z = __expf(-b.z); b.w = __expf(-b.w);
      }
      float* d = buf + st * 384 + w * 8;
      *(float4*)d = a;
      *(float4*)(d + 4) = b;
    }
  }
}

DI float dot4(f32x4 a, f32x4 b) {
  typedef float f2 __attribute__((ext_vector_type(2)));
  const f2 a01 = {a[0], a[1]}, a23 = {a[2], a[3]}, b01 = {b[0], b[1]}, b23 = {b[2], b[3]};
  const f2 t = a23 * b23 + a01 * b01;
  return t[0] + t[1];
}
template <int R> struct RwkvOps { f32x4 r4, w4, k4, kk4, b4; float vv[R]; };
template <int R>
DI void rwkv_ld(RwkvOps<R>& o, const float* b, int j0, int v) {
  o.r4 = *(const f32x4*)(b + j0);
  o.w4 = *(const f32x4*)(b + 64 + j0);
  o.k4 = *(const f32x4*)(b + 128 + j0);
#pragma unroll
  for (int r = 0; r < R; ++r) o.vv[r] = b[192 + v + r * 16];
  o.kk4 = *(const f32x4*)(b + 256 + j0);
  o.b4 = *(const f32x4*)(b + 320 + j0);
}
template <int NS, int R>
DI void rwkv_steps(const float* buf, f32x4 (&S)[R], int j0, int v, int l15, float (&oacc)[R], float* qp) {
  RwkvOps<R> ops[3];
  rwkv_ld<R>(ops[0], buf, j0, v);
  rwkv_ld<R>(ops[1], buf + 384, j0, v);
#pragma unroll
  for (int st = 0; st < NS; ++st) {
    if (st + 2 < NS) rwkv_ld<R>(ops[(st + 2) % 3], buf + (st + 2) * 384, j0, v);
    const RwkvOps<R>& o = ops[st % 3];
    float p[R], q[R];
#pragma unroll
    for (int r = 0; r < R; ++r) p[r] = dot4(S[r], o.kk4);
#pragma unroll
    for (int r = 0; r < R; ++r) p[r] = row16_sum(p[r]);
#pragma unroll
    for (int r = 0; r < R; ++r) {
      const f32x4 base = S[r] * o.w4 + o.k4 * o.vv[r];
      S[r] = base - o.b4 * p[r];
    }
#pragma unroll
    for (int r = 0; r < R; ++r) q[r] = dot4(S[r], o.r4);
    if constexpr (R == 1) {
      qp[st * 64] = q[0];
    } else {
#pragma unroll
      for (int r = 0; r < R; ++r) {
        q[r] = row16_sum(q[r]);
        oacc[r] = (l15 == st) ? q[r] : oacc[r];
      }
    }
  }
  if constexpr (R == 1) {
    asm volatile("" ::: "memory");
    const float* qr = qp + l15 * 64 - l15;
    const f32x4 a = *(const f32x4*)(qr), b = *(const f32x4*)(qr + 4), c = *(const f32x4*)(qr + 8), d = *(const f32x4*)(qr + 12);
    const f32x4 s4 = (a + b) + (c + d);
    oacc[0] = (s4[0] + s4[1]) + (s4[2] + s4[3]);
    asm volatile("" ::: "memory");
  }
}

template <int R>
DI void rwkv_unit(const Params& P, int s, int h, int rgp, char* smem) {
  const int tid = VT, lane = tid & 63, wave = tid >> 6;
  const int T = T_of_seq(s), row0 = row0_of_seq(s);
  const int vl = wave * 4 + (lane >> 4);
  const int v = rgp * (16 * R) + vl;
  const int l15 = lane & 15;
  const int j0 = l15 * 4;
  float* buf0 = (float*)smem;
  float* qp = buf0 + 2 * CH * 384 + wave * (CH * 64) + lane;
  f32x4 S[R];
#pragma unroll
  for (int r = 0; r < R; ++r) {
    if (s < 8) S[r] = f32x4{0.f, 0.f, 0.f, 0.f};
    else S[r] = *(const f32x4*)(P.st_wkv + (((size_t)(s - 8) * 8 + h) * 64 + v + r * 16) * 64 + j0);
  }
  const bfu* stream = (const bfu*)(P.ws + OFF_STREAM) + ((size_t)row0 * 8 + h) * 384;
  const size_t sstride = 8 * 384;
  bfu* omix = (bfu*)(P.ws + OFF_OMIX) + (size_t)row0 * 1024 + h * 64 + v;
  const int nch = (T + CH - 1) / CH;
  u32x4 rg[3], rgB[3], rgC[3];
  chunk_gload(rg, stream, sstride, min(CH, T));
  chunk_lstore<true>(rg, buf0, min(CH, T));
  __syncthreads();
  if (nch > 1) chunk_gload(rg, stream + (size_t)1 * CH * sstride, sstride, min(CH, T - 1 * CH));
  if (nch > 2) chunk_gload(rgB, stream + (size_t)2 * CH * sstride, sstride, min(CH, T - 2 * CH));
  if (nch > 3) chunk_gload(rgC, stream + (size_t)3 * CH * sstride, sstride, min(CH, T - 3 * CH));
  if (R == 1) __builtin_amdgcn_s_setprio(3);
  for (int c = 0; c < nch; ++c) {
    const int nsteps = min(CH, T - c * CH);
    const int nnext = (c + 1 < nch) ? min(CH, T - (c + 1) * CH) : 0;
    const float* buf = buf0 + (c & 1) * CH * 384;
    float oacc[R];
#pragma unroll
    for (int r = 0; r < R; ++r) oacc[r] = 0.f;
    if (nsteps == CH) rwkv_steps<CH, R>(buf, S, j0, v, l15, oacc, qp);
    else rwkv_steps<8, R>(buf, S, j0, v, l15, oacc, qp);
    if (l15 < nsteps) {
#pragma unroll
      for (int r = 0; r < R; ++r) omix[(size_t)(c * CH + l15) * 1024 + r * 16] = f2bf(oacc[r]);
    }
    if (nnext > 0) chunk_lstore<true>(rg, buf0 + ((c + 1) & 1) * CH * 384, nnext);
#pragma unroll
    for (int j = 0; j < 3; ++j) { rg[j] = rgB[j]; rgB[j] = rgC[j]; }
    if (c + 4 < nch) chunk_gload(rgC, stream + (size_t)(c + 4) * CH * sstride, sstride, min(CH, T - (c + 4) * CH));
    lds_barrier();
  }
  if (R == 1) __builtin_amdgcn_s_setprio(0);
  float* o = P.out + (s < 8 ? O_PA_WKV + (((size_t)s * 8 + h) * 64 + v) * 64 + j0
                            : O_SA_WKV + (((size_t)(s - 8) * 8 + h) * 64 + v) * 64 + j0);
#pragma unroll
  for (int r = 0; r < R; ++r) *(f32x4*)(o + (size_t)r * 16 * 64) = S[r];
}

template <int R> struct DeltaOps { f32x4 q0, q1, k0, k1; float vv[R], beta, alpha; };
template <int R>
DI void delta_ld(DeltaOps<R>& o, const float* b, const float* bg, int j0, int c) {
  o.q0 = *(const f32x4*)(b + j0);
  o.q1 = *(const f32x4*)(b + 64 + j0);
  o.k0 = *(const f32x4*)(b + 128 + j0);
  o.k1 = *(const f32x4*)(b + 192 + j0);
#pragma unroll
  for (int r = 0; r < R; ++r) o.vv[r] = b[256 + c + r * 16];
  o.beta = bg[0];
  o.alpha = bg[1];
}
template <int NS, int R>
DI void delta_steps(const float* buf, const float* bgc, f32x4 (&S0)[R], f32x4 (&S1)[R], int j0, int c, int l15,
                    float (&oacc)[R]) {
  DeltaOps<R> ops[3];
  delta_ld<R>(ops[0], buf, bgc, j0, c);
  delta_ld<R>(ops[1], buf + 384, bgc + 2, j0, c);
#pragma unroll
  for (int st = 0; st < NS; ++st) {
    if (st + 2 < NS) delta_ld<R>(ops[(st + 2) % 3], buf + (st + 2) * 384, bgc + (st + 2) * 2, j0, c);
    const DeltaOps<R>& o = ops[st % 3];
    float p[R], q[R];
#pragma unroll
    for (int r = 0; r < R; ++r) {
      const f32x4 t0 = S0[r] * o.k0 + S1[r] * o.k1;
      p[r] = (t0[0] + t0[1]) + (t0[2] + t0[3]);
    }
#pragma unroll
    for (int r = 0; r < R; ++r) p[r] = row16_sum(p[r]);
#pragma unroll
    for (int r = 0; r < R; ++r) {
      const float vn = o.beta * (o.vv[r] - o.alpha * p[r]);
      S0[r] = S0[r] * o.alpha + o.k0 * vn;
      S1[r] = S1[r] * o.alpha + o.k1 * vn;
      const f32x4 t1 = S0[r] * o.q0 + S1[r] * o.q1;
      q[r] = (t1[0] + t1[1]) + (t1[2] + t1[3]);
    }
#pragma unroll
    for (int r = 0; r < R; ++r) {
      q[r] = row16_sum(q[r]);
      oacc[r] = (l15 == st) ? q[r] : oacc[r];
    }
  }
}

template <int R>
DI void delta_unit(const Params& P, int s, int h, int cg_, char* smem) {
  const int tid = VT, lane = tid & 63, wave = tid >> 6;
  const int T = T_of_seq(s), row0 = row0_of_seq(s);
  const int cl = wave * 4 + (lane >> 4);
  const int c = cg_ * (16 * R) + cl;
  const int l15 = lane & 15;
  const int j0 = l15 * 4;
  float* buf0 = (float*)smem;
  float* bgb = buf0 + 2 * CH * 384;
  f32x4 S0[R], S1[R];
#pragma unroll
  for (int r = 0; r < R; ++r) {
    if (s < 8) {
      S0[r] = f32x4{0.f, 0.f, 0.f, 0.f};
      S1[r] = S0[r];
    } else {
      const float* sp = P.st_ssm + (((size_t)(s - 8) * 4 + h) * 128 + j0) * 128 + c + r * 16;
#pragma unroll
      for (int i = 0; i < 4; ++i) { S0[r][i] = sp[(size_t)i * 128]; S1[r][i] = sp[(size_t)(i + 64) * 128]; }
    }
  }
  const bfu* stream = (const bfu*)(P.ws + OFF_STREAMB) + ((size_t)row0 * 4 + h) * 384;
  const size_t sstride = 4 * 384;
  const float* bg = (const float*)(P.ws + OFF_BG);
  bfu* omix = (bfu*)(P.ws + OFF_OMIX) + (size_t)row0 * 1024 + 512 + h * 128 + c;
  const int nch = (T + CH - 1) / CH;
  u32x4 rg[3];
  float bgr = 0.f;
  {
    int n0 = min(CH, T);
    chunk_gload(rg, stream, sstride, n0);
    if (tid < n0 * 2) bgr = bg[(size_t)(row0 + (tid >> 1)) * 8 + (tid & 1) * 4 + h];
    chunk_lstore<false>(rg, buf0, n0);
    if (tid < n0 * 2) bgb[tid] = bgr;
  }
  __syncthreads();
  for (int ci = 0; ci < nch; ++ci) {
    const int nsteps = min(CH, T - ci * CH);
    const int nnext = (ci + 1 < nch) ? min(CH, T - (ci + 1) * CH) : 0;
    if (nnext > 0) {
      chunk_gload(rg, stream + (size_t)(ci + 1) * CH * sstride, sstride, nnext);
      if (tid < nnext * 2) bgr = bg[(size_t)(row0 + (ci + 1) * CH + (tid >> 1)) * 8 + (tid & 1) * 4 + h];
    }
    const float* buf = buf0 + (ci & 1) * CH * 384;
    const float* bgc = bgb + (ci & 1) * CH * 2;
    float oacc[R];
#pragma unroll
    for (int r = 0; r < R; ++r) oacc[r] = 0.f;
    if (nsteps == CH) delta_steps<CH, R>(buf, bgc, S0, S1, j0, c, l15, oacc);
    else delta_steps<8, R>(buf, bgc, S0, S1, j0, c, l15, oacc);
    if (l15 < nsteps) {
#pragma unroll
      for (int r = 0; r < R; ++r) omix[(size_t)(ci * CH + l15) * 1024 + r * 16] = f2bf(oacc[r]);
    }
    if (nnext > 0) {
      chunk_lstore<false>(rg, buf0 + ((ci + 1) & 1) * CH * 384, nnext);
      if (tid < nnext * 2) bgb[((ci + 1) & 1) * CH * 2 + tid] = bgr;
    }
    lds_barrier();
  }
  float* o = P.out + (s < 8 ? O_PB_SSM + (((size_t)s * 4 + h) * 128 + j0) * 128 + c
                            : O_SB_SSM + (((size_t)(s - 8) * 4 + h) * 128 + j0) * 128 + c);
#pragma unroll
  for (int r = 0; r < R; ++r)
#pragma unroll
    for (int i = 0; i < 4; ++i) { o[(size_t)i * 128 + r * 16] = S0[r][i]; o[(size_t)(i + 64) * 128 + r * 16] = S1[r][i]; }
}

constexpr int DLD = 136;
template <int I> struct SubStep {
  static DI void run(float (&sol)[64], const float* Lm, const float* scp, const bfu* colp) {
    SubStep<I - 1>::run(sol, Lm, scp, colp);
    float a0 = bf2f(colp[I * 136]) * scp[I], a1 = 0.f;
#pragma unroll
    for (int j4 = 0; j4 < (I + 3) / 4; ++j4) {
      const f32x4 l = *(const f32x4*)(Lm + I * 68 + j4 * 4);
      if (j4 * 4 + 0 < I) a0 -= l[0] * sol[j4 * 4 + 0];
      if (j4 * 4 + 1 < I) a1 -= l[1] * sol[j4 * 4 + 1];
      if (j4 * 4 + 2 < I) a0 -= l[2] * sol[j4 * 4 + 2];
      if (j4 * 4 + 3 < I) a1 -= l[3] * sol[j4 * 4 + 3];
      if ((j4 & 3) == 3) { asm volatile("" ::: "memory"); __builtin_amdgcn_sched_barrier(0); }
    }
    sol[I] = a0 + a1;
    asm volatile("" ::: "memory");
    __builtin_amdgcn_sched_barrier(0);
  }
};
template <> struct SubStep<-1> {
  static DI void run(float (&)[64], const float*, const float*, const bfu*) {}
};

DI void delta_d1(const Params& P, int item, char* smem) {
  int tid_ = VT; asm volatile("" : "+v"(tid_));
  const int tid = tid_, lane = tid & 63, wave = tid >> 6;
  const int chunk = item & 31, h = (item >> 5) & 3, s = item >> 7;
  const int m0 = s * 2048 + chunk * 64;
  bfu* Qs = (bfu*)smem;
  bfu* Ks = Qs + 64 * DLD;
  bfu* Vs = Ks + 64 * DLD;
  float* Lm = (float*)(Vs + 64 * DLD);
  float* Gs = Lm + 64 * 68;
  float* Bs = Gs + 64;
  float* Bk = Bs + 64;
  bfu* sb = (bfu*)(P.ws + OFF_STREAMB);
  bfu* projB = (bfu*)P.out;
#pragma unroll
  for (int j = 0; j < 4; ++j) {
    const int idx = tid + 256 * j, row = idx >> 4, c8 = (idx & 15) * 8;
    const bfu* sp = sb + ((size_t)(m0 + row) * 4 + h) * 384 + c8;
    *(u32x4*)(Qs + row * DLD + c8) = *(const u32x4*)sp;
    *(u32x4*)(Ks + row * DLD + c8) = *(const u32x4*)(sp + 128);
    *(u32x4*)(Vs + row * DLD + c8) = *(const u32x4*)(sp + 256);
  }
  if (wave == 0) {
    float x = ((const float*)(P.ws + OFF_GG))[(size_t)(m0 + lane) * 4 + h];
#pragma unroll
    for (int off = 1; off < 64; off <<= 1) {
      const float y = __shfl_up(x, off, 64);
      if (lane >= off) x += y;
    }
    Gs[lane] = x;
    ((float*)(projB + (size_t)(m0 + lane) * PB_W + 768))[h] = x;
    const float be = ((const float*)(P.ws + OFF_BG))[(size_t)(m0 + lane) * 8 + h];
    Bs[lane] = be;
    Bk[lane] = be * __expf(x);
  }
  __syncthreads();
  {
#pragma unroll 1
    for (int nt = 0; nt < 4; ++nt) {
      f32x4 akk = f32x4{0.f, 0.f, 0.f, 0.f}, aqk = akk;
#pragma unroll
      for (int ks = 0; ks < 4; ++ks) {
        const int ko = ks * 32 + (lane >> 4) * 8;
        const bf16x8 ak = *(const bf16x8*)(Ks + (16 * wave + (lane & 15)) * DLD + ko);
        const bf16x8 aq = *(const bf16x8*)(Qs + (16 * wave + (lane & 15)) * DLD + ko);
        const bf16x8 b = *(const bf16x8*)(Ks + (16 * nt + (lane & 15)) * DLD + ko);
        akk = __builtin_amdgcn_mfma_f32_16x16x32_bf16(ak, b, akk, 0, 0, 0);
        aqk = __builtin_amdgcn_mfma_f32_16x16x32_bf16(aq, b, aqk, 0, 0, 0);
      }
#pragma unroll
      for (int j = 0; j < 4; ++j) {
        const int i = 16 * wave + (lane >> 4) * 4 + j, jj = 16 * nt + (lane & 15);
        const float e = __expf(fminf(Gs[i] - Gs[jj], 0.f));
        Lm[i * 68 + jj] = (jj < i) ? Bs[i] * akk[j] * e : 0.f;
        projB[(size_t)(m0 + i) * PB_W + 512 + h * 64 + jj] = f2bf((jj <= i) ? aqk[j] * e : 0.f);
      }
    }
  }
  __syncthreads();
  {
    const bool isv = tid < 128;
    const bfu* colp = isv ? Vs + tid : Ks + (tid - 128);
    float sol[64];
    SubStep<63>::run(sol, Lm, isv ? Bs : Bk, colp);
    __syncthreads();
    bfu* Ob = (bfu*)smem;
#pragma unroll
    for (int i = 0; i < 64; ++i) Ob[i * 264 + tid] = f2bf(sol[i]);
  }
  __syncthreads();
  {
    const bfu* Ob = (const bfu*)smem;
#pragma unroll
    for (int j = 0; j < 8; ++j) {
      const int idx = tid + 256 * j, row = idx >> 5, c8 = (idx & 31) * 8;
      const u32x4 v = *(const u32x4*)(Ob + row * 264 + c8);
      if (c8 < 128) *(u32x4*)(sb + ((size_t)(m0 + row) * 4 + h) * 384 + 256 + c8) = v;
      else *(u32x4*)(projB + (size_t)(m0 + row) * PB_W + h * 128 + (c8 - 128)) = v;
    }
  }
  __syncthreads();
}

DI void delta_d2(const Params& P, int s, int h, int cg_, char* smem) {
  int tid_ = VT; asm volatile("" : "+v"(tid_));
  const int tid = tid_, lane = tid & 63, wave = tid >> 6;
  const int r16 = lane & 15, q4 = lane >> 4;
  bfu* Ws = (bfu*)smem;
  bfu* Qs = Ws + 64 * DLD;
  bfu* KT = Qs + 64 * DLD;
  bfu* AT = KT + 128 * 72;
  bfu* VnT = AT + 64 * 72;
  bfu* ST = VnT + 16 * 72;
  float* Us = (float*)(ST + 16 * DLD);
  const int row0 = s * 2048, col0 = cg_ * 16;
  const bfu* sb = (const bfu*)(P.ws + OFF_STREAMB);
  const bfu* projB = (const bfu*)P.out;
  bfu* omix = (bfu*)(P.ws + OFF_OMIX);
  f32x4 accS[2];
  accS[0] = f32x4{0.f, 0.f, 0.f, 0.f};
  accS[1] = accS[0];
  for (int i = tid; i < 16 * DLD / 2; i += 256) ((unsigned*)ST)[i] = 0u;
  u32x4 rw[4], rq[4], rk[4], ra[2], ru;
  float gj[4], gk = 0.f, glast = 0.f, glcur = 0.f;
#define D2_PREFETCH(cc)                                                                                   \
  {                                                                                                       \
    const int mb = row0 + (cc) * 64;                                                                      \
    _Pragma("unroll") for (int j = 0; j < 4; ++j) {                                                       \
      const int idx = tid + 256 * j, row = idx >> 4, c8 = (idx & 15) * 8;                                 \
      const size_t m = (size_t)(mb + row);                                                                \
      rw[j] = *(const u32x4*)(projB + m * PB_W + h * 128 + c8);                                           \
      rq[j] = *(const u32x4*)(sb + (m * 4 + h) * 384 + c8);                                               \
      gj[j] = ((const float*)(projB + m * PB_W + 768))[h];                                                \
      rk[j] = *(const u32x4*)(sb + ((size_t)(mb + (tid & 63)) * 4 + h) * 384 + 128 + ((tid >> 6) + 4 * j) * 8); \
    }                                                                                                     \
    gk = ((const float*)(projB + (size_t)(mb + (tid & 63)) * PB_W + 768))[h];                             \
    _Pragma("unroll") for (int j = 0; j < 2; ++j) {                                                       \
      const int idx = tid + 256 * j, row = idx >> 3, c8 = (idx & 7) * 8;                                  \
      ra[j] = *(const u32x4*)(projB + (size_t)(mb + row) * PB_W + 512 + h * 64 + c8);                     \
    }                                                                                                     \
    if (tid < 128) ru = *(const u32x4*)(sb + ((size_t)(mb + (tid >> 1)) * 4 + h) * 384 + 256 + col0 + (tid & 1) * 8); \
    glast = ((const float*)(projB + (size_t)(mb + 63) * PB_W + 768))[h];                                  \
  }
#define D2_STAGE1()                                                                                       \
  {                                                                                                       \
    const float ek = __expf(glast - gk);                                                                  \
    _Pragma("unroll") for (int j = 0; j < 4; ++j) {                                                       \
      const int c8 = ((tid >> 6) + 4 * j) * 8;                                                            \
      float f[8];                                                                                         \
      unpack8(rk[j], f);                                                                                  \
      _Pragma("unroll") for (int e = 0; e < 8; ++e) KT[(c8 + e) * 72 + (tid & 63)] = f2bf(f[e] * ek);     \
    }                                                                                                     \
  }
#define D2_STAGE2()                                                                                       \
  {                                                                                                       \
    _Pragma("unroll") for (int j = 0; j < 4; ++j) {                                                       \
      const int idx = tid + 256 * j, row = idx >> 4, c8 = (idx & 15) * 8;                                 \
      *(u32x4*)(Ws + row * DLD + c8) = rw[j];                                                             \
      const float eq = __expf(gj[j]);                                                                     \
      float f[8];                                                                                         \
      unpack8(rq[j], f);                                                                                  \
      _Pragma("unroll") for (int e = 0; e < 8; ++e) f[e] *= eq;                                           \
      *(u32x4*)(Qs + row * DLD + c8) = pack8(f);                                                          \
    }                                                                                                     \
    _Pragma("unroll") for (int j = 0; j < 2; ++j) {                                                       \
      const int idx = tid + 256 * j, row = idx >> 3, c8 = (idx & 7) * 8;                                  \
      *(u32x4*)(AT + row * 72 + c8) = ra[j];                                                              \
    }                                                                                                     \
    if (tid < 128) {                                                                                      \
      float f[8];                                                                                         \
      unpack8(ru, f);                                                                                     \
      float* up = Us + (tid >> 1) * 16 + (tid & 1) * 8;                                                   \
      *(f32x4*)up = f32x4{f[0], f[1], f[2], f[3]};                                                        \
      *(f32x4*)(up + 4) = f32x4{f[4], f[5], f[6], f[7]};                                                  \
    }                                                                                                     \
    glcur = glast;                                                                                        \
  }
  D2_PREFETCH(0);
  D2_STAGE1();
  D2_STAGE2();
  D2_PREFETCH(1);
  __syncthreads();
  for (int c = 0; c < 32; ++c) {
    f32x4 av = f32x4{0.f, 0.f, 0.f, 0.f}, ao = av;
#pragma unroll
    for (int ks = 0; ks < 4; ++ks) {
      const int ko = ks * 32 + q4 * 8;
      const bf16x8 bw = *(const bf16x8*)(Ws + (16 * wave + r16) * DLD + ko);
      const bf16x8 bq = *(const bf16x8*)(Qs + (16 * wave + r16) * DLD + ko);
      const bf16x8 bs = *(const bf16x8*)(ST + r16 * DLD + ko);
      av = __builtin_amdgcn_mfma_f32_16x16x32_bf16(bw, bs, av, 0, 0, 0);
      ao = __builtin_amdgcn_mfma_f32_16x16x32_bf16(bq, bs, ao, 0, 0, 0);
    }
    {
      const int tk = 16 * wave + q4 * 4;
      float vn[4];
#pragma unroll
      for (int j = 0; j < 4; ++j) vn[j] = Us[(tk + j) * 16 + r16] - av[j];
      *(uint2*)(VnT + r16 * 72 + tk) = uint2{pack2(vn[0], vn[1]), pack2(vn[2], vn[3])};
    }
    lds_barrier();
    bf16x8 bv[2];
#pragma unroll
    for (int ks = 0; ks < 2; ++ks) {
      bv[ks] = *(const bf16x8*)(VnT + r16 * 72 + ks * 32 + q4 * 8);
      const bf16x8 ba = *(const bf16x8*)(AT + (16 * wave + r16) * 72 + ks * 32 + q4 * 8);
      ao = __builtin_amdgcn_mfma_f32_16x16x32_bf16(ba, bv[ks], ao, 0, 0, 0);
    }
    {
      bfu* op = omix + (size_t)(row0 + c * 64 + 16 * wave + q4 * 4) * 1024 + 512 + h * 128 + col0 + r16;
#pragma unroll
      for (int j = 0; j < 4; ++j) op[(size_t)j * 1024] = f2bf(ao[j]);
    }
    {
      const float gl = __expf(glcur);
#pragma unroll
      for (int t = 0; t < 2; ++t) {
        accS[t] = accS[t] * gl;
#pragma unroll
        for (int ks = 0; ks < 2; ++ks) {
          const bf16x8 bk = *(const bf16x8*)(KT + (16 * (2 * wave + t) + r16) * 72 + ks * 32 + q4 * 8);
          accS[t] = __builtin_amdgcn_mfma_f32_16x16x32_bf16(bv[ks], bk, accS[t], 0, 0, 0);
        }
      }
    }
    lds_barrier();
#pragma unroll
    for (int t = 0; t < 2; ++t)
#pragma unroll
      for (int j = 0; j < 4; ++j) ST[(q4 * 4 + j) * DLD + 16 * (2 * wave + t) + r16] = f2bf(accS[t][j]);
    if (c + 1 < 32) D2_STAGE1();
    lds_barrier();
    if (c + 1 < 32) D2_STAGE2();
    if (c + 2 < 32) D2_PREFETCH(c + 2);
    lds_barrier();
  }
#undef D2_PREFETCH
#undef D2_STAGE1
#undef D2_STAGE2
  float* o = P.out + O_PB_SSM + ((size_t)(s * 4 + h) * 128) * 128 + col0;
#pragma unroll
  for (int t = 0; t < 2; ++t)
#pragma unroll
    for (int j = 0; j < 4; ++j) o[(size_t)(16 * (2 * wave + t) + r16) * 128 + q4 * 4 + j] = accS[t][j];
}

DI void ph_d1(const Params& P, int u, char* smem) { delta_d1(P, u, smem); }

DI void ph_scan(const Params& P, int u, char* smem) {
  const int k = u >> 1;
  if (k < 256) {
    if (u & 1) delta_d2(P, k >> 5, (k >> 3) & 3, k & 7, smem);
    else rwkv_unit<1>(P, k >> 5, (k >> 2) & 7, k & 3, smem);
  } else {
    const int j = k - 256;
    if (u & 1) delta_unit<4>(P, 8 + (j >> 3), (j >> 1) & 3, j & 1, smem);
    else rwkv_unit<4>(P, 8 + (j >> 3), j & 7, 0, smem);
  }
}

DI void ph_post(const Params& P, int u, char* smem) {
  const int tid = VT, lane = tid & 63, wave = tid >> 6;
  const int m0 = u * 8 + wave * 2;
  bfu* omix = (bfu*)(P.ws + OFF_OMIX);
  {
    const int h = lane >> 3, sub = lane & 7, ch = h * 64 + sub * 8;
    float gng[8], gnb[8];
    load8f(P.a_gn_g + ch, gng);
    load8f(P.a_gn_b + ch, gnb);
    u32x4 oq[2], vq[2], gq[2];
    float bon[2];
#pragma unroll
    for (int i = 0; i < 2; ++i) {
      const int m = m0 + i;
      oq[i] = *(const u32x4*)(omix + (size_t)m * 1024 + ch);
      vq[i] = *(const u32x4*)((const bfu*)(P.ws + OFF_STREAM) + (size_t)(m * 8 + h) * 384 + 192 + sub * 8);
      gq[i] = *(const u32x4*)((const bfu*)(P.ws + OFF_G) + (size_t)m * 512 + ch);
      bon[i] = ((const float*)(P.ws + OFF_BONUS))[m * 8 + h];
    }
#pragma unroll
    for (int i = 0; i < 2; ++i) {
      float o[8], v[8], g[8], r[8];
      unpack8(oq[i], o);
      unpack8(vq[i], v);
      unpack8(gq[i], g);
      float s = 0.f;
#pragma unroll
      for (int e = 0; e < 8; ++e) s += o[e];
      const float mean = sum8(s) * (1.f / 64.f);
      float q = 0.f;
#pragma unroll
      for (int e = 0; e < 8; ++e) {
        o[e] -= mean;
        q += o[e] * o[e];
      }
      const float rs = rsqrtf(sum8(q) * (1.f / 64.f) + GN_EPS);
#pragma unroll
      for (int e = 0; e < 8; ++e) r[e] = ((o[e] * rs * gng[e] + gnb[e]) + bon[i] * v[e]) * g[e];
      *(u32x4*)(omix + (size_t)(m0 + i) * 1024 + ch) = pack8(r);
    }
  }
  {
    const int h = lane >> 4, sub = lane & 15, ch = h * 128 + sub * 8;
    float ng[8];
    load8f(P.b_norm_g + sub * 8, ng);
    u32x4 oq[2], zq[2];
#pragma unroll
    for (int i = 0; i < 2; ++i) {
      const int m = m0 + i;
      oq[i] = *(const u32x4*)(omix + (size_t)m * 1024 + 512 + ch);
      zq[i] = *(const u32x4*)((const bfu*)P.out + (size_t)m * PB_W + 1536 + ch);
    }
#pragma unroll
    for (int i = 0; i < 2; ++i) {
      float o[8], z[8], r[8];
      unpack8(oq[i], o);
      unpack8(zq[i], z);
      float q = 0.f;
#pragma unroll
      for (int e = 0; e < 8; ++e) q += o[e] * o[e];
      const float rinv = rsqrtf(row16_sum(q) * (1.f / 128.f) + RMS_EPS);
#pragma unroll
      for (int e = 0; e < 8; ++e) r[e] = o[e] * rinv * ng[e] * siluf_(z[e]);
      *(u32x4*)(omix + (size_t)(m0 + i) * 1024 + 512 + ch) = pack8(r);
    }
  }
}

DI void ln_rows4(const float* src, float* dst, bfu* dstb, const float* g, const float* b, int lane) {
  f32x4 v[4][4];
#pragma unroll
  for (int r = 0; r < 4; ++r)
#pragma unroll
    for (int i = 0; i < 4; ++i) v[r][i] = *(const f32x4*)(src + (size_t)r * DM + i * 256 + lane * 4);
  f32x4 gg[4], bb[4];
#pragma unroll
  for (int i = 0; i < 4; ++i) {
    gg[i] = *(const f32x4*)(g + i * 256 + lane * 4);
    bb[i] = *(const f32x4*)(b + i * 256 + lane * 4);
  }
#pragma unroll
  for (int r = 0; r < 4; ++r) {
    float s = 0.f;
#pragma unroll
    for (int i = 0; i < 4; ++i) s += (v[r][i][0] + v[r][i][1]) + (v[r][i][2] + v[r][i][3]);
    const float mean = wave_sum(s) * (1.f / 1024.f);
    float q = 0.f;
#pragma unroll
    for (int i = 0; i < 4; ++i) {
      v[r][i] = v[r][i] - mean;
      q += (v[r][i][0] * v[r][i][0] + v[r][i][1] * v[r][i][1]) + (v[r][i][2] * v[r][i][2] + v[r][i][3] * v[r][i][3]);
    }
    const float rstd = rsqrtf(wave_sum(q) * (1.f / 1024.f) + LN_EPS);
#pragma unroll
    for (int i = 0; i < 4; ++i) {
      const f32x4 o = v[r][i] * rstd * gg[i] + bb[i];
      if (dst) *(f32x4*)(dst + (size_t)r * DM + i * 256 + lane * 4) = o;
      store_bf4(dstb + (size_t)r * DM + i * 256 + lane * 4, o);
    }
  }
}

template <int NR>
DI void ln_rowsb(const bfu* src, bfu* dst, const float* g, const float* b, int lane) {
  u32x4 q[NR][2];
#pragma unroll
  for (int r = 0; r < NR; ++r)
#pragma unroll
    for (int i = 0; i < 2; ++i) q[r][i] = *(const u32x4*)(src + (size_t)r * DM + i * 512 + lane * 8);
  float gg[2][8], bb[2][8];
#pragma unroll
  for (int i = 0; i < 2; ++i) {
    load8f(g + i * 512 + lane * 8, gg[i]);
    load8f(b + i * 512 + lane * 8, bb[i]);
  }
#pragma unroll
  for (int r = 0; r < NR; ++r) {
    float v[2][8];
    unpack8(q[r][0], v[0]);
    unpack8(q[r][1], v[1]);
    float s = 0.f;
#pragma unroll
    for (int i = 0; i < 2; ++i)
#pragma unroll
      for (int e = 0; e < 8; ++e) s += v[i][e];
    const float mean = wave_sum(s) * (1.f / 1024.f);
    float sq = 0.f;
#pragma unroll
    for (int i = 0; i < 2; ++i)
#pragma unroll
      for (int e = 0; e < 8; ++e) {
        v[i][e] -= mean;
        sq += v[i][e] * v[i][e];
      }
    const float rstd = rsqrtf(wave_sum(sq) * (1.f / 1024.f) + LN_EPS);
#pragma unroll
    for (int i = 0; i < 2; ++i) {
      float o[8];
#pragma unroll
      for (int e = 0; e < 8; ++e) o[e] = v[i][e] * rstd * gg[i][e] + bb[i][e];
      *(u32x4*)(dst + (size_t)r * DM + i * 512 + lane * 8) = pack8(o);
    }
  }
}

template <bool RESF>
DI void ln_row_slabs(const float* slabrow, const void* res, bfu* dst, const float* g, const float* b, int lane) {
  f32x4 v[4];
#pragma unroll
  for (int i = 0; i < 4; ++i) {
    const int co = i * 256 + lane * 4;
    f32x4 r;
    if constexpr (RESF) r = *(const f32x4*)((const float*)res + co);
    else {
      const uint2 q = *(const uint2*)((const bfu*)res + co);
      r = f32x4{lo_bf(q.x), hi_bf(q.x), lo_bf(q.y), hi_bf(q.y)};
    }
    const f32x4 s0 = *(const f32x4*)(slabrow + co), s1 = *(const f32x4*)(slabrow + (size_t)1024 * 1024 + co);
    const f32x4 s2 = *(const f32x4*)(slabrow + (size_t)2 * 1024 * 1024 + co), s3 = *(const f32x4*)(slabrow + (size_t)3 * 1024 * 1024 + co);
    v[i] = r * DN_ALPHA + ((s0 + s1) + (s2 + s3));
  }
  float s = 0.f;
#pragma unroll
  for (int i = 0; i < 4; ++i) s += (v[i][0] + v[i][1]) + (v[i][2] + v[i][3]);
  const float mean = wave_sum(s) * (1.f / 1024.f);
  float q = 0.f;
#pragma unroll
  for (int i = 0; i < 4; ++i) {
    v[i] = v[i] - mean;
    q += (v[i][0] * v[i][0] + v[i][1] * v[i][1]) + (v[i][2] * v[i][2] + v[i][3] * v[i][3]);
  }
  const float rstd = rsqrtf(wave_sum(q) * (1.f / 1024.f) + LN_EPS);
#pragma unroll
  for (int i = 0; i < 4; ++i) {
    const int co = i * 256 + lane * 4;
    const f32x4 gg = *(const f32x4*)(g + co), bb = *(const f32x4*)(b + co);
    store_bf4(dst + co, v[i] * rstd * gg + bb);
  }
}
#define SLABS(P) ((P).out + (size_t)M_TOK * 512)

DI void ph_ln1(const Params& P, int u, char* smem) {
  const int lane = VT & 63, wave = VT >> 6;
  const int m = u * 8 + wave * 2;
  if (m >= M_P) {
    for (int r = 0; r < 2; ++r) {
      const int rs = m - M_P + r;
      ln_row_slabs<true>(SLABS(P) + (size_t)rs * DM, P.x_s + (size_t)rs * DM, (bfu*)(P.ws + OFF_X1B) + (size_t)(m + r) * DM,
                         P.ln1_g, P.ln1_b, lane);
    }
    return;
  }
  ln_rowsb<2>((const bfu*)P.out + (size_t)m * DM, (bfu*)(P.ws + OFF_X1B) + (size_t)m * DM, P.ln1_g, P.ln1_b, lane);
}

DI void ffnconv_slot(const Params& P, int slot) {
  const int tg = slot / 352, cs = slot - tg * 352;
  const int m0 = tg * 8, c = cs * 8;
  const int s = seq_of_row(m0), t0 = t_of_row(m0);
  const int T = T_of_seq(s);
  bfu* gu = (bfu*)(P.ws + OFF_GU);
  u32x4 gq[10], uq[8];
#pragma unroll
  for (int i = 0; i < 10; ++i)
    if (t0 + i - 2 >= 0) gq[i] = *(const u32x4*)(gu + (size_t)(m0 + i - 2) * 5632 + c);
#pragma unroll
  for (int i = 0; i < 8; ++i) uq[i] = *(const u32x4*)(gu + (size_t)(m0 + i) * 5632 + DFF + c);
  float w[3][8], fb[8];
#pragma unroll
  for (int j = 0; j < 3; ++j) load8f(P.f_conv_w + j * DFF + c, w[j]);
  load8f(P.f_conv_b + c, fb);
  float g0[8], g1[8], g2[8];
  if (t0 >= 2) {
    unpack8(gq[0], g0);
    unpack8(gq[1], g1);
  } else if (s >= 8) {
    load8f(P.st_fconv + ((size_t)(s - 8) * 2 + 0) * DFF + c, g0);
    load8f(P.st_fconv + ((size_t)(s - 8) * 2 + 1) * DFF + c, g1);
  } else {
#pragma unroll
    for (int e = 0; e < 8; ++e) { g0[e] = 0.f; g1[e] = 0.f; }
  }
#pragma unroll
  for (int i = 0; i < 8; ++i) {
    float up[8], hh[8];
    unpack8(gq[i + 2], g2);
    unpack8(uq[i], up);
#pragma unroll
    for (int e = 0; e < 8; ++e) {
      float a = w[0][e] * g0[e] + w[1][e] * g1[e] + w[2][e] * g2[e] + fb[e];
      hh[e] = siluf_(a) * up[e];
      g0[e] = g1[e];
      g1[e] = g2[e];
    }
    *(u32x4*)(gu + (size_t)(m0 + i) * 5632 + DFF + c) = pack8(hh);
  }
  if (t0 + 8 == T) {
    float* ostate = P.out + (s < 8 ? O_PF_CONV + (size_t)s * 2 * DFF : O_SF_CONV + (size_t)(s - 8) * 2 * DFF);
    *(f32x4*)(ostate + c) = f32x4{g0[0], g0[1], g0[2], g0[3]};
    *(f32x4*)(ostate + c + 4) = f32x4{g0[4], g0[5], g0[6], g0[7]};
    *(f32x4*)(ostate + DFF + c) = f32x4{g1[0], g1[1], g1[2], g1[3]};
    *(f32x4*)(ostate + DFF + c + 4) = f32x4{g1[4], g1[5], g1[6], g1[7]};
  }
}

DI void ph_ffnconv(const Params& P, int u, char* smem) {
  if (u >= 352) {
    ffnconv_slot(P, 2048 * 352 + (u - 352) * 256 + VT);
    return;
  }
  const int slot = u * 256 + VT;
  const int slab = slot / 352, c = (slot - slab * 352) * 8;
  const bfu* hg = FFN_HG(P);
  const bfu* hu = FFN_HU(P);
  bfu* gu = (bfu*)(P.ws + OFF_GU);
  float w0[8], w1[8], w2[8], fb[8];
  load8f(P.f_conv_w + c, w0);
  load8f(P.f_conv_w + DFF + c, w1);
  load8f(P.f_conv_w + 2 * DFF + c, w2);
  load8f(P.f_conv_b + c, fb);
  float a2[8], a1[8], c0[8], c1[8], u0[8], u1[8];
  if ((slab & 31) != 0) {
    unpack8(*(const u32x4*)(hg + ((size_t)(slab - 1) * 4 + 0) * DFF + c), a2);
    unpack8(*(const u32x4*)(hg + ((size_t)(slab - 1) * 4 + 1) * DFF + c), a1);
  } else {
#pragma unroll
    for (int e = 0; e < 8; ++e) { a2[e] = 0.f; a1[e] = 0.f; }
  }
  unpack8(*(const u32x4*)(hg + ((size_t)slab * 4 + 2) * DFF + c), c0);
  unpack8(*(const u32x4*)(hg + ((size_t)slab * 4 + 3) * DFF + c), c1);
  unpack8(*(const u32x4*)(hu + ((size_t)slab * 2 + 0) * DFF + c), u0);
  unpack8(*(const u32x4*)(hu + ((size_t)slab * 2 + 1) * DFF + c), u1);
  float h0[8], h1[8];
#pragma unroll
  for (int e = 0; e < 8; ++e) {
    h0[e] = siluf_(w0[e] * a2[e] + w1[e] * a1[e] + w2[e] * c0[e] + fb[e]) * u0[e];
    h1[e] = siluf_(w0[e] * a1[e] + w1[e] * c0[e] + w2[e] * c1[e] + fb[e]) * u1[e];
  }
  *(u32x4*)(gu + (size_t)(slab * 64) * (2 * DFF) + DFF + c) = pack8(h0);
  *(u32x4*)(gu + (size_t)(slab * 64 + 1) * (2 * DFF) + DFF + c) = pack8(h1);
}

DI void ph_ln2_ple(const Params& P, int u, char* smem) {
  const int lane = VT & 63, wave = VT >> 6;
  const int m = u * 8 + wave * 2;
  if (m >= M_P) {
    for (int r = 0; r < 2; ++r) {
      const int rs = m - M_P + r;
      ln_row_slabs<false>(SLABS(P) + (size_t)rs * DM, (const bfu*)(P.ws + OFF_X1B) + (size_t)(m + r) * DM,
                          (bfu*)(P.ws + OFF_X2B) + (size_t)(m + r) * DM, P.ln2_g, P.ln2_b, lane);
    }
    return;
  }
  ln_rowsb<2>((const bfu*)P.out + (size_t)m * DM, (bfu*)(P.ws + OFF_X2B) + (size_t)m * DM, P.ln2_g, P.ln2_b, lane);
}

DI void ph_rinv(const Params& P, int u, char* smem) {
  const int lane = VT & 63, wave = VT >> 6;
  const int m = u * 16 + wave * 4;
  const bfu* ep = (const bfu*)(P.ws + OFF_EPRE) + (size_t)m * DM;
  u32x4 v[4][2];
#pragma unroll
  for (int r = 0; r < 4; ++r)
#pragma unroll
    for (int i = 0; i < 2; ++i) v[r][i] = *(const u32x4*)(ep + (size_t)r * DM + i * 512 + lane * 8);
#pragma unroll
  for (int r = 0; r < 4; ++r) {
    float q = 0.f;
#pragma unroll
    for (int i = 0; i < 2; ++i) {
      float a[8];
      unpack8(v[r][i], a);
#pragma unroll
      for (int e = 0; e < 8; ++e) q += a[e] * a[e];
    }
    q = wave_sum(q);
    if (lane == 0) ((float*)(P.ws + OFF_RINV))[m + r] = rsqrtf(q * (1.f / 1024.f) + RMS_EPS);
  }
}

DI void ph_fins(const Params& P, int u, char* smem) {
  const int lane = VT & 63, wave = VT >> 6;
  const int rs = u * 4 + wave, m = M_P + rs;
  const float* sl = (const float*)(P.ws + OFF_FSLAB) + (size_t)rs * DM;
  const bfu* x2 = (const bfu*)(P.ws + OFF_X2B) + (size_t)m * DM;
  const bfu* ep = (const bfu*)(P.ws + OFF_EPRE) + (size_t)m * DM;
  const float ri = ((const float*)(P.ws + OFF_RINV))[m];
#pragma unroll
  for (int i = 0; i < 4; ++i) {
    const int co = i * 256 + lane * 4;
    const f32x4 s0 = *(const f32x4*)(sl + co), s1 = *(const f32x4*)(sl + (size_t)1024 * 1024 + co);
    const f32x4 s2 = *(const f32x4*)(sl + (size_t)2 * 1024 * 1024 + co), s3 = *(const f32x4*)(sl + (size_t)3 * 1024 * 1024 + co);
    const f32x4 a = (s0 + s1) + (s2 + s3);
    const uint2 xq = *(const uint2*)(x2 + co);
    const uint2 eq = *(const uint2*)(ep + co);
    const f32x4 gv = *(const f32x4*)(P.ple_g + co);
    f32x4 o;
    o[0] = lo_bf(xq.x) + sigmoidf_(a[0]) * (lo_bf(eq.x) * ri * gv[0]);
    o[1] = hi_bf(xq.x) + sigmoidf_(a[1]) * (hi_bf(eq.x) * ri * gv[1]);
    o[2] = lo_bf(xq.y) + sigmoidf_(a[2]) * (lo_bf(eq.y) * ri * gv[2]);
    o[3] = hi_bf(xq.y) + sigmoidf_(a[3]) * (hi_bf(eq.y) * ri * gv[3]);
    *(f32x4*)(P.out + (size_t)m * DM + co) = o;
  }
}

template <int PH>
DI void run_unit(const Params& P, int u, char* smem) {
  if (PH == PH_WT) ph_wt(P, u, smem);
  else if (PH == PH_LORAIN) ph_lorain(P, u, smem);
  else if (PH == PH_LORA) ph_lora(P, u, smem);
  else if (PH == PH_PREPA) ph_prepa(P, u, smem);
  else if (PH == PH_PREPB) ph_prepb(P, u, smem);
  else if (PH == PH_D1) ph_d1(P, u, smem);
  else if (PH == PH_SCAN) ph_scan(P, u, smem);
  else if (PH == PH_POST) ph_post(P, u, smem);
  else if (PH == PH_LN1) ph_ln1(P, u, smem);
  else if (PH == PH_FFNCONV) ph_ffnconv(P, u, smem);
  else if (PH == PH_LN2_PLE) ph_ln2_ple(P, u, smem);
  else if (PH == PH_RINV) ph_rinv(P, u, smem);
  else if (PH == PH_FINS) ph_fins(P, u, smem);
}

template <int PH>
DI void run_phase(const Params& P, char* lds) {
  const int half = (int)(threadIdx.x >> 8);
  char* smem = lds + half * SMEM_BYTES;
  const int n = units_of(PH, P.wd_tiles);
  for (int u = (int)blockIdx.x * 2 + half; u < n; u += 2 * (int)gridDim.x) run_unit<PH>(P, u, smem);
}

#define XB_TMO      128
#define XB_XCNT(j)  (256  + 64 * (j))
#define XB_XSUB(j)  (1280 + 64 * (j))
#define XB_XGEN(j)  (2304 + 64 * (j))
#define XB_TOP      3328
#define XB_TOPGEN   3392
#define XCD_BAR_WORDS 3456
#define XB_SPIN_CAP (1u << 18)
#define XLAS __attribute__((address_space(3)))

__device__ __forceinline__ unsigned xb_ld(unsigned* p)              { return __hip_atomic_load(p, __ATOMIC_RELAXED, __HIP_MEMORY_SCOPE_AGENT); }
__device__ __forceinline__ unsigned xb_add(unsigned* p, unsigned v) { return __hip_atomic_fetch_add(p, v, __ATOMIC_RELAXED, __HIP_MEMORY_SCOPE_AGENT); }
__device__ __forceinline__ unsigned xb_xcc_id() { return (unsigned)__builtin_amdgcn_s_getreg((3 << 11) | 20) & 0xFu; }
#define XB_SPIN(cond, bar) do { unsigned _sp = 0; while (cond) { __builtin_amdgcn_s_sleep(1); \
    if ((++_sp & 255u) == 0u) { if (xb_ld(&(bar)[XB_TMO])) break; if (_sp > XB_SPIN_CAP) { atomicAdd(&(bar)[XB_TMO], 1u); break; } } } } while (0)

struct XcdBarrier {
    unsigned* bar; unsigned x;
    volatile XLAS unsigned* st;
};

__device__ __forceinline__ XcdBarrier xcd_barrier_post(unsigned* bar, volatile XLAS unsigned* st) {
    XcdBarrier b; b.bar = bar; b.x = xb_xcc_id(); b.st = st;
    if (threadIdx.x == 0) (void)xb_add(&bar[XB_XCNT(b.x)], 1u);
    return b;
}
__device__ __forceinline__ void xcd_barrier_complete(unsigned* bar, unsigned x, unsigned& nloc, unsigned& nx) {
    const unsigned G = gridDim.x * gridDim.y * gridDim.z;
    unsigned sum, cnt, mine, sp = 0u;
    for (;;) {
        sum = 0u; cnt = 0u; mine = 0u;
#pragma unroll
        for (unsigned j = 0; j < 16; ++j) { const unsigned c = xb_ld(&bar[XB_XCNT(j)]); sum += c; cnt += (c > 0u) ? 1u : 0u; mine = (j == x) ? c : mine; }
        if (sum == G) break;
        __builtin_amdgcn_s_sleep(1);
        if ((++sp & 255u) == 0u) { if (xb_ld(&bar[XB_TMO])) break; if (sp > XB_SPIN_CAP) { atomicAdd(&bar[XB_TMO], 1u); break; } }
    }
    nloc = mine > 0u ? mine : 1u; nx = cnt > 0u ? cnt : 1u;
}

__device__ __forceinline__ void xcd_barrier(const XcdBarrier& b) {
    asm volatile("s_waitcnt vmcnt(0)" ::: "memory");
    __syncthreads();
    if (threadIdx.x == 0) {
        unsigned* bar = b.bar;
        __builtin_amdgcn_s_waitcnt(0);
        unsigned nloc = b.st[0], nx = b.st[1];
        if (nloc == 0u) { xcd_barrier_complete(bar, b.x, nloc, nx); b.st[0] = nloc; b.st[1] = nx; }
        const unsigned old = xb_add(&bar[XB_XSUB(b.x)], 1u);
        const unsigned gen = old / nloc;
        if (old + 1u == (gen + 1u) * nloc) {
            __builtin_amdgcn_fence(__ATOMIC_RELEASE, "agent");
            asm volatile("s_waitcnt vmcnt(0)" ::: "memory");
            const unsigned og = xb_add(&bar[XB_TOP], 1u);
            const unsigned tg = og / nx;
            if (og + 1u == (tg + 1u) * nx) xb_add(&bar[XB_TOPGEN], 1u);
            else XB_SPIN(xb_ld(&bar[XB_TOPGEN]) == tg, bar);
            __builtin_amdgcn_fence(__ATOMIC_ACQUIRE, "agent");
            xb_add(&bar[XB_XGEN(b.x)], 1u);
            asm volatile("s_waitcnt vmcnt(0)" ::: "memory");
        } else {
            XB_SPIN(xb_ld(&bar[XB_XGEN(b.x)]) == gen, bar);
            __builtin_amdgcn_fence(__ATOMIC_ACQUIRE, "agent");
            asm volatile("s_waitcnt vmcnt(0)" ::: "memory");
        }
    }
    __syncthreads();
}


constexpr int DYN_LDS = 2 * SMEM_BYTES + 16;

__global__ void __launch_bounds__(512, 2) k_mega(Params P) {
  extern __shared__ __attribute__((aligned(16))) unsigned char dyn_lds[];
  cg::grid_group grid = cg::this_grid();
  PG8_LAS unsigned char* lds3 = (PG8_LAS unsigned char*)dyn_lds;
  char* lds = (char*)dyn_lds;
  char* ws = P.ws;
  volatile XLAS unsigned* xst = (volatile XLAS unsigned*)((PG8_LAS unsigned char*)dyn_lds + 2 * SMEM_BYTES);
  if (threadIdx.x == 0) { xst[0] = 0u; xst[1] = 0u; xst[2] = 0u; xst[3] = 0u; }
  __syncthreads();
  const XcdBarrier xbar = xcd_barrier_post((unsigned*)(ws + OFF_END), xst);
  run_phase<PH_WT>(P, lds);
  if (P.pad_ != 0) grid.sync();
  xcd_barrier(xbar);
  {
    EpiBf16Split E{(bfu*)(ws + OFF_PROJA), ASW, (bfu*)P.out, PB_W, ASW};
    run_pg8(lds3, (const bfu*)(ws + OFF_XB), DM, (const bfu*)(ws + WT_IN), M_TOK, 3840, DM, E);
  }
  xcd_barrier(xbar);
  run_phase<PH_LORAIN>(P, lds);
  xcd_barrier(xbar);
  run_phase<PH_LORA>(P, lds);
  xcd_barrier(xbar);
  run_phase<PH_PREPA>(P, lds);
  xcd_barrier(xbar);
  run_phase<PH_PREPB>(P, lds);
  xcd_barrier(xbar);
  run_phase<PH_D1>(P, lds);
  xcd_barrier(xbar);
  run_phase<PH_SCAN>(P, lds);
  xcd_barrier(xbar);
  run_phase<PH_POST>(P, lds);
  xcd_barrier(xbar);
  {
    EpiResO E{P.x_p, P.x_s, (bfu*)P.out};
    run_pg8(lds3, (const bfu*)(ws + OFF_OMIX), DM, (const bfu*)(ws + WT_O), M_P, DM, DM, E);
  }
  run_split(lds3, (const bfu*)(ws + OFF_OMIX), DM, (const bfu*)(ws + WT_O), DM, SLABS(P));
  if (blockIdx.x >= 64) {
    const int half = (int)(threadIdx.x >> 8);
    for (int t = ((int)blockIdx.x - 64) * 2 + half; t < P.wd_tiles - WT_EARLY; t += 2 * ((int)gridDim.x - 64))
      ph_wt_impl(P, WT_EARLY + t, lds + half * SMEM_BYTES);
  }
  xcd_barrier(xbar);
  run_phase<PH_LN1>(P, lds);
  xcd_barrier(xbar);
  {
    EpiFfn E{(bfu*)(ws + OFF_GU), FFN_HG(P), FFN_HU(P), P.f_conv_w, P.f_conv_b, P.out + O_PF_CONV};
    run_pg8(lds3, (const bfu*)(ws + OFF_X1B), DM, (const bfu*)(ws + WT_UP), M_TOK, 2 * DFF, DM, E);
  }
  xcd_barrier(xbar);
  run_phase<PH_FFNCONV>(P, lds);
  xcd_barrier(xbar);
  {
    EpiResD E{(const bfu*)(ws + OFF_X1B), (bfu*)P.out};
    run_pg8(lds3, (const bfu*)(ws + OFF_GU) + DFF, 2 * DFF, (const bfu*)(ws + WT_DOWN), M_P, DM, DFF, E);
  }
  run_split(lds3, (const bfu*)(ws + OFF_GU) + DFF, 2 * DFF, (const bfu*)(ws + WT_DOWN), DFF, SLABS(P));
  xcd_barrier(xbar);
  {
    EpiBf16Split E{(bfu*)(ws + OFF_EPRE), DM, (bfu*)(ws + OFF_EPRE), DM, 1 << 30};
    run_pg8(lds3, (const bfu*)(ws + OFF_PB), PLE, (const bfu*)(ws + WT_PLE), M_TOK, DM, PLE, E);
  }
  run_phase<PH_LN2_PLE>(P, lds);
  xcd_barrier(xbar);
  run_phase<PH_RINV>(P, lds);
  xcd_barrier(xbar);
  {
    EpiFin E{(const bfu*)(ws + OFF_X2B), (const bfu*)(ws + OFF_EPRE), (const float*)(ws + OFF_RINV), P.ple_g, P.out};
    run_pg8(lds3, (const bfu*)(ws + OFF_X2B), DM, (const bfu*)(ws + WT_GATE), M_P, DM, DM, E);
  }
  run_split(lds3, (const bfu*)(ws + OFF_X2B), DM, (const bfu*)(ws + WT_GATE), DM, (float*)(ws + OFF_FSLAB));
  xcd_barrier(xbar);
  run_phase<PH_FINS>(P, lds);
}

extern "C" void kernel_launch(void* const* d_in, const int* in_sizes, int n_in, void* d_out, int out_size,
                              void* d_ws, size_t ws_size, hipStream_t stream) {
  Params P;
  memset(&P, 0, sizeof(P));
  const float** f = (const float**)&P;
  for (int i = 0; i < 37; ++i) f[i] = (const float*)d_in[i];
  P.out = (float*)d_out;
  P.ws = (char*)d_ws;
  char* ws = (char*)d_ws;
  struct { const float* src; size_t off; int K, N, Npad; } wl[9] = {
      {P.w_in, WT_IN, 1024, INW, INW_PAD},   {P.a_w_w2, WT_W2, 64, 512, 512},   {P.a_w_a2, WT_A2, 64, 512, 512},
      {P.a_w_g2, WT_G2, 128, 512, 512},      {P.w_o, WT_O, 1024, 1024, 1024},   {P.w_up, WT_UP, 1024, 5632, 5632},
      {P.w_down, WT_DOWN, 2816, 1024, 1024}, {P.w_ple, WT_PLE, 256, 1024, 1024}, {P.w_ple_gate, WT_GATE, 1024, 1024, 1024}};
  int t0 = 0;
  for (int i = 0; i < 9; ++i) {
    P.wd[i].src = wl[i].src;
    P.wd[i].dst = (bfu*)(ws + wl[i].off);
    P.wd[i].K = wl[i].K;
    P.wd[i].N = wl[i].N;
    P.wd[i].Npad = wl[i].Npad;
    P.wd[i].t0 = t0;
    t0 += (wl[i].Npad / 64) * (wl[i].K / 64);
  }
  P.wd_tiles = t0;
  static int grid_blocks = 0;
  if (!grid_blocks) {
    int dev = 0, cus = 0, per_cu = 0;
    hipGetDevice(&dev);
    hipDeviceGetAttribute(&cus, hipDeviceAttributeMultiprocessorCount, dev);
    hipFuncSetAttribute((const void*)k_mega, hipFuncAttributeMaxDynamicSharedMemorySize, DYN_LDS);
    hipOccupancyMaxActiveBlocksPerMultiprocessor(&per_cu, (const void*)k_mega, 512, DYN_LDS);
    if (per_cu < 1) per_cu = 1;
    if (per_cu > 1) per_cu = 1;
    grid_blocks = cus * per_cu;
  }
  hipMemsetAsync((char*)d_ws + OFF_END, 0, XCD_BAR_WORDS * 4, stream);
  void* args[] = {&P};
  hipError_t e = hipLaunchCooperativeKernel((void*)k_mega, dim3(grid_blocks), dim3(512), args, DYN_LDS, stream);
  if (e != hipSuccess) fprintf(stderr, "cooperative launch failed: %s (grid %d)\n", hipGetErrorString(e), grid_blocks);
}
```

```cpp
#include <hip/hip_runtime.h>
#include <hip/hip_bf16.h>
#include <hip/hip_cooperative_groups.h>
#include <cstdio>
#include <cstring>
namespace cg = cooperative_groups;

#ifndef MULTI_LAUNCH
#define MULTI_LAUNCH 0
#endif

#define DI __device__ __forceinline__
#define VT ((int)(threadIdx.x & 255u))
typedef unsigned short bfu;
using bf16x8 = __attribute__((ext_vector_type(8))) short;
using f32x4 = __attribute__((ext_vector_type(4))) float;
using u32x4 = __attribute__((ext_vector_type(4))) unsigned;

constexpr int M_TOK = 17408, M_P = 16384, NSEQ = 136;
constexpr int DM = 1024, AW = 512, ASW = 1792, BQKV = 1536, PB_W = 2048, INW = 3848, INW_PAD = 3968;
constexpr int DFF = 2816, PLE = 256;
constexpr float DN_ALPHA = 1.189207115002721f;
constexpr float LN_EPS = 1e-5f, GN_EPS = 64e-5f, RMS_EPS = 1e-6f, L2_EPS = 1e-12f;

constexpr size_t O_Y = 0;
constexpr size_t O_PA_WKV = (size_t)M_TOK * 1024;
constexpr size_t O_PA_SHIFT = O_PA_WKV + 8 * 8 * 64 * 64;
constexpr size_t O_PB_SSM = O_PA_SHIFT + 8 * 1792;
constexpr size_t O_PB_CONV = O_PB_SSM + 8 * 4 * 128 * 128;
constexpr size_t O_PF_CONV = O_PB_CONV + 8 * 3 * 1536;
constexpr size_t O_SA_WKV = O_PF_CONV + 8 * 2 * 2816;
constexpr size_t O_SA_SHIFT = O_SA_WKV + (size_t)128 * 8 * 64 * 64;
constexpr size_t O_SB_SSM = O_SA_SHIFT + 128 * 1792;
constexpr size_t O_SB_CONV = O_SB_SSM + (size_t)128 * 4 * 128 * 128;
constexpr size_t O_SF_CONV = O_SB_CONV + 128 * 3 * 1536;

constexpr size_t WL_UP = 0;
constexpr size_t WL_DOWN = WL_UP + (size_t)5632 * 1024 * 2;
constexpr size_t WL_PLE = WL_DOWN + (size_t)1024 * 2816 * 2;
constexpr size_t WL_GATE = WL_PLE + 1024 * 256 * 2;
constexpr size_t OFF_PB = WL_GATE + 1024 * 1024 * 2;
constexpr size_t OFF_STREAM = OFF_PB + (size_t)M_TOK * 256 * 2;
constexpr size_t OFF_G = OFF_STREAM + (size_t)M_TOK * 8 * 384 * 2;
constexpr size_t OFF_PROJA = OFF_G + (size_t)M_TOK * 512 * 2;
constexpr size_t OFF_LORAIN = OFF_PROJA + (size_t)M_TOK * 1792 * 2;
constexpr size_t OFF_ABUF = OFF_LORAIN + (size_t)M_TOK * 256 * 2;
constexpr size_t OFF_BA = OFF_ABUF + (size_t)M_TOK * 512 * 2;
constexpr size_t OFF_BG = OFF_BA + (size_t)M_TOK * 8 * 4;
constexpr size_t OFF_BONUS = OFF_BG + (size_t)M_TOK * 8 * 4;
constexpr size_t WT_IN = OFF_BONUS + (size_t)M_TOK * 8 * 4;
constexpr size_t WT_W2 = WT_IN + (size_t)INW_PAD * 1024 * 2;
constexpr size_t WT_A2 = WT_W2 + 512 * 64 * 2;
constexpr size_t WT_G2 = WT_A2 + 512 * 64 * 2;
constexpr size_t WT_O = WT_G2 + 512 * 128 * 2;
constexpr size_t WT_UP = WL_UP, WT_DOWN = WL_DOWN, WT_PLE = WL_PLE, WT_GATE = WL_GATE;
constexpr size_t OFF_WEND = WT_O + 1024 * 1024 * 2;
constexpr size_t OFF_XB = OFF_STREAM;
constexpr size_t OFF_STREAMB = OFF_PROJA;
constexpr size_t OFF_OMIX = OFF_STREAMB + (size_t)M_TOK * 4 * 384 * 2;
constexpr size_t OFF_GU = OFF_STREAM;
constexpr size_t OFF_X1B = OFF_GU + (size_t)M_TOK * 5632 * 2;
constexpr size_t OFF_RINV = OFF_X1B + (size_t)M_TOK * 1024 * 2;
constexpr size_t OFF_GG = OFF_RINV + (size_t)M_TOK * 4;
constexpr size_t OFF_END = OFF_GG + (size_t)M_TOK * 4 * 4;
constexpr size_t OFF_X2 = OFF_STREAM;
constexpr size_t OFF_X2B = OFF_X1B;
constexpr int EP_LD = 2 * 2816;
constexpr int FSL_LD = 2816;
static_assert(OFF_OMIX + (size_t)M_TOK * 1024 * 2 <= OFF_BA, "omix overlap");
static_assert(OFF_X1B >= OFF_ABUF, "x1b overlaps live data");
static_assert(OFF_X1B >= OFF_OMIX + 0 || true, "");
static_assert(OFF_RINV >= OFF_WEND, "rinv overlaps weights");
static_assert(OFF_END + 3456 * 4 <= 256ull * 1024 * 1024, "ws too small");
static_assert(OFF_END % 256 == 0, "barrier word alignment");

struct WD { const float* src; bfu* dst; int K, N, Npad, t0; };

struct Params {
  const float *x_p, *x_s, *p_p, *p_s, *st_wkv, *st_shift, *st_ssm, *st_bconv, *st_fconv;
  const float *w_in, *a_mu, *a_w0, *a_w_w2, *a_a0, *a_w_a2, *a_w_g2, *a_k_k, *a_k_a, *a_r_k, *a_gn_g, *a_gn_b;
  const float *b_conv_w, *b_a_log, *b_dt_bias, *b_norm_g, *w_o, *ln1_g, *ln1_b, *w_up, *f_conv_w, *f_conv_b,
      *w_down, *ln2_g, *ln2_b, *w_ple, *ple_g, *w_ple_gate;
  float* out;
  char* ws;
  WD wd[9];
  int wd_tiles;
  int pad_;
};

typedef __bf16 bf16x2_t __attribute__((ext_vector_type(2)));
typedef float f32x2_t __attribute__((ext_vector_type(2)));
DI unsigned pack2(float a, float b) {
  const f32x2_t v = {a, b};
  const bf16x2_t r = __builtin_convertvector(v, bf16x2_t);
  return __builtin_bit_cast(unsigned, r);
}
DI bfu f2bf(float f) { return (bfu)pack2(f, f); }
DI float bf2f(bfu h) { return __uint_as_float(((unsigned)h) << 16); }
DI float lo_bf(unsigned u) { return __uint_as_float(u << 16); }
DI float hi_bf(unsigned u) { return __uint_as_float(u & 0xffff0000u); }
DI float sigmoidf_(float x) { return __builtin_amdgcn_rcpf(1.f + __builtin_amdgcn_exp2f(x * -1.4426950408889634f)); }
DI float siluf_(float x) { return x * __builtin_amdgcn_rcpf(1.f + __builtin_amdgcn_exp2f(x * -1.4426950408889634f)); }
DI float softplusf_(float x) { return fmaxf(x, 0.f) + log1pf(__expf(-fabsf(x))); }
DI float wave_sum(float v) {
#pragma unroll
  for (int o = 32; o > 0; o >>= 1) v += __shfl_xor(v, o, 64);
  return v;
}
DI float row16_sum(float x) {
  x += __int_as_float(__builtin_amdgcn_update_dpp(0, __float_as_int(x), 0x128, 0xf, 0xf, false));
  x += __int_as_float(__builtin_amdgcn_update_dpp(0, __float_as_int(x), 0x124, 0xf, 0xf, false));
  x += __int_as_float(__builtin_amdgcn_update_dpp(0, __float_as_int(x), 0x122, 0xf, 0xf, false));
  x += __int_as_float(__builtin_amdgcn_update_dpp(0, __float_as_int(x), 0x121, 0xf, 0xf, false));
  return x;
}
DI float sum8(float x) {
  x += __int_as_float(__builtin_amdgcn_update_dpp(0, __float_as_int(x), 0xB1, 0xf, 0xf, false));
  x += __int_as_float(__builtin_amdgcn_update_dpp(0, __float_as_int(x), 0x4E, 0xf, 0xf, false));
  x += __int_as_float(__builtin_amdgcn_update_dpp(0, __float_as_int(x), 0x141, 0xf, 0xf, false));
  return x;
}
DI void unpack8(u32x4 q, float (&f)[8]) {
  f[0] = lo_bf(q.x); f[1] = hi_bf(q.x); f[2] = lo_bf(q.y); f[3] = hi_bf(q.y);
  f[4] = lo_bf(q.z); f[5] = hi_bf(q.z); f[6] = lo_bf(q.w); f[7] = hi_bf(q.w);
}
DI u32x4 pack8(const float (&f)[8]) {
  u32x4 q;
  q.x = pack2(f[0], f[1]); q.y = pack2(f[2], f[3]); q.z = pack2(f[4], f[5]); q.w = pack2(f[6], f[7]);
  return q;
}
DI void load8f(const float* p, float (&f)[8]) {
  f32x4 a = *(const f32x4*)p, b = *(const f32x4*)(p + 4);
  f[0] = a[0]; f[1] = a[1]; f[2] = a[2]; f[3] = a[3]; f[4] = b[0]; f[5] = b[1]; f[6] = b[2]; f[7] = b[3];
}
DI int seq_of_row(int m) { return m < M_P ? (m >> 11) : 8 + ((m - M_P) >> 3); }
DI int t_of_row(int m) { return m < M_P ? (m & 2047) : (m & 7); }
DI int row0_of_seq(int s) { return s < 8 ? s * 2048 : M_P + (s - 8) * 8; }
DI int T_of_seq(int s) { return s < 8 ? 2048 : 8; }

constexpr int SMEM_BYTES = 81904;

constexpr int LDT = 72;
constexpr int TILE_ELEMS = 128 * LDT;
constexpr int GBK = 64;

template <bool AF32>
DI void g_load(const void* __restrict__ Ap, int lda, const bfu* __restrict__ Bp, int K, int kt, int lrow, int lkc,
               u32x4 (&ra)[4], u32x4 (&rb)[4], f32x4 (&fa)[4][2]) {
#pragma unroll
  for (int j = 0; j < 4; ++j) {
    const int row = lrow + 32 * j;
    if constexpr (AF32) {
      const float* ap = (const float*)Ap + (size_t)row * lda + kt * GBK + lkc;
      fa[j][0] = *(const f32x4*)ap;
      fa[j][1] = *(const f32x4*)(ap + 4);
    } else {
      const bfu* ap = (const bfu*)Ap + (size_t)row * lda + kt * GBK + lkc;
      ra[j] = *(const u32x4*)ap;
    }
    rb[j] = *(const u32x4*)(Bp + (size_t)row * K + kt * GBK + lkc);
  }
}
template <bool AF32>
DI void l_store(bfu* As, bfu* Bs, int lrow, int lkc, const u32x4 (&ra)[4], const u32x4 (&rb)[4],
                const f32x4 (&fa)[4][2]) {
#pragma unroll
  for (int j = 0; j < 4; ++j) {
    const int row = lrow + 32 * j;
    u32x4 va;
    if constexpr (AF32) {
      va.x = pack2(fa[j][0].x, fa[j][0].y);
      va.y = pack2(fa[j][0].z, fa[j][0].w);
      va.z = pack2(fa[j][1].x, fa[j][1].y);
      va.w = pack2(fa[j][1].z, fa[j][1].w);
    } else {
      va = ra[j];
    }
    *(u32x4*)(As + row * LDT + lkc) = va;
    *(u32x4*)(Bs + row * LDT + lkc) = rb[j];
  }
}

template <bool AF32, class Epi>
DI void gemm_tile(const void* __restrict__ Ap, int lda, const bfu* __restrict__ Bp, int K, int m0, int n0,
                  bfu* smem, Epi epi) {
  const int tid = VT, lane = tid & 63, wave = tid >> 6;
  const int wm = wave >> 1, wn = wave & 1;
  bfu* As = smem;
  bfu* Bs = smem + TILE_ELEMS;
  f32x4 acc[4][4];
#pragma unroll
  for (int i = 0; i < 4; ++i)
#pragma unroll
    for (int j = 0; j < 4; ++j) acc[i][j] = f32x4{0.f, 0.f, 0.f, 0.f};
  const int lrow = tid >> 3, lkc = (tid & 7) * 8;
  u32x4 ra[4], rb[4];
  f32x4 fa[4][2];
  const int nk = K / GBK;

  g_load<AF32>(Ap, lda, Bp, K, 0, lrow, lkc, ra, rb, fa);
  for (int kt = 0; kt < nk; ++kt) {
    __syncthreads();
    l_store<AF32>(As, Bs, lrow, lkc, ra, rb, fa);
    __syncthreads();
    if (kt + 1 < nk) g_load<AF32>(Ap, lda, Bp, K, kt + 1, lrow, lkc, ra, rb, fa);
#pragma unroll
    for (int ks = 0; ks < 2; ++ks) {
      bf16x8 af[4], bfr[4];
#pragma unroll
      for (int mi = 0; mi < 4; ++mi)
        af[mi] = *(const bf16x8*)(As + (wm * 64 + mi * 16 + (lane & 15)) * LDT + ks * 32 + (lane >> 4) * 8);
#pragma unroll
      for (int ni = 0; ni < 4; ++ni)
        bfr[ni] = *(const bf16x8*)(Bs + (wn * 64 + ni * 16 + (lane & 15)) * LDT + ks * 32 + (lane >> 4) * 8);
#pragma unroll
      for (int mi = 0; mi < 4; ++mi)
#pragma unroll
        for (int ni = 0; ni < 4; ++ni)
          acc[mi][ni] = __builtin_amdgcn_mfma_f32_16x16x32_bf16(bfr[ni], af[mi], acc[mi][ni], 0, 0, 0);
    }
  }
#pragma unroll
  for (int mi = 0; mi < 4; ++mi)
#pragma unroll
    for (int ni = 0; ni < 4; ++ni) {
      int m = m0 + wm * 64 + mi * 16 + (lane & 15);
      int n = n0 + wn * 64 + ni * 16 + (lane >> 4) * 4;
      epi(m, n, acc[mi][ni]);
    }
  __syncthreads();
}

DI void store_bf4(bfu* p, f32x4 v) {
  uint2 u;
  u.x = pack2(v[0], v[1]);
  u.y = pack2(v[2], v[3]);
  *(uint2*)p = u;
}

namespace pg8 {
#define PG8_LAS __attribute__((address_space(3)))
typedef unsigned short bf16_t;
typedef short bf16x8 __attribute__((ext_vector_type(8)));
typedef float f32x4 __attribute__((ext_vector_type(4)));
typedef unsigned u32x4 __attribute__((ext_vector_type(4)));
constexpr int BM = 256, BK = 64, HALF = 128, HTB = HALF * BK * 2  , STAGE_BYTES = 8 * HTB, NXCD = 8, WGM = 8;

__host__ __device__ __forceinline__ int lds_byte(int r, int c) { const int st = (r >> 4) * 2 + (c >> 5), rr = r & 15, cc = c & 31, ob = rr * 64 + cc * 2; return st * 1024 + (ob ^ (((ob >> 9) & 1) << 5)); }
__host__ __device__ __forceinline__ void stage_rc(int b, int& R, int& C) { const int st = b / 1024, sb = b % 1024, swz = sb ^ (((sb >> 9) & 1) << 5); R = (st >> 1) * 16 + swz / 64; C = (st & 1) * 32 + (swz % 64) / 2; }
__host__ __device__ __forceinline__ int perm32(int rho) { const int n = rho >> 4, i = rho & 15; return 8 * (i >> 2) + 4 * n + (i & 3); }

struct Unit { int pm, pn; };
struct Gemm { const bf16_t* A; const bf16_t* Bt; int M, N, K, lda, ldb; };

struct StaticOrder {
    int nM, nN, nwg, G, c;
    __host__ __device__ void init(int M, int N, int G_, int c_) { nM = M / BM; nN = N / BM; nwg = nM * nN; G = G_; c = c_; }
    __host__ __device__ bool next(int i, Unit& u) const {
        const long L = (long)i * G + c; if (L >= nwg) return false;
        int wgid = (int)L; { const int q = nwg / NXCD, r = nwg % NXCD, xcd = wgid % NXCD, off = wgid / NXCD; wgid = (xcd < r ? xcd * (q + 1) : r * (q + 1) + (xcd - r) * q) + off; }
        const int nig = WGM * nN, gid = wgid / nig, fm = gid * WGM, gsz = (nM - fm) < WGM ? (nM - fm) : WGM;
        u.pm = fm + ((wgid % nig) % gsz); u.pn = (wgid % nig) / gsz; return true;
    }
    __device__ __forceinline__ void a_ready(const Unit&) const {}
    __device__ __forceinline__ void done(const Unit&) const {}
};
__device__ __forceinline__ unsigned cvt_pk_bf16(float lo, float hi) { unsigned r; asm volatile("v_cvt_pk_bf16_f32 %0, %1, %2" : "=v"(r) : "v"(lo), "v"(hi)); return r; }
template <class Epi, class Sched, bool STAMP = false>
__device__ __forceinline__ void gemm_phase(PG8_LAS unsigned char* lds, const Gemm g, const Sched& S, const Epi& E, unsigned long long* stamps) {
    int tid_ = threadIdx.x; asm volatile("" : "+v"(tid_));
    const int tid = tid_, wid = __builtin_amdgcn_readfirstlane(tid >> 6), lane = tid & 63, wr = wid >> 2, wc = wid & 3, fr = lane & 15, fq = lane >> 4;
    const int K = g.K, nt = K / BK;
    int ts_lo = 0, ts_hi = 0, nts = 0; const unsigned long long rt_entry = STAMP ? (unsigned long long)wall_clock64() : 0ull;
#define PG8_STAMP() do { if (STAMP && wid == 0 && nts < 64) { const unsigned long long _c = (unsigned long long)clock64(); \
        ts_lo = (lane == nts) ? (int)(unsigned)_c : ts_lo; ts_hi = (lane == nts) ? (int)(unsigned)(_c >> 32) : ts_hi; ++nts; } } while (0)
    PG8_STAMP();
    unsigned voffA[2], voffB[2];
#pragma unroll
    for (int i = 0; i < 2; ++i) { int R, C; stage_rc(tid * 16 + i * 8192, R, C); const int Rb = Epi::PERM ? ((R & ~31) + perm32(R & 31)) : R;
        voffA[i] = (unsigned)(R * g.lda + C) * 2u; voffB[i] = (unsigned)(Rb * g.ldb + C) * 2u; }
    const size_t kstep = (size_t)(BK * 2);
    const size_t hstep = (size_t)HALF * g.ldb * 2; const size_t hstepA = (size_t)HALF * g.lda * 2;
    const size_t tstep = 2 * hstep; const size_t tstepA = 2 * hstepA;
    const unsigned ldsw = (unsigned)wid * 1024u;
    const int aoff = lds_byte(wr * 64 + fr, fq * 8), boff = lds_byte(wc * 32 + fr, fq * 8);
#define PG8_SA(b, h) (((b) * 2 + (h)) * HTB)
#define PG8_SB(b, h) ((4 + (b) * 2 + (h)) * HTB)
#define PG8_STAGE(bufoff, gbase, voff) do { _Pragma("unroll") for (int _i = 0; _i < 2; ++_i) \
        __builtin_amdgcn_global_load_lds((const unsigned*)((const char*)(gbase) + (voff)[_i]), (PG8_LAS unsigned*)(lds + (bufoff) + ldsw + _i * 8192), 16, 0, 0); } while (0)
#define PG8_LDA(dst, b, h) do { _Pragma("unroll") for (int m = 0; m < 4; ++m) _Pragma("unroll") for (int k = 0; k < 2; ++k) dst[m][k] = *(const PG8_LAS bf16x8*)(lds + PG8_SA(b, h) + aoff + m * 2048 + k * 1024); } while (0)
#define PG8_LDB(dst, b, h) do { _Pragma("unroll") for (int n = 0; n < 2; ++n) _Pragma("unroll") for (int k = 0; k < 2; ++k) dst[n][k] = *(const PG8_LAS bf16x8*)(lds + PG8_SB(b, h) + boff + n * 2048 + k * 1024); } while (0)
#define PG8_MMA(ai, bj, At, Bt) do { __builtin_amdgcn_s_setprio(1); _Pragma("unroll") for (int m = 0; m < 4; ++m) _Pragma("unroll") for (int n = 0; n < 2; ++n) _Pragma("unroll") for (int k = 0; k < 2; ++k) \
        acc[ai][bj][m][n] = __builtin_amdgcn_mfma_f32_16x16x32_bf16(Bt[n][k], At[m][k], acc[ai][bj][m][n], 0, 0, 0); __builtin_amdgcn_s_setprio(0); } while (0)
#define PG8_WAIT_V(n) asm volatile("s_waitcnt vmcnt(" #n ")" ::: "memory")
#define PG8_WAIT_L(n) asm volatile("s_waitcnt lgkmcnt(" #n ")" ::: "memory")
#define PG8_BAR __builtin_amdgcn_s_barrier()
#define PG8_SCHED __builtin_amdgcn_sched_barrier(0)
    Unit cur, nxt; int ui = 0;
    if (!S.next(0, cur)) return;
    f32x4 acc[2][2][4][2];
#pragma unroll
    for (int a = 0; a < 2; ++a)
#pragma unroll
        for (int b = 0; b < 2; ++b)
#pragma unroll
            for (int m = 0; m < 4; ++m)
#pragma unroll
                for (int n = 0; n < 2; ++n) acc[a][b][m][n] = (f32x4){0.f, 0.f, 0.f, 0.f};
    bf16x8 At[4][2], B0[2][2], B1[2][2];
    const char* cA = (const char*)g.A + (size_t)cur.pm * tstepA; const char* cB = (const char*)g.Bt + (size_t)cur.pn * tstep;
    S.a_ready(cur);
    PG8_STAGE(PG8_SB(0, 0), cB, voffB); PG8_STAGE(PG8_SA(0, 0), cA, voffA); PG8_STAGE(PG8_SB(0, 1), cB + hstep, voffB); PG8_STAGE(PG8_SA(0, 1), cA + hstepA, voffA);
    if (wr == 1) PG8_BAR;
    PG8_WAIT_V(4); PG8_BAR;
    PG8_STAGE(PG8_SB(1, 0), cB + kstep, voffB); PG8_STAGE(PG8_SA(1, 0), cA + kstep, voffA); PG8_STAGE(PG8_SB(1, 1), cB + hstep + kstep, voffB);
    PG8_WAIT_V(6); PG8_BAR;
    PG8_STAMP();
    for (;;) {
        const bool has_next = S.next(ui + 1, nxt);
        const char* nA = has_next ? (const char*)g.A + (size_t)nxt.pm * tstepA : cA; const char* nB = has_next ? (const char*)g.Bt + (size_t)nxt.pn * tstep : cB;
        for (int t = 0; t < nt; t += 2) {
            const bool last = (t == nt - 2);
            const char* a1 = cA + (size_t)(t + 1) * kstep;
            const char* a2 = last ? nA : cA + (size_t)(t + 2) * kstep; const char* b2 = last ? nB : cB + (size_t)(t + 2) * kstep;
            const char* a3 = a2 + kstep; const char* b3 = b2 + kstep;
            if (last && has_next) S.a_ready(nxt);
            PG8_LDB(B0, 0, 0); PG8_SCHED; PG8_LDA(At, 0, 0); PG8_STAGE(PG8_SA(1, 1), a1 + hstepA, voffA);
            PG8_WAIT_L(8); PG8_BAR; PG8_WAIT_L(0); PG8_MMA(0, 0, At, B0); PG8_BAR; PG8_SCHED;
            PG8_LDB(B1, 0, 1); PG8_STAGE(PG8_SB(0, 0), b2, voffB);
            PG8_BAR; PG8_WAIT_L(0); PG8_MMA(0, 1, At, B1); PG8_BAR;
            PG8_LDA(At, 0, 1); PG8_STAGE(PG8_SA(0, 0), a2, voffA);
            PG8_BAR; PG8_WAIT_L(0); PG8_MMA(1, 0, At, B0); PG8_BAR; PG8_SCHED;
            PG8_STAGE(PG8_SB(0, 1), b2 + hstep, voffB);
            PG8_WAIT_V(6); PG8_BAR; PG8_MMA(1, 1, At, B1); PG8_BAR;
            PG8_LDB(B0, 1, 0); PG8_SCHED; PG8_LDA(At, 1, 0); PG8_STAGE(PG8_SA(0, 1), a2 + hstepA, voffA);
            PG8_WAIT_L(8); PG8_BAR; PG8_WAIT_L(0); PG8_MMA(0, 0, At, B0); PG8_BAR; PG8_SCHED;
            PG8_LDB(B1, 1, 1); PG8_STAGE(PG8_SB(1, 0), b3, voffB);
            PG8_BAR; PG8_WAIT_L(0); PG8_MMA(0, 1, At, B1); PG8_BAR;
            PG8_LDA(At, 1, 1); PG8_STAGE(PG8_SA(1, 0), a3, voffA);
            PG8_BAR; PG8_WAIT_L(0); PG8_MMA(1, 0, At, B0); PG8_BAR; PG8_SCHED;
            PG8_STAGE(PG8_SB(1, 1), b3 + hstep, voffB);
            PG8_WAIT_V(6); PG8_BAR; PG8_MMA(1, 1, At, B1); PG8_BAR;
        }
        PG8_STAMP();
        if constexpr (!Epi::AFTER_DRAIN) { E(acc, cur, wr, wc, fr, fq); S.done(cur); }
        PG8_STAMP();
        if (!has_next) break;
#pragma unroll
        for (int a = 0; a < 2; ++a)
#pragma unroll
            for (int b = 0; b < 2; ++b)
#pragma unroll
                for (int m = 0; m < 4; ++m)
#pragma unroll
                    for (int n = 0; n < 2; ++n) acc[a][b][m][n] = (f32x4){0.f, 0.f, 0.f, 0.f};
        cur = nxt; cA = nA; cB = nB; ++ui;
    }
    PG8_WAIT_V(0);
    if (wr == 0) PG8_BAR;
    PG8_BAR;
    if constexpr (Epi::AFTER_DRAIN) { E.fused(acc, cur, wr, wc, fr, fq, lds, wid, lane); S.done(cur); }
    PG8_STAMP();
    if (STAMP && wid == 0) { stamps[lane] = lane < nts ? (((unsigned long long)(unsigned)ts_hi << 32) | (unsigned)ts_lo) : 0ull;
        if (lane == 62) stamps[62] = rt_entry; if (lane == 63) stamps[63] = (unsigned long long)wall_clock64(); }
#undef PG8_STAMP
#undef PG8_SA
#undef PG8_SB
#undef PG8_STAGE
#undef PG8_LDA
#undef PG8_LDB
#undef PG8_MMA
#undef PG8_WAIT_V
#undef PG8_WAIT_L
#undef PG8_BAR
#undef PG8_SCHED
}
}

struct EpiBf16Split {
  static constexpr bool PERM = true, AFTER_DRAIN = false;
  bfu* O1; int ld1; bfu* O2; int ld2; int split;
  DI void operator()(const f32x4 (&acc)[2][2][4][2], const pg8::Unit& u, int wr, int wc, int fr, int fq) const {
    const int row0 = u.pm * 256 + wr * 64 + fr;
    int colt = u.pn * 256; bfu* base = O1; int ld = ld1;
    if (colt >= split) { base = O2; ld = ld2; colt -= split; }
    const int col0 = colt + wc * 32 + 8 * fq;
#pragma unroll
    for (int ai = 0; ai < 2; ++ai)
#pragma unroll
      for (int m = 0; m < 4; ++m) {
        bfu* rowp = base + (size_t)(row0 + ai * 128 + m * 16) * ld + col0;
#pragma unroll
        for (int bj = 0; bj < 2; ++bj) {
          const f32x4 v0 = acc[ai][bj][m][0], v1 = acc[ai][bj][m][1];
          u32x4 o;
          o.x = pack2(v0[0], v0[1]); o.y = pack2(v0[2], v0[3]); o.z = pack2(v1[0], v1[1]); o.w = pack2(v1[2], v1[3]);
          *(u32x4*)(rowp + bj * 128) = o;
        }
      }
  }
};
struct EpiRes {
  static constexpr bool PERM = false, AFTER_DRAIN = false;
  const float* Xp; const float* Xs; float* Y;
  DI void operator()(const f32x4 (&acc)[2][2][4][2], const pg8::Unit& u, int wr, int wc, int fr, int fq) const {
    const int row0 = u.pm * 256 + wr * 64 + fr, col0 = u.pn * 256 + wc * 32 + 4 * fq;
    const float* xb = (u.pm * 256 < M_P) ? Xp : Xs - (size_t)M_P * DM;
#pragma unroll
    for (int ai = 0; ai < 2; ++ai)
#pragma unroll
      for (int m = 0; m < 4; ++m) {
        const size_t ro = (size_t)(row0 + ai * 128 + m * 16) * DM + col0;
#pragma unroll
        for (int bj = 0; bj < 2; ++bj)
#pragma unroll
          for (int n = 0; n < 2; ++n) {
            const f32x4 xv = *(const f32x4*)(xb + ro + bj * 128 + n * 16);
            *(f32x4*)(Y + ro + bj * 128 + n * 16) = xv * DN_ALPHA + acc[ai][bj][m][n];
          }
      }
  }
};
struct EpiResB {
  static constexpr bool PERM = false, AFTER_DRAIN = false;
  const bfu* Xb; float* Y;
  DI void operator()(const f32x4 (&acc)[2][2][4][2], const pg8::Unit& u, int wr, int wc, int fr, int fq) const {
    const int row0 = u.pm * 256 + wr * 64 + fr, col0 = u.pn * 256 + wc * 32 + 4 * fq;
#pragma unroll
    for (int ai = 0; ai < 2; ++ai)
#pragma unroll
      for (int m = 0; m < 4; ++m) {
        const size_t ro = (size_t)(row0 + ai * 128 + m * 16) * DM + col0;
#pragma unroll
        for (int bj = 0; bj < 2; ++bj)
#pragma unroll
          for (int n = 0; n < 2; ++n) {
            const uint2 xq = *(const uint2*)(Xb + ro + bj * 128 + n * 16);
            const f32x4 xv = f32x4{lo_bf(xq.x), hi_bf(xq.x), lo_bf(xq.y), hi_bf(xq.y)};
            *(f32x4*)(Y + ro + bj * 128 + n * 16) = xv * DN_ALPHA + acc[ai][bj][m][n];
          }
      }
  }
};
struct EpiResO {
  static constexpr bool PERM = true, AFTER_DRAIN = false;
  const float* Xp; const float* Xs; bfu* Y;
  DI void operator()(const f32x4 (&acc)[2][2][4][2], const pg8::Unit& u, int wr, int wc, int fr, int fq) const {
    const int row0 = u.pm * 256 + wr * 64 + fr, col0 = u.pn * 256 + wc * 32 + 8 * fq;
    const float* xb = (u.pm * 256 < M_P) ? Xp : Xs - (size_t)M_P * DM;
#pragma unroll
    for (int ai = 0; ai < 2; ++ai)
#pragma unroll
      for (int m = 0; m < 4; ++m) {
        const size_t ro = (size_t)(row0 + ai * 128 + m * 16) * DM + col0;
#pragma unroll
        for (int bj = 0; bj < 2; ++bj) {
          const f32x4 x0 = *(const f32x4*)(xb + ro + bj * 128), x1 = *(const f32x4*)(xb + ro + bj * 128 + 4);
          const f32x4 v0 = x0 * DN_ALPHA + acc[ai][bj][m][0], v1 = x1 * DN_ALPHA + acc[ai][bj][m][1];
          u32x4 o;
          o.x = pack2(v0[0], v0[1]); o.y = pack2(v0[2], v0[3]); o.z = pack2(v1[0], v1[1]); o.w = pack2(v1[2], v1[3]);
          *(u32x4*)(Y + ro + bj * 128) = o;
        }
      }
  }
};
struct EpiResD {
  static constexpr bool PERM = true, AFTER_DRAIN = false;
  const bfu* Xb; bfu* Y;
  DI void operator()(const f32x4 (&acc)[2][2][4][2], const pg8::Unit& u, int wr, int wc, int fr, int fq) const {
    const int row0 = u.pm * 256 + wr * 64 + fr, col0 = u.pn * 256 + wc * 32 + 8 * fq;
#pragma unroll
    for (int ai = 0; ai < 2; ++ai)
#pragma unroll
      for (int m = 0; m < 4; ++m) {
        const size_t ro = (size_t)(row0 + ai * 128 + m * 16) * DM + col0;
#pragma unroll
        for (int bj = 0; bj < 2; ++bj) {
          const u32x4 xq = *(const u32x4*)(Xb + ro + bj * 128);
          const f32x4 a0 = acc[ai][bj][m][0], a1 = acc[ai][bj][m][1];
          u32x4 o;
          o.x = pack2(lo_bf(xq.x) * DN_ALPHA + a0[0], hi_bf(xq.x) * DN_ALPHA + a0[1]);
          o.y = pack2(lo_bf(xq.y) * DN_ALPHA + a0[2], hi_bf(xq.y) * DN_ALPHA + a0[3]);
          o.z = pack2(lo_bf(xq.z) * DN_ALPHA + a1[0], hi_bf(xq.z) * DN_ALPHA + a1[1]);
          o.w = pack2(lo_bf(xq.w) * DN_ALPHA + a1[2], hi_bf(xq.w) * DN_ALPHA + a1[3]);
          *(u32x4*)(Y + ro + bj * 128) = o;
        }
      }
  }
};
#define FFN_HG(P) ((bfu*)((P).out + (size_t)M_TOK * 512))
#define FFN_HU(P) (FFN_HG(P) + (size_t)272 * 4 * DFF)
struct EpiFfn {
  static constexpr bool PERM = true, AFTER_DRAIN = false;
  bfu* gu; bfu* hg; bfu* hu; const float* cw; const float* cb; float* ostate;
  DI void operator()(const f32x4 (&acc)[2][2][4][2], const pg8::Unit& u, int wr, int wc, int fr, int fq) const {
    const int lane = (int)(threadIdx.x & 63u);
    const int cgl = u.pn * 128 + wc * 32 + 8 * fq;
    const int rowb = u.pm * 256 + wr * 64 + fr;
    if (u.pm >= 64) {
#pragma unroll
      for (int ai = 0; ai < 2; ++ai)
#pragma unroll
        for (int m = 0; m < 4; ++m) {
          bfu* rp = gu + (size_t)(rowb + ai * 128 + m * 16) * (2 * DFF) + cgl;
#pragma unroll
          for (int bj = 0; bj < 2; ++bj) {
            const f32x4 v0 = acc[ai][bj][m][0], v1 = acc[ai][bj][m][1];
            u32x4 o;
            o.x = pack2(v0[0], v0[1]); o.y = pack2(v0[2], v0[3]); o.z = pack2(v1[0], v1[1]); o.w = pack2(v1[2], v1[3]);
            *(u32x4*)(rp + bj * DFF) = o;
          }
        }
      return;
    }
#pragma unroll
    for (int n = 0; n < 2; ++n) {
      const int cc = cgl + 4 * n;
      const f32x4 w0 = *(const f32x4*)(cw + cc), w1 = *(const f32x4*)(cw + DFF + cc), w2 = *(const f32x4*)(cw + 2 * DFF + cc);
      const f32x4 fb = *(const f32x4*)(cb + cc);
#pragma unroll
      for (int ai = 0; ai < 2; ++ai) {
        unsigned gpx = 0u, gpy = 0u;
#pragma unroll
        for (int m = 0; m < 4; ++m) {
          const int r = rowb + ai * 128 + m * 16;
          const int slab = u.pm * 4 + ai * 2 + wr;
          const f32x4 g = acc[ai][0][m][n];
          const unsigned gx = pack2(g[0], g[1]), gy = pack2(g[2], g[3]);
          const unsigned s1x = fr == 15 ? gpx : gx, s1y = fr == 15 ? gpy : gy;
          const unsigned s2x = fr >= 14 ? gpx : gx, s2y = fr >= 14 ? gpy : gy;
          const unsigned p1x = (unsigned)__builtin_amdgcn_update_dpp(0, (int)s1x, 0x121, 0xf, 0xf, false);
          const unsigned p1y = (unsigned)__builtin_amdgcn_update_dpp(0, (int)s1y, 0x121, 0xf, 0xf, false);
          const unsigned p2x = (unsigned)__builtin_amdgcn_update_dpp(0, (int)s2x, 0x122, 0xf, 0xf, false);
          const unsigned p2y = (unsigned)__builtin_amdgcn_update_dpp(0, (int)s2y, 0x122, 0xf, 0xf, false);
          const f32x4 gc = f32x4{lo_bf(gx), hi_bf(gx), lo_bf(gy), hi_bf(gy)};
          const f32x4 g1 = f32x4{lo_bf(p1x), hi_bf(p1x), lo_bf(p1y), hi_bf(p1y)};
          const f32x4 g2 = f32x4{lo_bf(p2x), hi_bf(p2x), lo_bf(p2y), hi_bf(p2y)};
          const f32x4 up = acc[ai][1][m][n];
          const f32x4 a = w0 * g2 + w1 * g1 + w2 * gc + fb;
          f32x4 hh;
#pragma unroll
          for (int e = 0; e < 4; ++e) hh[e] = siluf_(a[e]) * up[e];
          if (m > 0 || fr >= 2) store_bf4(gu + (size_t)r * (2 * DFF) + DFF + cc, hh);
          if (m == 3 && fr >= 14) {
            *(uint2*)(hg + ((size_t)slab * 4 + (fr - 14)) * DFF + cc) = uint2{gx, gy};
            if ((u.pm & 7) == 7 && ai == 1 && wr == 1)
              *(f32x4*)(ostate + (size_t)(u.pm >> 3) * 2 * DFF + (size_t)(fr - 14) * DFF + cc) = gc;
          }
          if (m == 0 && fr < 2) {
            *(uint2*)(hg + ((size_t)slab * 4 + 2 + fr) * DFF + cc) = uint2{gx, gy};
            store_bf4(hu + ((size_t)slab * 2 + fr) * DFF + cc, up);
          }
          gpx = gx;
          gpy = gy;
        }
      }
    }
  }
};
struct EpiFin {
  static constexpr bool PERM = false, AFTER_DRAIN = false;
  const bfu* x2; const bfu* ep; const float* rinv; const float* pg; float* y;
  DI void operator()(const f32x4 (&acc)[2][2][4][2], const pg8::Unit& u, int wr, int wc, int fr, int fq) const {
    const int row0 = u.pm * 256 + wr * 64 + fr, col0 = u.pn * 256 + wc * 32 + 4 * fq;
#pragma unroll
    for (int ai = 0; ai < 2; ++ai)
#pragma unroll
      for (int m = 0; m < 4; ++m) {
        const int r = row0 + ai * 128 + m * 16;
        const size_t ro = (size_t)r * DM + col0;
        const float ri = rinv[r];
#pragma unroll
        for (int bj = 0; bj < 2; ++bj)
#pragma unroll
          for (int n = 0; n < 2; ++n) {
            const int co = bj * 128 + n * 16;
            const uint2 xq = *(const uint2*)(x2 + ro + co);
            const f32x4 xv = f32x4{lo_bf(xq.x), hi_bf(xq.x), lo_bf(xq.y), hi_bf(xq.y)};
            const uint2 eq = *(const uint2*)(ep + (size_t)r * EP_LD + col0 + co);
            const f32x4 gv = *(const f32x4*)(pg + col0 + co);
            const f32x4 a = acc[ai][bj][m][n];
            f32x4 o;
            o[0] = xv[0] + sigmoidf_(a[0]) * (lo_bf(eq.x) * ri * gv[0]);
            o[1] = xv[1] + sigmoidf_(a[1]) * (hi_bf(eq.x) * ri * gv[1]);
            o[2] = xv[2] + sigmoidf_(a[2]) * (lo_bf(eq.y) * ri * gv[2]);
            o[3] = xv[3] + sigmoidf_(a[3]) * (hi_bf(eq.y) * ri * gv[3]);
            *(f32x4*)(y + ro + co) = o;
          }
      }
  }
};
struct SplitOrder {
  int c;
  DI bool next(int i, pg8::Unit& u) const {
    if (i > 0 || c >= 64) return false;
    u.pm = 64 + (c >> 4); u.pn = (c >> 2) & 3;
    return true;
  }
  DI void a_ready(const pg8::Unit&) const {}
  DI void done(const pg8::Unit&) const {}
};
struct EpiSlab {
  static constexpr bool PERM = false, AFTER_DRAIN = false;
  float* slab; int ld;
  DI void operator()(const f32x4 (&acc)[2][2][4][2], const pg8::Unit& u, int wr, int wc, int fr, int fq) const {
    const int row0 = (u.pm - 64) * 256 + wr * 64 + fr, col0 = u.pn * 256 + wc * 32 + 4 * fq;
#pragma unroll
    for (int ai = 0; ai < 2; ++ai)
#pragma unroll
      for (int m = 0; m < 4; ++m) {
        float* rp = slab + (size_t)(row0 + ai * 128 + m * 16) * ld + col0;
#pragma unroll
        for (int bj = 0; bj < 2; ++bj)
#pragma unroll
          for (int n = 0; n < 2; ++n) *(f32x4*)(rp + bj * 128 + n * 16) = acc[ai][bj][m][n];
      }
  }
};
DI void run_split(PG8_LAS unsigned char* lds, const bfu* A, int lda, const bfu* Bt, int K, float* slabs, int sld) {
  const int c = (int)blockIdx.x;
  if (c >= 64) return;
  const int kp = c & 3;
  int koff, kl;
  if (K == 1024) { koff = kp * 256; kl = 256; }
  else { koff = kp < 2 ? kp * 768 : 1536 + (kp - 2) * 640; kl = kp < 2 ? 768 : 640; }
  pg8::Gemm g{A + koff, Bt + koff, M_TOK, DM, kl, lda, K};
  SplitOrder S{c};
  EpiSlab E{slabs + (size_t)kp * 1024 * sld, sld};
  pg8::gemm_phase<EpiSlab, SplitOrder, false>(lds, g, S, E, nullptr);
}

template <class Epi>
DI void run_pg8_sub(PG8_LAS unsigned char* lds, const bfu* A, int lda, const bfu* Bt, int M, int N, int K, const Epi& E, int G, int c) {
  pg8::Gemm g{A, Bt, M, N, K, lda, K};
  pg8::StaticOrder S;
  S.init(M, N, G, c);
  pg8::gemm_phase<Epi, pg8::StaticOrder, false>(lds, g, S, E, nullptr);
}
template <class Epi>
DI void run_pg8(PG8_LAS unsigned char* lds, const bfu* A, int lda, const bfu* Bt, int M, int N, int K, const Epi& E) {
  pg8::Gemm g{A, Bt, M, N, K, lda, K};
  pg8::StaticOrder S;
  S.init(M, N, (int)gridDim.x, (int)blockIdx.x);
  pg8::gemm_phase<Epi, pg8::StaticOrder, false>(lds, g, S, E, nullptr);
}

enum {
  PH_WT = 0,
  PH_GEMM_IN,
  PH_LORAIN,
  PH_LORA,
  PH_PREPA,
  PH_PREPB,
  PH_D1,
  PH_SCAN,
  PH_POST,
  PH_GEMM_O,
  PH_LN1,
  PH_GEMM_UP,
  PH_FFNCONV,
  PH_GEMM_DOWN,
  PH_LN2_PLE,
  PH_RINV,
  PH_GEMM_FIN,
  PH_FINS,
  PH_COUNT
};

constexpr int MT = M_TOK / 128;

__host__ __device__ constexpr int units_of(int ph, int wd_tiles) {
  return ph == PH_WT ? 1280 + M_TOK / 4
       : ph == PH_LORAIN ? (M_TOK / 64 + M_TOK / 16 + NSEQ)
       : ph == PH_LORA ? MT * 4 * 3
       : ph == PH_PREPA ? M_TOK / 16
       : ph == PH_PREPB ? (M_TOK / 8) * 3 / 4
       : ph == PH_D1 ? 1024
       : ph == PH_SCAN ? 2 * (256 + 1024)
       : ph == PH_POST ? M_TOK / 8
       : ph == PH_LN1 ? M_TOK / 8
       : ph == PH_FFNCONV ? (352 + 176)
       : ph == PH_LN2_PLE ? M_TOK / 8
       : ph == PH_RINV ? M_TOK / 16
       : ph == PH_FINS ? 256
       : 0;
}

constexpr int WT_EARLY = 1280;
DI void ph_wt_impl(const Params& P, int u, char* smem) {
  if (u >= P.wd_tiles) {
    const int lane = VT & 63, wave = VT >> 6;
    const int m = (u - P.wd_tiles) * 4 + wave;
    const float* xr = (m < M_P) ? P.x_p + (size_t)m * DM : P.x_s + (size_t)(m - M_P) * DM;
    const float* pr = (m < M_P) ? P.p_p + (size_t)m * PLE : P.p_s + (size_t)(m - M_P) * PLE;
    f32x4 v[4];
#pragma unroll
    for (int i = 0; i < 4; ++i) v[i] = *(const f32x4*)(xr + i * 256 + lane * 4);
    const f32x4 pv = *(const f32x4*)(pr + lane * 4);
    bfu* xb = (bfu*)(P.ws + OFF_XB) + (size_t)m * DM;
#pragma unroll
    for (int i = 0; i < 4; ++i) store_bf4(xb + i * 256 + lane * 4, v[i]);
    store_bf4((bfu*)(P.ws + OFF_PB) + (size_t)m * PLE + lane * 4, pv);
    return;
  }
  int wi = 0;
#pragma unroll
  for (int i = 1; i < 9; ++i)
    if (u >= P.wd[i].t0) wi = i;
  const float* src = P.wd[wi].src;
  bfu* dst = P.wd[wi].dst;
  const int K = P.wd[wi].K, N = P.wd[wi].N;
  int tl = u - P.wd[wi].t0;
  const int kts = K >> 6;
  const int nt = tl / kts, kt = tl - nt * kts;
  const int n0 = nt * 64, k0 = kt * 64;
  int drow0 = n0;
  if (wi == 5) {
    const int nn = n0 < DFF ? n0 : n0 - DFF;
    drow0 = (nn >> 7) * 256 + (n0 < DFF ? 0 : 128) + (nn & 127);
  }
  float* tile = (float*)smem;
  const int tid = VT;
#pragma unroll
  for (int i = 0; i < 4; ++i) {
    const int kr = (tid >> 4) + 16 * i, c4 = (tid & 15) * 4;
    f32x4 v = f32x4{0.f, 0.f, 0.f, 0.f};
    if (n0 + c4 + 3 < N) v = *(const f32x4*)(src + (size_t)(k0 + kr) * N + n0 + c4);
    tile[kr * 65 + c4 + 0] = v[0];
    tile[kr * 65 + c4 + 1] = v[1];
    tile[kr * 65 + c4 + 2] = v[2];
    tile[kr * 65 + c4 + 3] = v[3];
  }
  __syncthreads();
#pragma unroll
  for (int j = 0; j < 2; ++j) {
    const int nr = (tid >> 3) + 32 * j, kc = (tid & 7) * 8;
    float f[8];
#pragma unroll
    for (int e = 0; e < 8; ++e) f[e] = tile[(kc + e) * 65 + nr];
    *(u32x4*)(dst + (size_t)(drow0 + nr) * K + k0 + kc) = pack8(f);
  }
  __syncthreads();
}

DI void ph_wt(const Params& P, int u, char* smem) {
  ph_wt_impl(P, u < WT_EARLY ? u : u + (P.wd_tiles - WT_EARLY), smem);
}

DI void ph_lorain(const Params& P, int u, char* smem) {
  const bfu* projA = (const bfu*)(P.ws + OFF_PROJA);
  const int tid = VT;
  if (u < M_TOK / 64) {
    const int lane = tid & 63, wave = tid >> 6;
    const int r0 = (u * 4 + wave) * 16;
    const bfu* ap = (const bfu*)(P.ws + OFF_XB) + (size_t)(r0 + (lane & 15)) * DM + (lane >> 4) * 8;
    const bfu* bp = (const bfu*)(P.ws + WT_IN) + (size_t)(3840 + (lane & 15)) * DM + (lane >> 4) * 8;
    f32x4 acc = f32x4{0.f, 0.f, 0.f, 0.f};
#pragma unroll 8
    for (int ks = 0; ks < 32; ++ks) {
      const bf16x8 af = *(const bf16x8*)(ap + ks * 32);
      const bf16x8 bf = *(const bf16x8*)(bp + ks * 32);
      acc = __builtin_amdgcn_mfma_f32_16x16x32_bf16(af, bf, acc, 0, 0, 0);
    }
    if ((lane & 15) < 8) {
      float* ba = (float*)(P.ws + OFF_BA);
#pragma unroll
      for (int j = 0; j < 4; ++j) ba[(size_t)(r0 + (lane >> 4) * 4 + j) * 8 + (lane & 15)] = acc[j];
    }
    return;
  }
  u -= M_TOK / 64;
  if (u < M_TOK / 16) {
    bfu* lin = (bfu*)(P.ws + OFF_LORAIN);
    const int lane = tid & 63, wave = tid >> 6;
    const int cg = lane & 31, sub = lane >> 5;
    const int mb = u * 16 + wave * 4 + sub * 2;
    const int col = 1536 + cg * 8;
    float mu[8];
    load8f(P.a_mu + col, mu);
    const int t0 = t_of_row(mb);
    u32x4 rows[3];
    if (t0 != 0) rows[0] = *(const u32x4*)(projA + (size_t)(mb - 1) * ASW + col);
#pragma unroll
    for (int i = 0; i < 2; ++i) rows[i + 1] = *(const u32x4*)(projA + (size_t)(mb + i) * ASW + col);
    float prev[8];
    if (t0 != 0) unpack8(rows[0], prev);
    else {
      const int s = seq_of_row(mb);
      if (s < 8) {
#pragma unroll
        for (int e = 0; e < 8; ++e) prev[e] = 0.f;
      } else load8f(P.st_shift + (size_t)(s - 8) * ASW + col, prev);
    }
#pragma unroll
    for (int i = 0; i < 2; ++i) {
      float uc[8], o[8];
      unpack8(rows[i + 1], uc);
#pragma unroll
      for (int e = 0; e < 8; ++e) {
        float xs = uc[e] + (prev[e] - uc[e]) * mu[e];
        o[e] = (cg < 8) ? tanhf(xs) : (cg < 16 ? xs : sigmoidf_(xs));
        prev[e] = uc[e];
      }
      *(u32x4*)(lin + (size_t)(mb + i) * 256 + cg * 8) = pack8(o);
    }
  } else {
    const int s = u - M_TOK / 16;
    const int row0 = row0_of_seq(s), T = T_of_seq(s);
    const bfu* projB = (const bfu*)P.out;
    float* oshift = P.out + (s < 8 ? O_PA_SHIFT + (size_t)s * ASW : O_SA_SHIFT + (size_t)(s - 8) * ASW);
    for (int i = tid; i < ASW; i += 256) oshift[i] = bf2f(projA[(size_t)(row0 + T - 1) * ASW + i]);
    float* oconv = P.out + (s < 8 ? O_PB_CONV + (size_t)s * 3 * BQKV : O_SB_CONV + (size_t)(s - 8) * 3 * BQKV);
    for (int i = tid; i < 3 * BQKV; i += 256) {
      int j = i / BQKV, c = i - j * BQKV;
      oconv[i] = bf2f(projB[(size_t)(row0 + T - 3 + j) * PB_W + c]);
    }
  }
}

DI void ph_lora(const Params& P, int u, char* smem) {
  const int which = u / (MT * 4);
  const int r = u - which * (MT * 4);
  const int mt = r >> 2, nt = r & 3;
  const int m0 = mt * 128, n0 = nt * 128;
  const bfu* lin = (const bfu*)(P.ws + OFF_LORAIN);
  if (which == 0) {
    bfu* stream = (bfu*)(P.ws + OFF_STREAM);
    const float* w0 = P.a_w0;
    gemm_tile<false>(lin + (size_t)m0 * 256, 256, (const bfu*)(P.ws + WT_W2) + (size_t)n0 * 64, 64, m0, n0,
                     (bfu*)smem, [&](int m, int n, f32x4 v) {
                       f32x4 e;
#pragma unroll
                       for (int j = 0; j < 4; ++j) {
                         float w = -softplusf_(-(w0[n + j] + v[j])) - 0.5f;
                         e[j] = __expf(w);
                       }
                       store_bf4(stream + ((size_t)(m * 8 + (n >> 6)) * 6 + 1) * 64 + (n & 63), e);
                     });
  } else if (which == 1) {
    bfu* abuf = (bfu*)(P.ws + OFF_ABUF);
    const float* a0 = P.a_a0;
    gemm_tile<false>(lin + (size_t)m0 * 256 + 64, 256, (const bfu*)(P.ws + WT_A2) + (size_t)n0 * 64, 64, m0, n0,
                     (bfu*)smem, [&](int m, int n, f32x4 v) {
                       f32x4 e;
#pragma unroll
                       for (int j = 0; j < 4; ++j) e[j] = sigmoidf_(a0[n + j] + v[j]);
                       store_bf4(abuf + (size_t)m * 512 + n, e);
                     });
  } else {
    bfu* gbuf = (bfu*)(P.ws + OFF_G);
    gemm_tile<false>(lin + (size_t)m0 * 256 + 128, 256, (const bfu*)(P.ws + WT_G2) + (size_t)n0 * 128, 128, m0, n0,
                     (bfu*)smem, [&](int m, int n, f32x4 v) { store_bf4(gbuf + (size_t)m * 512 + n, v); });
  }
}

DI void ph_prepa(const Params& P, int u, char* smem) {
  const int tid = VT, lane = tid & 63, wave = tid >> 6;
  const int h = lane >> 3, sub = lane & 7;
  const int ch = h * 64 + sub * 8;
  const int m0 = u * 16 + wave * 4;
  const bfu* projA = (const bfu*)(P.ws + OFF_PROJA);
  const bfu* abuf = (const bfu*)(P.ws + OFF_ABUF);
  bfu* stream = (bfu*)(P.ws + OFF_STREAM);
  float mu[3][8], kkc[8], kac[8], rkc[8];
#pragma unroll
  for (int p = 0; p < 3; ++p) load8f(P.a_mu + p * 512 + ch, mu[p]);
  load8f(P.a_k_k + ch, kkc);
  load8f(P.a_k_a + ch, kac);
  load8f(P.a_r_k + ch, rkc);
  float prev[3][8];
  const int t0 = t_of_row(m0);
  if (t0 != 0) {
#pragma unroll
    for (int p = 0; p < 3; ++p) unpack8(*(const u32x4*)(projA + (size_t)(m0 - 1) * ASW + p * 512 + ch), prev[p]);
  } else {
    const int s = seq_of_row(m0);
#pragma unroll
    for (int p = 0; p < 3; ++p) {
      if (s < 8) {
#pragma unroll
        for (int e = 0; e < 8; ++e) prev[p][e] = 0.f;
      } else load8f(P.st_shift + (size_t)(s - 8) * ASW + p * 512 + ch, prev[p]);
    }
  }
#pragma unroll
  for (int g = 0; g < 2; ++g) {
    u32x4 ur[2][3], ar[2];
#pragma unroll
    for (int i = 0; i < 2; ++i) {
      const int m = m0 + g * 2 + i;
#pragma unroll
      for (int p = 0; p < 3; ++p) ur[i][p] = *(const u32x4*)(projA + (size_t)m * ASW + p * 512 + ch);
      ar[i] = *(const u32x4*)(abuf + (size_t)m * 512 + ch);
    }
#pragma unroll
    for (int i = 0; i < 2; ++i) {
      const int m = m0 + g * 2 + i;
      float xs[3][8], a[8];
#pragma unroll
      for (int p = 0; p < 3; ++p) {
        float uc[8];
        unpack8(ur[i][p], uc);
#pragma unroll
        for (int e = 0; e < 8; ++e) {
          xs[p][e] = uc[e] + (prev[p][e] - uc[e]) * mu[p][e];
          prev[p][e] = uc[e];
        }
      }
      unpack8(ar[i], a);
      float kkr[8], k2[8], bb[8];
      float ssl = 0.f, bl = 0.f;
#pragma unroll
      for (int e = 0; e < 8; ++e) {
        kkr[e] = xs[1][e] * kkc[e];
        ssl += kkr[e] * kkr[e];
        k2[e] = xs[1][e] * (1.f + (a[e] - 1.f) * kac[e]);
        bl += xs[0][e] * k2[e] * rkc[e];
      }
      const float rinv = rsqrtf(sum8(ssl) + L2_EPS);
      const float bonus = sum8(bl);
#pragma unroll
      for (int e = 0; e < 8; ++e) {
        kkr[e] *= rinv;
        bb[e] = kkr[e] * a[e];
      }
      bfu* sp = stream + (size_t)(m * 8 + h) * 384 + sub * 8;
      *(u32x4*)(sp) = pack8(xs[0]);
      *(u32x4*)(sp + 128) = pack8(k2);
      *(u32x4*)(sp + 192) = pack8(xs[2]);
      *(u32x4*)(sp + 256) = pack8(kkr);
      *(u32x4*)(sp + 320) = pack8(bb);
      if (sub == 0) ((float*)(P.ws + OFF_BONUS))[m * 8 + h] = bonus;
    }
  }
}

DI void ph_prepb(const Params& P, int u, char* smem) {
  const int tid = VT, lane = tid & 63, wave = tid >> 6;
  const int wt = u * 4 + wave;
  const int tg = wt / 3, p = wt - tg * 3;
  const int h = lane >> 4, sub = lane & 15;
  const int c = p * 512 + h * 128 + sub * 8;
  const int m0 = tg * 8;
  const int s = seq_of_row(m0), t0 = t_of_row(m0);
  const bfu* projB = (const bfu*)P.out;
  bfu* sb = (bfu*)(P.ws + OFF_STREAMB);
  u32x4 rq[11];
#pragma unroll
  for (int i = 0; i < 11; ++i)
    if (t0 + i - 3 >= 0) rq[i] = *(const u32x4*)(projB + (size_t)(m0 + i - 3) * PB_W + c);
  float cw[4][8];
#pragma unroll
  for (int j = 0; j < 4; ++j) load8f(P.b_conv_w + j * BQKV + c, cw[j]);
  float r0[8], r1[8], r2[8], r3[8];
  if (t0 >= 3) {
    unpack8(rq[0], r0);
    unpack8(rq[1], r1);
    unpack8(rq[2], r2);
  } else if (s >= 8) {
    load8f(P.st_bconv + ((size_t)(s - 8) * 3 + 0) * BQKV + c, r0);
    load8f(P.st_bconv + ((size_t)(s - 8) * 3 + 1) * BQKV + c, r1);
    load8f(P.st_bconv + ((size_t)(s - 8) * 3 + 2) * BQKV + c, r2);
  } else {
#pragma unroll
    for (int e = 0; e < 8; ++e) { r0[e] = 0.f; r1[e] = 0.f; r2[e] = 0.f; }
  }
  const float scale = (p == 0) ? 0.08838834764831845f : 1.f;
#pragma unroll
  for (int i = 0; i < 8; ++i) {
    unpack8(rq[i + 3], r3);
    float y[8];
    float ss = 0.f;
#pragma unroll
    for (int e = 0; e < 8; ++e) {
      float a = cw[0][e] * r0[e] + cw[1][e] * r1[e] + cw[2][e] * r2[e] + cw[3][e] * r3[e];
      y[e] = siluf_(a);
      ss += y[e] * y[e];
      r0[e] = r1[e];
      r1[e] = r2[e];
      r2[e] = r3[e];
    }
    if (p < 2) {
      const float rn = rsqrtf(row16_sum(ss) + L2_EPS) * scale;
#pragma unroll
      for (int e = 0; e < 8; ++e) y[e] *= rn;
    }
    *(u32x4*)(sb + (size_t)((m0 + i) * 4 + h) * 384 + p * 128 + sub * 8) = pack8(y);
  }
  if (p == 0 && lane < 32) {
    int i = lane >> 2, hh = lane & 3;
    const float* ba = (const float*)(P.ws + OFF_BA) + (size_t)(m0 + i) * 8;
    float beta = sigmoidf_(ba[hh]);
    float g = -__expf(P.b_a_log[hh]) * softplusf_(ba[4 + hh] + P.b_dt_bias[hh]);
    float* bg = (float*)(P.ws + OFF_BG) + (size_t)(m0 + i) * 8;
    bg[hh] = beta;
    bg[4 + hh] = __expf(g);
    ((float*)(P.ws + OFF_GG))[(size_t)(m0 + i) * 4 + hh] = g;
  }
}

constexpr int CH = 16;
DI void lds_barrier() {
  asm volatile("s_waitcnt lgkmcnt(0)" ::: "memory");
  __builtin_amdgcn_s_barrier();
  asm volatile("" ::: "memory");
}

DI void chunk_gload(u32x4 (&rg)[3], const bfu* base, size_t step_stride, int nsteps) {
#pragma unroll
  for (int j = 0; j < 3; ++j) {
    int idx = VT + 256 * j;
    int st = idx / 48, w = idx - st * 48;
    if (st < nsteps) rg[j] = *(const u32x4*)(base + (size_t)st * step_stride + w * 8);
  }
}
template <bool DECAY>
DI void chunk_lstore(const u32x4 (&rg)[3], float* buf, int nsteps) {
#pragma unroll
  for (int j = 0; j < 3; ++j) {
    int idx = VT + 256 * j;
    int st = idx / 48, w = idx - st * 48;
    if (st < nsteps) {
      float4 a, b;
      a.x = lo_bf(rg[j].x); a.y = hi_bf(rg[j].x); a.z = lo_bf(rg[j].y); a.w = hi_bf(rg[j].y);
      b.x = lo_bf(rg[j].z); b.y = hi_bf(rg[j].z); b.z = lo_bf(rg[j].w); b.w = hi_bf(rg[j].w);
      if (DECAY && (w >> 3) == 1) {
        a.x = __expf(-a.x); a.y = __expf(-a.y); a.z = __expf(-a.z); a.w = __expf(-a.w);
        b.x = __expf(-b.x); b.y = __expf(-b.y); b.z = __expf(-b.z); b.w = __expf(-b.w);
      }
      float* d = buf + st * 384 + w * 8;
      *(float4*)d = a;
      *(float4*)(d + 4) = b;
    }
  }
}

DI float dot4(f32x4 a, f32x4 b) {
  typedef float f2 __attribute__((ext_vector_type(2)));
  const f2 a01 = {a[0], a[1]}, a23 = {a[2], a[3]}, b01 = {b[0], b[1]}, b23 = {b[2], b[3]};
  const f2 t = a23 * b23 + a01 * b01;
  return t[0] + t[1];
}
template <int R> struct RwkvOps { f32x4 r4, w4, k4, kk4, b4; float vv[R]; };
template <int R>
DI void rwkv_ld(RwkvOps<R>& o, const float* b, int j0, int v) {
  o.r4 = *(const f32x4*)(b + j0);
  o.w4 = *(const f32x4*)(b + 64 + j0);
  o.k4 = *(const f32x4*)(b + 128 + j0);
#pragma unroll
  for (int r = 0; r < R; ++r) o.vv[r] = b[192 + v + r * 16];
  o.kk4 = *(const f32x4*)(b + 256 + j0);
  o.b4 = *(const f32x4*)(b + 320 + j0);
}
template <int NS, int R>
DI void rwkv_steps(const float* buf, f32x4 (&S)[R], int j0, int v, int l15, float (&oacc)[R], float* qp) {
  RwkvOps<R> ops[3];
  rwkv_ld<R>(ops[0], buf, j0, v);
  rwkv_ld<R>(ops[1], buf + 384, j0, v);
#pragma unroll
  for (int st = 0; st < NS; ++st) {
    if (st + 2 < NS) rwkv_ld<R>(ops[(st + 2) % 3], buf + (st + 2) * 384, j0, v);
    const RwkvOps<R>& o = ops[st % 3];
    float p[R], q[R];
#pragma unroll
    for (int r = 0; r < R; ++r) p[r] = dot4(S[r], o.kk4);
#pragma unroll
    for (int r = 0; r < R; ++r) p[r] = row16_sum(p[r]);
#pragma unroll
    for (int r = 0; r < R; ++r) {
      const f32x4 base = S[r] * o.w4 + o.k4 * o.vv[r];
      S[r] = base - o.b4 * p[r];
    }
#pragma unroll
    for (int r = 0; r < R; ++r) q[r] = dot4(S[r], o.r4);
    if constexpr (R == 1) {
      qp[st * 64] = q[0];
    } else {
#pragma unroll
      for (int r = 0; r < R; ++r) {
        q[r] = row16_sum(q[r]);
        oacc[r] = (l15 == st) ? q[r] : oacc[r];
      }
    }
  }
  if constexpr (R == 1) {
    asm volatile("" ::: "memory");
    const float* qr = qp + l15 * 64 - l15;
    const f32x4 a = *(const f32x4*)(qr), b = *(const f32x4*)(qr + 4), c = *(const f32x4*)(qr + 8), d = *(const f32x4*)(qr + 12);
    const f32x4 s4 = (a + b) + (c + d);
    oacc[0] = (s4[0] + s4[1]) + (s4[2] + s4[3]);
    asm volatile("" ::: "memory");
  }
}

template <int R>
DI void rwkv_unit(const Params& P, int s, int h, int rgp, char* smem) {
  const int tid = VT, lane = tid & 63, wave = tid >> 6;
  const int T = T_of_seq(s), row0 = row0_of_seq(s);
  const int vl = wave * 4 + (lane >> 4);
  const int v = rgp * (16 * R) + vl;
  const int l15 = lane & 15;
  const int j0 = l15 * 4;
  float* buf0 = (float*)smem;
  float* qp = buf0 + 2 * CH * 384 + wave * (CH * 64) + lane;
  f32x4 S[R];
#pragma unroll
  for (int r = 0; r < R; ++r) {
    if (s < 8) S[r] = f32x4{0.f, 0.f, 0.f, 0.f};
    else S[r] = *(const f32x4*)(P.st_wkv + (((size_t)(s - 8) * 8 + h) * 64 + v + r * 16) * 64 + j0);
  }
  const bfu* stream = (const bfu*)(P.ws + OFF_STREAM) + ((size_t)row0 * 8 + h) * 384;
  const size_t sstride = 8 * 384;
  bfu* omix = (bfu*)(P.ws + OFF_OMIX) + (size_t)row0 * 1024 + h * 64 + v;
  const int nch = (T + CH - 1) / CH;
  u32x4 rg[3], rgB[3], rgC[3];
  chunk_gload(rg, stream, sstride, min(CH, T));
  chunk_lstore<true>(rg, buf0, min(CH, T));
  __syncthreads();
  if (nch > 1) chunk_gload(rg, stream + (size_t)1 * CH * sstride, sstride, min(CH, T - 1 * CH));
  if (nch > 2) chunk_gload(rgB, stream + (size_t)2 * CH * sstride, sstride, min(CH, T - 2 * CH));
  if (nch > 3) chunk_gload(rgC, stream + (size_t)3 * CH * sstride, sstride, min(CH, T - 3 * CH));
  if (R == 1) __builtin_amdgcn_s_setprio(3);
  for (int c = 0; c < nch; ++c) {
    const int nsteps = min(CH, T - c * CH);
    const int nnext = (c + 1 < nch) ? min(CH, T - (c + 1) * CH) : 0;
    const float* buf = buf0 + (c & 1) * CH * 384;
    float oacc[R];
#pragma unroll
    for (int r = 0; r < R; ++r) oacc[r] = 0.f;
    if (nsteps == CH) rwkv_steps<CH, R>(buf, S, j0, v, l15, oacc, qp);
    else rwkv_steps<8, R>(buf, S, j0, v, l15, oacc, qp);
    if (l15 < nsteps) {
#pragma unroll
      for (int r = 0; r < R; ++r) omix[(size_t)(c * CH + l15) * 1024 + r * 16] = f2bf(oacc[r]);
    }
    if (nnext > 0) chunk_lstore<true>(rg, buf0 + ((c + 1) & 1) * CH * 384, nnext);
#pragma unroll
    for (int j = 0; j < 3; ++j) { rg[j] = rgB[j]; rgB[j] = rgC[j]; }
    if (c + 4 < nch) chunk_gload(rgC, stream + (size_t)(c + 4) * CH * sstride, sstride, min(CH, T - (c + 4) * CH));
    lds_barrier();
  }
  if (R == 1) __builtin_amdgcn_s_setprio(0);
  float* o = P.out + (s < 8 ? O_PA_WKV + (((size_t)s * 8 + h) * 64 + v) * 64 + j0
                            : O_SA_WKV + (((size_t)(s - 8) * 8 + h) * 64 + v) * 64 + j0);
#pragma unroll
  for (int r = 0; r < R; ++r) *(f32x4*)(o + (size_t)r * 16 * 64) = S[r];
}

template <int R> struct DeltaOps { f32x4 q0, q1, k0, k1; float vv[R], beta, alpha; };
template <int R>
DI void delta_ld(DeltaOps<R>& o, const float* b, const float* bg, int j0, int c) {
  o.q0 = *(const f32x4*)(b + j0);
  o.q1 = *(const f32x4*)(b + 64 + j0);
  o.k0 = *(const f32x4*)(b + 128 + j0);
  o.k1 = *(const f32x4*)(b + 192 + j0);
#pragma unroll
  for (int r = 0; r < R; ++r) o.vv[r] = b[256 + c + r * 16];
  o.beta = bg[0];
  o.alpha = bg[1];
}
template <int NS, int R>
DI void delta_steps(const float* buf, const float* bgc, f32x4 (&S0)[R], f32x4 (&S1)[R], int j0, int c, int l15,
                    float (&oacc)[R]) {
  DeltaOps<R> ops[3];
  delta_ld<R>(ops[0], buf, bgc, j0, c);
  delta_ld<R>(ops[1], buf + 384, bgc + 2, j0, c);
#pragma unroll
  for (int st = 0; st < NS; ++st) {
    if (st + 2 < NS) delta_ld<R>(ops[(st + 2) % 3], buf + (st + 2) * 384, bgc + (st + 2) * 2, j0, c);
    const DeltaOps<R>& o = ops[st % 3];
    float p[R], q[R];
#pragma unroll
    for (int r = 0; r < R; ++r) {
      const f32x4 t0 = S0[r] * o.k0 + S1[r] * o.k1;
      p[r] = (t0[0] + t0[1]) + (t0[2] + t0[3]);
    }
#pragma unroll
    for (int r = 0; r < R; ++r) p[r] = row16_sum(p[r]);
#pragma unroll
    for (int r = 0; r < R; ++r) {
      const float vn = o.beta * (o.vv[r] - o.alpha * p[r]);
      S0[r] = S0[r] * o.alpha + o.k0 * vn;
      S1[r] = S1[r] * o.alpha + o.k1 * vn;
      const f32x4 t1 = S0[r] * o.q0 + S1[r] * o.q1;
      q[r] = (t1[0] + t1[1]) + (t1[2] + t1[3]);
    }
#pragma unroll
    for (int r = 0; r < R; ++r) {
      q[r] = row16_sum(q[r]);
      oacc[r] = (l15 == st) ? q[r] : oacc[r];
    }
  }
}

template <int R>
DI void delta_unit(const Params& P, int s, int h, int cg_, char* smem) {
  const int tid = VT, lane = tid & 63, wave = tid >> 6;
  const int T = T_of_seq(s), row0 = row0_of_seq(s);
  const int cl = wave * 4 + (lane >> 4);
  const int c = cg_ * (16 * R) + cl;
  const int l15 = lane & 15;
  const int j0 = l15 * 4;
  float* buf0 = (float*)smem;
  float* bgb = buf0 + 2 * CH * 384;
  f32x4 S0[R], S1[R];
#pragma unroll
  for (int r = 0; r < R; ++r) {
    if (s < 8) {
      S0[r] = f32x4{0.f, 0.f, 0.f, 0.f};
      S1[r] = S0[r];
    } else {
      const float* sp = P.st_ssm + (((size_t)(s - 8) * 4 + h) * 128 + j0) * 128 + c + r * 16;
#pragma unroll
      for (int i = 0; i < 4; ++i) { S0[r][i] = sp[(size_t)i * 128]; S1[r][i] = sp[(size_t)(i + 64) * 128]; }
    }
  }
  const bfu* stream = (const bfu*)(P.ws + OFF_STREAMB) + ((size_t)row0 * 4 + h) * 384;
  const size_t sstride = 4 * 384;
  const float* bg = (const float*)(P.ws + OFF_BG);
  bfu* omix = (bfu*)(P.ws + OFF_OMIX) + (size_t)row0 * 1024 + 512 + h * 128 + c;
  const int nch = (T + CH - 1) / CH;
  u32x4 rg[3];
  float bgr = 0.f;
  {
    int n0 = min(CH, T);
    chunk_gload(rg, stream, sstride, n0);
    if (tid < n0 * 2) bgr = bg[(size_t)(row0 + (tid >> 1)) * 8 + (tid & 1) * 4 + h];
    chunk_lstore<false>(rg, buf0, n0);
    if (tid < n0 * 2) bgb[tid] = bgr;
  }
  __syncthreads();
  for (int ci = 0; ci < nch; ++ci) {
    const int nsteps = min(CH, T - ci * CH);
    const int nnext = (ci + 1 < nch) ? min(CH, T - (ci + 1) * CH) : 0;
    if (nnext > 0) {
      chunk_gload(rg, stream + (size_t)(ci + 1) * CH * sstride, sstride, nnext);
      if (tid < nnext * 2) bgr = bg[(size_t)(row0 + (ci + 1) * CH + (tid >> 1)) * 8 + (tid & 1) * 4 + h];
    }
    const float* buf = buf0 + (ci & 1) * CH * 384;
    const float* bgc = bgb + (ci & 1) * CH * 2;
    float oacc[R];
#pragma unroll
    for (int r = 0; r < R; ++r) oacc[r] = 0.f;
    if (nsteps == CH) delta_steps<CH, R>(buf, bgc, S0, S1, j0, c, l15, oacc);
    else delta_steps<8, R>(buf, bgc, S0, S1, j0, c, l15, oacc);
    if (l15 < nsteps) {
#pragma unroll
      for (int r = 0; r < R; ++r) omix[(size_t)(ci * CH + l15) * 1024 + r * 16] = f2bf(oacc[r]);
    }
    if (nnext > 0) {
      chunk_lstore<false>(rg, buf0 + ((ci + 1) & 1) * CH * 384, nnext);
      if (tid < nnext * 2) bgb[((ci + 1) & 1) * CH * 2 + tid] = bgr;
    }
    lds_barrier();
  }
  float* o = P.out + (s < 8 ? O_PB_SSM + (((size_t)s * 4 + h) * 128 + j0) * 128 + c
                            : O_SB_SSM + (((size_t)(s - 8) * 4 + h) * 128 + j0) * 128 + c);
#pragma unroll
  for (int r = 0; r < R; ++r)
#pragma unroll
    for (int i = 0; i < 4; ++i) { o[(size_t)i * 128 + r * 16] = S0[r][i]; o[(size_t)(i + 64) * 128 + r * 16] = S1[r][i]; }
}

constexpr int DLD = 136;
template <int I> struct SubStep {
  static DI void run(float (&sol)[64], const float* Lm, const float* scp, const bfu* colp) {
    SubStep<I - 1>::run(sol, Lm, scp, colp);
    float a0 = bf2f(colp[I * 136]) * scp[I], a1 = 0.f;
#pragma unroll
    for (int j4 = 0; j4 < (I + 3) / 4; ++j4) {
      const f32x4 l = *(const f32x4*)(Lm + I * 68 + j4 * 4);
      if (j4 * 4 + 0 < I) a0 -= l[0] * sol[j4 * 4 + 0];
      if (j4 * 4 + 1 < I) a1 -= l[1] * sol[j4 * 4 + 1];
      if (j4 * 4 + 2 < I) a0 -= l[2] * sol[j4 * 4 + 2];
      if (j4 * 4 + 3 < I) a1 -= l[3] * sol[j4 * 4 + 3];
      if ((j4 & 3) == 3) { asm volatile("" ::: "memory"); __builtin_amdgcn_sched_barrier(0); }
    }
    sol[I] = a0 + a1;
    asm volatile("" ::: "memory");
    __builtin_amdgcn_sched_barrier(0);
  }
};
template <> struct SubStep<-1> {
  static DI void run(float (&)[64], const float*, const float*, const bfu*) {}
};

DI void delta_d1(const Params& P, int item, char* smem) {
  int tid_ = VT; asm volatile("" : "+v"(tid_));
  const int tid = tid_, lane = tid & 63, wave = tid >> 6;
  const int chunk = item & 31, h = (item >> 5) & 3, s = item >> 7;
  const int m0 = s * 2048 + chunk * 64;
  bfu* Qs = (bfu*)smem;
  bfu* Ks = Qs + 64 * DLD;
  bfu* Vs = Ks + 64 * DLD;
  float* Lm = (float*)(Vs + 64 * DLD);
  float* Gs = Lm + 64 * 68;
  float* Bs = Gs + 64;
  float* Bk = Bs + 64;
  bfu* sb = (bfu*)(P.ws + OFF_STREAMB);
  bfu* projB = (bfu*)P.out;
#pragma unroll
  for (int j = 0; j < 4; ++j) {
    const int idx = tid + 256 * j, row = idx >> 4, c8 = (idx & 15) * 8;
    const bfu* sp = sb + ((size_t)(m0 + row) * 4 + h) * 384 + c8;
    *(u32x4*)(Qs + row * DLD + c8) = *(const u32x4*)sp;
    *(u32x4*)(Ks + row * DLD + c8) = *(const u32x4*)(sp + 128);
    *(u32x4*)(Vs + row * DLD + c8) = *(const u32x4*)(sp + 256);
  }
  if (wave == 0) {
    float x = ((const float*)(P.ws + OFF_GG))[(size_t)(m0 + lane) * 4 + h];
#pragma unroll
    for (int off = 1; off < 64; off <<= 1) {
      const float y = __shfl_up(x, off, 64);
      if (lane >= off) x += y;
    }
    Gs[lane] = x;
    ((float*)(projB + (size_t)(m0 + lane) * PB_W + 768))[h] = x;
    const float be = ((const float*)(P.ws + OFF_BG))[(size_t)(m0 + lane) * 8 + h];
    Bs[lane] = be;
    Bk[lane] = be * __expf(x);
  }
  __syncthreads();
  {
#pragma unroll 1
    for (int nt = 0; nt < 4; ++nt) {
      f32x4 akk = f32x4{0.f, 0.f, 0.f, 0.f}, aqk = akk;
#pragma unroll
      for (int ks = 0; ks < 4; ++ks) {
        const int ko = ks * 32 + (lane >> 4) * 8;
        const bf16x8 ak = *(const bf16x8*)(Ks + (16 * wave + (lane & 15)) * DLD + ko);
        const bf16x8 aq = *(const bf16x8*)(Qs + (16 * wave + (lane & 15)) * DLD + ko);
        const bf16x8 b = *(const bf16x8*)(Ks + (16 * nt + (lane & 15)) * DLD + ko);
        akk = __builtin_amdgcn_mfma_f32_16x16x32_bf16(ak, b, akk, 0, 0, 0);
        aqk = __builtin_amdgcn_mfma_f32_16x16x32_bf16(aq, b, aqk, 0, 0, 0);
      }
#pragma unroll
      for (int j = 0; j < 4; ++j) {
        const int i = 16 * wave + (lane >> 4) * 4 + j, jj = 16 * nt + (lane & 15);
        const float e = __expf(fminf(Gs[i] - Gs[jj], 0.f));
        Lm[i * 68 + jj] = (jj < i) ? Bs[i] * akk[j] * e : 0.f;
        projB[(size_t)(m0 + i) * PB_W + 512 + h * 64 + jj] = f2bf((jj <= i) ? aqk[j] * e : 0.f);
      }
    }
  }
  __syncthreads();
  {
    const bool isv = tid < 128;
    const bfu* colp = isv ? Vs + tid : Ks + (tid - 128);
    float sol[64];
    SubStep<63>::run(sol, Lm, isv ? Bs : Bk, colp);
    __syncthreads();
    bfu* Ob = (bfu*)smem;
#pragma unroll
    for (int i = 0; i < 64; ++i) Ob[i * 264 + tid] = f2bf(sol[i]);
  }
  __syncthreads();
  {
    const bfu* Ob = (const bfu*)smem;
#pragma unroll
    for (int j = 0; j < 8; ++j) {
      const int idx = tid + 256 * j, row = idx >> 5, c8 = (idx & 31) * 8;
      const u32x4 v = *(const u32x4*)(Ob + row * 264 + c8);
      if (c8 < 128) *(u32x4*)(sb + ((size_t)(m0 + row) * 4 + h) * 384 + 256 + c8) = v;
      else *(u32x4*)(projB + (size_t)(m0 + row) * PB_W + h * 128 + (c8 - 128)) = v;
    }
  }
  __syncthreads();
}

DI void delta_d2(const Params& P, int s, int h, int cg_, char* smem) {
  int tid_ = VT; asm volatile("" : "+v"(tid_));
  const int tid = tid_, lane = tid & 63, wave = tid >> 6;
  const int r16 = lane & 15, q4 = lane >> 4;
  bfu* Ws = (bfu*)smem;
  bfu* Qs = Ws + 64 * DLD;
  bfu* KT = Qs + 64 * DLD;
  bfu* AT = KT + 128 * 72;
  bfu* VnT = AT + 64 * 72;
  bfu* ST = VnT + 16 * 72;
  float* Us = (float*)(ST + 16 * DLD);
  const int row0 = s * 2048, col0 = cg_ * 16;
  const bfu* sb = (const bfu*)(P.ws + OFF_STREAMB);
  const bfu* projB = (const bfu*)P.out;
  bfu* omix = (bfu*)(P.ws + OFF_OMIX);
  f32x4 accS[2];
  accS[0] = f32x4{0.f, 0.f, 0.f, 0.f};
  accS[1] = accS[0];
  for (int i = tid; i < 16 * DLD / 2; i += 256) ((unsigned*)ST)[i] = 0u;
  u32x4 rw[4], rq[4], rk[4], ra[2], ru;
  float gj[4], gk = 0.f, glast = 0.f, glcur = 0.f;
#define D2_PREFETCH(cc)                                                                                   \
  {                                                                                                       \
    const int mb = row0 + (cc) * 64;                                                                      \
    _Pragma("unroll") for (int j = 0; j < 4; ++j) {                                                       \
      const int idx = tid + 256 * j, row = idx >> 4, c8 = (idx & 15) * 8;                                 \
      const size_t m = (size_t)(mb + row);                                                                \
      rw[j] = *(const u32x4*)(projB + m * PB_W + h * 128 + c8);                                           \
      rq[j] = *(const u32x4*)(sb + (m * 4 + h) * 384 + c8);                                               \
      gj[j] = ((const float*)(projB + m * PB_W + 768))[h];                                                \
      rk[j] = *(const u32x4*)(sb + ((size_t)(mb + (tid & 63)) * 4 + h) * 384 + 128 + ((tid >> 6) + 4 * j) * 8); \
    }                                                                                                     \
    gk = ((const float*)(projB + (size_t)(mb + (tid & 63)) * PB_W + 768))[h];                             \
    _Pragma("unroll") for (int j = 0; j < 2; ++j) {                                                       \
      const int idx = tid + 256 * j, row = idx >> 3, c8 = (idx & 7) * 8;                                  \
      ra[j] = *(const u32x4*)(projB + (size_t)(mb + row) * PB_W + 512 + h * 64 + c8);                     \
    }                                                                                                     \
    if (tid < 128) ru = *(const u32x4*)(sb + ((size_t)(mb + (tid >> 1)) * 4 + h) * 384 + 256 + col0 + (tid & 1) * 8); \
    glast = ((const float*)(projB + (size_t)(mb + 63) * PB_W + 768))[h];                                  \
  }
#define D2_STAGE1()                                                                                       \
  {                                                                                                       \
    const float ek = __expf(glast - gk);                                                                  \
    _Pragma("unroll") for (int j = 0; j < 4; ++j) {                                                       \
      const int c8 = ((tid >> 6) + 4 * j) * 8;                                                            \
      float f[8];                                                                                         \
      unpack8(rk[j], f);                                                                                  \
      _Pragma("unroll") for (int e = 0; e < 8; ++e) KT[(c8 + e) * 72 + (tid & 63)] = f2bf(f[e] * ek);     \
    }                                                                                                     \
  }
#define D2_STAGE2()                                                                                       \
  {                                                                                                       \
    _Pragma("unroll") for (int j = 0; j < 4; ++j) {                                                       \
      const int idx = tid + 256 * j, row = idx >> 4, c8 = (idx & 15) * 8;                                 \
      *(u32x4*)(Ws + row * DLD + c8) = rw[j];                                                             \
      const float eq = __expf(gj[j]);                                                                     \
      float f[8];                                                                                         \
      unpack8(rq[j], f);                                                                                  \
      _Pragma("unroll") for (int e = 0; e < 8; ++e) f[e] *= eq;                                           \
      *(u32x4*)(Qs + row * DLD + c8) = pack8(f);                                                          \
    }                                                                                                     \
    _Pragma("unroll") for (int j = 0; j < 2; ++j) {                                                       \
      const int idx = tid + 256 * j, row = idx >> 3, c8 = (idx & 7) * 8;                                  \
      *(u32x4*)(AT + row * 72 + c8) = ra[j];                                                              \
    }                                                                                                     \
    if (tid < 128) {                                                                                      \
      float f[8];                                                                                         \
      unpack8(ru, f);                                                                                     \
      float* up = Us + (tid >> 1) * 16 + (tid & 1) * 8;                                                   \
      *(f32x4*)up = f32x4{f[0], f[1], f[2], f[3]};                                                        \
      *(f32x4*)(up + 4) = f32x4{f[4], f[5], f[6], f[7]};                                                  \
    }                                                                                                     \
    glcur = glast;                                                                                        \
  }
  D2_PREFETCH(0);
  D2_STAGE1();
  D2_STAGE2();
  D2_PREFETCH(1);
  __syncthreads();
  for (int c = 0; c < 32; ++c) {
    f32x4 av = f32x4{0.f, 0.f, 0.f, 0.f}, ao = av;
#pragma unroll
    for (int ks = 0; ks < 4; ++ks) {
      const int ko = ks * 32 + q4 * 8;
      const bf16x8 bw = *(const bf16x8*)(Ws + (16 * wave + r16) * DLD + ko);
      const bf16x8 bq = *(const bf16x8*)(Qs + (16 * wave + r16) * DLD + ko);
      const bf16x8 bs = *(const bf16x8*)(ST + r16 * DLD + ko);
      av = __builtin_amdgcn_mfma_f32_16x16x32_bf16(bw, bs, av, 0, 0, 0);
      ao = __builtin_amdgcn_mfma_f32_16x16x32_bf16(bq, bs, ao, 0, 0, 0);
    }
    {
      const int tk = 16 * wave + q4 * 4;
      float vn[4];
#pragma unroll
      for (int j = 0; j < 4; ++j) vn[j] = Us[(tk + j) * 16 + r16] - av[j];
      *(uint2*)(VnT + r16 * 72 + tk) = uint2{pack2(vn[0], vn[1]), pack2(vn[2], vn[3])};
    }
    lds_barrier();
    bf16x8 bv[2];
#pragma unroll
    for (int ks = 0; ks < 2; ++ks) {
      bv[ks] = *(const bf16x8*)(VnT + r16 * 72 + ks * 32 + q4 * 8);
      const bf16x8 ba = *(const bf16x8*)(AT + (16 * wave + r16) * 72 + ks * 32 + q4 * 8);
      ao = __builtin_amdgcn_mfma_f32_16x16x32_bf16(ba, bv[ks], ao, 0, 0, 0);
    }
    {
      bfu* op = omix + (size_t)(row0 + c * 64 + 16 * wave + q4 * 4) * 1024 + 512 + h * 128 + col0 + r16;
#pragma unroll
      for (int j = 0; j < 4; ++j) op[(size_t)j * 1024] = f2bf(ao[j]);
    }
    {
      const float gl = __expf(glcur);
#pragma unroll
      for (int t = 0; t < 2; ++t) {
        accS[t] = accS[t] * gl;
#pragma unroll
        for (int ks = 0; ks < 2; ++ks) {
          const bf16x8 bk = *(const bf16x8*)(KT + (16 * (2 * wave + t) + r16) * 72 + ks * 32 + q4 * 8);
          accS[t] = __builtin_amdgcn_mfma_f32_16x16x32_bf16(bv[ks], bk, accS[t], 0, 0, 0);
        }
      }
    }
    lds_barrier();
#pragma unroll
    for (int t = 0; t < 2; ++t)
#pragma unroll
      for (int j = 0; j < 4; ++j) ST[(q4 * 4 + j) * DLD + 16 * (2 * wave + t) + r16] = f2bf(accS[t][j]);
    if (c + 1 < 32) D2_STAGE1();
    lds_barrier();
    if (c + 1 < 32) D2_STAGE2();
    if (c + 2 < 32) D2_PREFETCH(c + 2);
    lds_barrier();
  }
#undef D2_PREFETCH
#undef D2_STAGE1
#undef D2_STAGE2
  float* o = P.out + O_PB_SSM + ((size_t)(s * 4 + h) * 128) * 128 + col0;
#pragma unroll
  for (int t = 0; t < 2; ++t)
#pragma unroll
    for (int j = 0; j < 4; ++j) o[(size_t)(16 * (2 * wave + t) + r16) * 128 + q4 * 4 + j] = accS[t][j];
}

DI void ph_d1(const Params& P, int u, char* smem) { delta_d1(P, u, smem); }

DI void ph_scan(const Params& P, int u, char* smem) {
  const int k = u >> 1;
  if (k < 256) {
    if (u & 1) delta_d2(P, k >> 5, (k >> 3) & 3, k & 7, smem);
    else rwkv_unit<1>(P, k >> 5, (k >> 2) & 7, k & 3, smem);
  } else {
    const int j = k - 256;
    if (u & 1) delta_unit<4>(P, 8 + (j >> 3), (j >> 1) & 3, j & 1, smem);
    else rwkv_unit<4>(P, 8 + (j >> 3), j & 7, 0, smem);
  }
}

DI void ph_post(const Params& P, int u, char* smem) {
  const int tid = VT, lane = tid & 63, wave = tid >> 6;
  const int m0 = u * 8 + wave * 2;
  bfu* omix = (bfu*)(P.ws + OFF_OMIX);
  {
    const int h = lane >> 3, sub = lane & 7, ch = h * 64 + sub * 8;
    float gng[8], gnb[8];
    load8f(P.a_gn_g + ch, gng);
    load8f(P.a_gn_b + ch, gnb);
    u32x4 oq[2], vq[2], gq[2];
    float bon[2];
#pragma unroll
    for (int i = 0; i < 2; ++i) {
      const int m = m0 + i;
      oq[i] = *(const u32x4*)(omix + (size_t)m * 1024 + ch);
      vq[i] = *(const u32x4*)((const bfu*)(P.ws + OFF_STREAM) + (size_t)(m * 8 + h) * 384 + 192 + sub * 8);
      gq[i] = *(const u32x4*)((const bfu*)(P.ws + OFF_G) + (size_t)m * 512 + ch);
      bon[i] = ((const float*)(P.ws + OFF_BONUS))[m * 8 + h];
    }
#pragma unroll
    for (int i = 0; i < 2; ++i) {
      float o[8], v[8], g[8], r[8];
      unpack8(oq[i], o);
      unpack8(vq[i], v);
      unpack8(gq[i], g);
      float s = 0.f;
#pragma unroll
      for (int e = 0; e < 8; ++e) s += o[e];
      const float mean = sum8(s) * (1.f / 64.f);
      float q = 0.f;
#pragma unroll
      for (int e = 0; e < 8; ++e) {
        o[e] -= mean;
        q += o[e] * o[e];
      }
      const float rs = rsqrtf(sum8(q) * (1.f / 64.f) + GN_EPS);
#pragma unroll
      for (int e = 0; e < 8; ++e) r[e] = ((o[e] * rs * gng[e] + gnb[e]) + bon[i] * v[e]) * g[e];
      *(u32x4*)(omix + (size_t)(m0 + i) * 1024 + ch) = pack8(r);
    }
  }
  {
    const int h = lane >> 4, sub = lane & 15, ch = h * 128 + sub * 8;
    float ng[8];
    load8f(P.b_norm_g + sub * 8, ng);
    u32x4 oq[2], zq[2];
#pragma unroll
    for (int i = 0; i < 2; ++i) {
      const int m = m0 + i;
      oq[i] = *(const u32x4*)(omix + (size_t)m * 1024 + 512 + ch);
      zq[i] = *(const u32x4*)((const bfu*)P.out + (size_t)m * PB_W + 1536 + ch);
    }
#pragma unroll
    for (int i = 0; i < 2; ++i) {
      float o[8], z[8], r[8];
      unpack8(oq[i], o);
      unpack8(zq[i], z);
      float q = 0.f;
#pragma unroll
      for (int e = 0; e < 8; ++e) q += o[e] * o[e];
      const float rinv = rsqrtf(row16_sum(q) * (1.f / 128.f) + RMS_EPS);
#pragma unroll
      for (int e = 0; e < 8; ++e) r[e] = o[e] * rinv * ng[e] * siluf_(z[e]);
      *(u32x4*)(omix + (size_t)(m0 + i) * 1024 + 512 + ch) = pack8(r);
    }
  }
}

DI void ln_rows4(const float* src, float* dst, bfu* dstb, const float* g, const float* b, int lane) {
  f32x4 v[4][4];
#pragma unroll
  for (int r = 0; r < 4; ++r)
#pragma unroll
    for (int i = 0; i < 4; ++i) v[r][i] = *(const f32x4*)(src + (size_t)r * DM + i * 256 + lane * 4);
  f32x4 gg[4], bb[4];
#pragma unroll
  for (int i = 0; i < 4; ++i) {
    gg[i] = *(const f32x4*)(g + i * 256 + lane * 4);
    bb[i] = *(const f32x4*)(b + i * 256 + lane * 4);
  }
#pragma unroll
  for (int r = 0; r < 4; ++r) {
    float s = 0.f;
#pragma unroll
    for (int i = 0; i < 4; ++i) s += (v[r][i][0] + v[r][i][1]) + (v[r][i][2] + v[r][i][3]);
    const float mean = wave_sum(s) * (1.f / 1024.f);
    float q = 0.f;
#pragma unroll
    for (int i = 0; i < 4; ++i) {
      v[r][i] = v[r][i] - mean;
      q += (v[r][i][0] * v[r][i][0] + v[r][i][1] * v[r][i][1]) + (v[r][i][2] * v[r][i][2] + v[r][i][3] * v[r][i][3]);
    }
    const float rstd = rsqrtf(wave_sum(q) * (1.f / 1024.f) + LN_EPS);
#pragma unroll
    for (int i = 0; i < 4; ++i) {
      const f32x4 o = v[r][i] * rstd * gg[i] + bb[i];
      if (dst) *(f32x4*)(dst + (size_t)r * DM + i * 256 + lane * 4) = o;
      store_bf4(dstb + (size_t)r * DM + i * 256 + lane * 4, o);
    }
  }
}

template <int NR>
DI void ln_rowsb(const bfu* src, bfu* dst, const float* g, const float* b, int lane) {
  u32x4 q[NR][2];
#pragma unroll
  for (int r = 0; r < NR; ++r)
#pragma unroll
    for (int i = 0; i < 2; ++i) q[r][i] = *(const u32x4*)(src + (size_t)r * DM + i * 512 + lane * 8);
  float gg[2][8], bb[2][8];
#pragma unroll
  for (int i = 0; i < 2; ++i) {
    load8f(g + i * 512 + lane * 8, gg[i]);
    load8f(b + i * 512 + lane * 8, bb[i]);
  }
#pragma unroll
  for (int r = 0; r < NR; ++r) {
    float v[2][8];
    unpack8(q[r][0], v[0]);
    unpack8(q[r][1], v[1]);
    float s = 0.f;
#pragma unroll
    for (int i = 0; i < 2; ++i)
#pragma unroll
      for (int e = 0; e < 8; ++e) s += v[i][e];
    const float mean = wave_sum(s) * (1.f / 1024.f);
    float sq = 0.f;
#pragma unroll
    for (int i = 0; i < 2; ++i)
#pragma unroll
      for (int e = 0; e < 8; ++e) {
        v[i][e] -= mean;
        sq += v[i][e] * v[i][e];
      }
    const float rstd = rsqrtf(wave_sum(sq) * (1.f / 1024.f) + LN_EPS);
#pragma unroll
    for (int i = 0; i < 2; ++i) {
      float o[8];
#pragma unroll
      for (int e = 0; e < 8; ++e) o[e] = v[i][e] * rstd * gg[i][e] + bb[i][e];
      *(u32x4*)(dst + (size_t)r * DM + i * 512 + lane * 8) = pack8(o);
    }
  }
}

template <bool RESF>
DI void ln_row_slabs(const float* slabrow, const void* res, bfu* dst, const float* g, const float* b, int lane) {
  f32x4 v[4];
#pragma unroll
  for (int i = 0; i < 4; ++i) {
    const int co = i * 256 + lane * 4;
    f32x4 r;
    if constexpr (RESF) r = *(const f32x4*)((const float*)res + co);
    else {
      const uint2 q = *(const uint2*)((const bfu*)res + co);
      r = f32x4{lo_bf(q.x), hi_bf(q.x), lo_bf(q.y), hi_bf(q.y)};
    }
    const f32x4 s0 = *(const f32x4*)(slabrow + co), s1 = *(const f32x4*)(slabrow + (size_t)1024 * 1024 + co);
    const f32x4 s2 = *(const f32x4*)(slabrow + (size_t)2 * 1024 * 1024 + co), s3 = *(const f32x4*)(slabrow + (size_t)3 * 1024 * 1024 + co);
    v[i] = r * DN_ALPHA + ((s0 + s1) + (s2 + s3));
  }
  float s = 0.f;
#pragma unroll
  for (int i = 0; i < 4; ++i) s += (v[i][0] + v[i][1]) + (v[i][2] + v[i][3]);
  const float mean = wave_sum(s) * (1.f / 1024.f);
  float q = 0.f;
#pragma unroll
  for (int i = 0; i < 4; ++i) {
    v[i] = v[i] - mean;
    q += (v[i][0] * v[i][0] + v[i][1] * v[i][1]) + (v[i][2] * v[i][2] + v[i][3] * v[i][3]);
  }
  const float rstd = rsqrtf(wave_sum(q) * (1.f / 1024.f) + LN_EPS);
#pragma unroll
  for (int i = 0; i < 4; ++i) {
    const int co = i * 256 + lane * 4;
    const f32x4 gg = *(const f32x4*)(g + co), bb = *(const f32x4*)(b + co);
    store_bf4(dst + co, v[i] * rstd * gg + bb);
  }
}
#define EPRE(ws_) ((bfu*)((ws_) + OFF_GU))
#define FSLAB(ws_) ((float*)((ws_) + OFF_GU + 5632))
#define SLABS(P) ((P).out + (size_t)M_TOK * 512)

DI void ph_ln1(const Params& P, int u, char* smem) {
  const int lane = VT & 63, wave = VT >> 6;
  const int m = u * 8 + wave * 2;
  if (m >= M_P) {
    for (int r = 0; r < 2; ++r) {
      const int rs = m - M_P + r;
      ln_row_slabs<true>(SLABS(P) + (size_t)rs * DM, P.x_s + (size_t)rs * DM, (bfu*)(P.ws + OFF_X1B) + (size_t)(m + r) * DM,
                         P.ln1_g, P.ln1_b, lane);
    }
    return;
  }
  ln_rowsb<2>((const bfu*)P.out + (size_t)m * DM, (bfu*)(P.ws + OFF_X1B) + (size_t)m * DM, P.ln1_g, P.ln1_b, lane);
}

DI void ffnconv_slot(const Params& P, int slot) {
  const int tg = slot / 352, cs = slot - tg * 352;
  const int m0 = tg * 8, c = cs * 8;
  const int s = seq_of_row(m0), t0 = t_of_row(m0);
  const int T = T_of_seq(s);
  bfu* gu = (bfu*)(P.ws + OFF_GU);
  u32x4 gq[10], uq[8];
#pragma unroll
  for (int i = 0; i < 10; ++i)
    if (t0 + i - 2 >= 0) gq[i] = *(const u32x4*)(gu + (size_t)(m0 + i - 2) * 5632 + c);
#pragma unroll
  for (int i = 0; i < 8; ++i) uq[i] = *(const u32x4*)(gu + (size_t)(m0 + i) * 5632 + DFF + c);
  float w[3][8], fb[8];
#pragma unroll
  for (int j = 0; j < 3; ++j) load8f(P.f_conv_w + j * DFF + c, w[j]);
  load8f(P.f_conv_b + c, fb);
  float g0[8], g1[8], g2[8];
  if (t0 >= 2) {
    unpack8(gq[0], g0);
    unpack8(gq[1], g1);
  } else if (s >= 8) {
    load8f(P.st_fconv + ((size_t)(s - 8) * 2 + 0) * DFF + c, g0);
    load8f(P.st_fconv + ((size_t)(s - 8) * 2 + 1) * DFF + c, g1);
  } else {
#pragma unroll
    for (int e = 0; e < 8; ++e) { g0[e] = 0.f; g1[e] = 0.f; }
  }
#pragma unroll
  for (int i = 0; i < 8; ++i) {
    float up[8], hh[8];
    unpack8(gq[i + 2], g2);
    unpack8(uq[i], up);
#pragma unroll
    for (int e = 0; e < 8; ++e) {
      float a = w[0][e] * g0[e] + w[1][e] * g1[e] + w[2][e] * g2[e] + fb[e];
      hh[e] = siluf_(a) * up[e];
      g0[e] = g1[e];
      g1[e] = g2[e];
    }
    *(u32x4*)(gu + (size_t)(m0 + i) * 5632 + DFF + c) = pack8(hh);
  }
  if (t0 + 8 == T) {
    float* ostate = P.out + (s < 8 ? O_PF_CONV + (size_t)s * 2 * DFF : O_SF_CONV + (size_t)(s - 8) * 2 * DFF);
    *(f32x4*)(ostate + c) = f32x4{g0[0], g0[1], g0[2], g0[3]};
    *(f32x4*)(ostate + c + 4) = f32x4{g0[4], g0[5], g0[6], g0[7]};
    *(f32x4*)(ostate + DFF + c) = f32x4{g1[0], g1[1], g1[2], g1[3]};
    *(f32x4*)(ostate + DFF + c + 4) = f32x4{g1[4], g1[5], g1[6], g1[7]};
  }
}

DI void ph_ffnconv(const Params& P, int u, char* smem) {
  if (u >= 352) {
    ffnconv_slot(P, 2048 * 352 + (u - 352) * 256 + VT);
    return;
  }
  const int slot = u * 256 + VT;
  const int slab = slot / 352, c = (slot - slab * 352) * 8;
  const bfu* hg = FFN_HG(P);
  const bfu* hu = FFN_HU(P);
  bfu* gu = (bfu*)(P.ws + OFF_GU);
  float w0[8], w1[8], w2[8], fb[8];
  load8f(P.f_conv_w + c, w0);
  load8f(P.f_conv_w + DFF + c, w1);
  load8f(P.f_conv_w + 2 * DFF + c, w2);
  load8f(P.f_conv_b + c, fb);
  float a2[8], a1[8], c0[8], c1[8], u0[8], u1[8];
  if ((slab & 31) != 0) {
    unpack8(*(const u32x4*)(hg + ((size_t)(slab - 1) * 4 + 0) * DFF + c), a2);
    unpack8(*(const u32x4*)(hg + ((size_t)(slab - 1) * 4 + 1) * DFF + c), a1);
  } else {
#pragma unroll
    for (int e = 0; e < 8; ++e) { a2[e] = 0.f; a1[e] = 0.f; }
  }
  unpack8(*(const u32x4*)(hg + ((size_t)slab * 4 + 2) * DFF + c), c0);
  unpack8(*(const u32x4*)(hg + ((size_t)slab * 4 + 3) * DFF + c), c1);
  unpack8(*(const u32x4*)(hu + ((size_t)slab * 2 + 0) * DFF + c), u0);
  unpack8(*(const u32x4*)(hu + ((size_t)slab * 2 + 1) * DFF + c), u1);
  float h0[8], h1[8];
#pragma unroll
  for (int e = 0; e < 8; ++e) {
    h0[e] = siluf_(w0[e] * a2[e] + w1[e] * a1[e] + w2[e] * c0[e] + fb[e]) * u0[e];
    h1[e] = siluf_(w0[e] * a1[e] + w1[e] * c0[e] + w2[e] * c1[e] + fb[e]) * u1[e];
  }
  *(u32x4*)(gu + (size_t)(slab * 64) * (2 * DFF) + DFF + c) = pack8(h0);
  *(u32x4*)(gu + (size_t)(slab * 64 + 1) * (2 * DFF) + DFF + c) = pack8(h1);
}

DI void ph_ln2_ple(const Params& P, int u, char* smem) {
  const int lane = VT & 63, wave = VT >> 6;
  const int m = u * 8 + wave * 2;
  if (m >= M_P) {
    for (int r = 0; r < 2; ++r) {
      const int rs = m - M_P + r;
      ln_row_slabs<false>(SLABS(P) + (size_t)rs * DM, (const bfu*)(P.ws + OFF_X1B) + (size_t)(m + r) * DM,
                          (bfu*)(P.ws + OFF_X2B) + (size_t)(m + r) * DM, P.ln2_g, P.ln2_b, lane);
    }
    return;
  }
  ln_rowsb<2>((const bfu*)P.out + (size_t)m * DM, (bfu*)(P.ws + OFF_X2B) + (size_t)m * DM, P.ln2_g, P.ln2_b, lane);
}

DI void ph_rinv(const Params& P, int u, char* smem) {
  const int lane = VT & 63, wave = VT >> 6;
  const int m = u * 16 + wave * 4;
  const bfu* ep = EPRE(P.ws) + (size_t)m * EP_LD;
  u32x4 v[4][2];
#pragma unroll
  for (int r = 0; r < 4; ++r)
#pragma unroll
    for (int i = 0; i < 2; ++i) v[r][i] = *(const u32x4*)(ep + (size_t)r * EP_LD + i * 512 + lane * 8);
#pragma unroll
  for (int r = 0; r < 4; ++r) {
    float q = 0.f;
#pragma unroll
    for (int i = 0; i < 2; ++i) {
      float a[8];
      unpack8(v[r][i], a);
#pragma unroll
      for (int e = 0; e < 8; ++e) q += a[e] * a[e];
    }
    q = wave_sum(q);
    if (lane == 0) ((float*)(P.ws + OFF_RINV))[m + r] = rsqrtf(q * (1.f / 1024.f) + RMS_EPS);
  }
}

DI void ph_fins(const Params& P, int u, char* smem) {
  const int lane = VT & 63, wave = VT >> 6;
  const int rs = u * 4 + wave, m = M_P + rs;
  const float* sl = FSLAB(P.ws) + (size_t)rs * FSL_LD;
  const bfu* x2 = (const bfu*)(P.ws + OFF_X2B) + (size_t)m * DM;
  const bfu* ep = EPRE(P.ws) + (size_t)m * EP_LD;
  const float ri = ((const float*)(P.ws + OFF_RINV))[m];
#pragma unroll
  for (int i = 0; i < 4; ++i) {
    const int co = i * 256 + lane * 4;
    const f32x4 s0 = *(const f32x4*)(sl + co), s1 = *(const f32x4*)(sl + (size_t)1024 * FSL_LD + co);
    const f32x4 s2 = *(const f32x4*)(sl + (size_t)2 * 1024 * FSL_LD + co), s3 = *(const f32x4*)(sl + (size_t)3 * 1024 * FSL_LD + co);
    const f32x4 a = (s0 + s1) + (s2 + s3);
    const uint2 xq = *(const uint2*)(x2 + co);
    const uint2 eq = *(const uint2*)(ep + co);
    const f32x4 gv = *(const f32x4*)(P.ple_g + co);
    f32x4 o;
    o[0] = lo_bf(xq.x) + sigmoidf_(a[0]) * (lo_bf(eq.x) * ri * gv[0]);
    o[1] = hi_bf(xq.x) + sigmoidf_(a[1]) * (hi_bf(eq.x) * ri * gv[1]);
    o[2] = lo_bf(xq.y) + sigmoidf_(a[2]) * (lo_bf(eq.y) * ri * gv[2]);
    o[3] = hi_bf(xq.y) + sigmoidf_(a[3]) * (hi_bf(eq.y) * ri * gv[3]);
    *(f32x4*)(P.out + (size_t)m * DM + co) = o;
  }
}

template <int PH>
DI void run_unit(const Params& P, int u, char* smem) {
  if (PH == PH_WT) ph_wt(P, u, smem);
  else if (PH == PH_LORAIN) ph_lorain(P, u, smem);
  else if (PH == PH_LORA) ph_lora(P, u, smem);
  else if (PH == PH_PREPA) ph_prepa(P, u, smem);
  else if (PH == PH_PREPB) ph_prepb(P, u, smem);
  else if (PH == PH_D1) ph_d1(P, u, smem);
  else if (PH == PH_SCAN) ph_scan(P, u, smem);
  else if (PH == PH_POST) ph_post(P, u, smem);
  else if (PH == PH_LN1) ph_ln1(P, u, smem);
  else if (PH == PH_FFNCONV) ph_ffnconv(P, u, smem);
  else if (PH == PH_LN2_PLE) ph_ln2_ple(P, u, smem);
  else if (PH == PH_RINV) ph_rinv(P, u, smem);
  else if (PH == PH_FINS) ph_fins(P, u, smem);
}

template <int PH>
DI void run_phase(const Params& P, char* lds) {
  const int half = (int)(threadIdx.x >> 8);
  char* smem = lds + half * SMEM_BYTES;
  const int n = units_of(PH, P.wd_tiles);
  for (int u = (int)blockIdx.x * 2 + half; u < n; u += 2 * (int)gridDim.x) run_unit<PH>(P, u, smem);
}

#define XB_TMO      128
#define XB_XCNT(j)  (256  + 64 * (j))
#define XB_XSUB(j)  (1280 + 64 * (j))
#define XB_XGEN(j)  (2304 + 64 * (j))
#define XB_TOP      3328
#define XB_TOPGEN   3392
#define XCD_BAR_WORDS 3456
#define XB_SPIN_CAP (1u << 18)
#define XLAS __attribute__((address_space(3)))

__device__ __forceinline__ unsigned xb_ld(unsigned* p)              { return __hip_atomic_load(p, __ATOMIC_RELAXED, __HIP_MEMORY_SCOPE_AGENT); }
__device__ __forceinline__ unsigned xb_add(unsigned* p, unsigned v) { return __hip_atomic_fetch_add(p, v, __ATOMIC_RELAXED, __HIP_MEMORY_SCOPE_AGENT); }
__device__ __forceinline__ unsigned xb_xcc_id() { return (unsigned)__builtin_amdgcn_s_getreg((3 << 11) | 20) & 0xFu; }
#define XB_SPIN(cond, bar) do { unsigned _sp = 0; while (cond) { __builtin_amdgcn_s_sleep(1); \
    if ((++_sp & 255u) == 0u) { if (xb_ld(&(bar)[XB_TMO])) break; if (_sp > XB_SPIN_CAP) { atomicAdd(&(bar)[XB_TMO], 1u); break; } } } } while (0)

struct XcdBarrier {
    unsigned* bar; unsigned x;
    volatile XLAS unsigned* st;
};

__device__ __forceinline__ XcdBarrier xcd_barrier_post(unsigned* bar, volatile XLAS unsigned* st) {
    XcdBarrier b; b.bar = bar; b.x = xb_xcc_id(); b.st = st;
    if (threadIdx.x == 0) (void)xb_add(&bar[XB_XCNT(b.x)], 1u);
    return b;
}
__device__ __forceinline__ void xcd_barrier_complete(unsigned* bar, unsigned x, unsigned& nloc, unsigned& nx) {
    const unsigned G = gridDim.x * gridDim.y * gridDim.z;
    unsigned sum, cnt, mine, sp = 0u;
    for (;;) {
        sum = 0u; cnt = 0u; mine = 0u;
#pragma unroll
        for (unsigned j = 0; j < 16; ++j) { const unsigned c = xb_ld(&bar[XB_XCNT(j)]); sum += c; cnt += (c > 0u) ? 1u : 0u; mine = (j == x) ? c : mine; }
        if (sum == G) break;
        __builtin_amdgcn_s_sleep(1);
        if ((++sp & 255u) == 0u) { if (xb_ld(&bar[XB_TMO])) break; if (sp > XB_SPIN_CAP) { atomicAdd(&bar[XB_TMO], 1u); break; } }
    }
    nloc = mine > 0u ? mine : 1u; nx = cnt > 0u ? cnt : 1u;
}

__device__ __forceinline__ void xcd_barrier(const XcdBarrier& b) {
    asm volatile("s_waitcnt vmcnt(0)" ::: "memory");
    __syncthreads();
    if (threadIdx.x == 0) {
        unsigned* bar = b.bar;
        __builtin_amdgcn_s_waitcnt(0);
        unsigned nloc = b.st[0], nx = b.st[1];
        if (nloc == 0u) { xcd_barrier_complete(bar, b.x, nloc, nx); b.st[0] = nloc; b.st[1] = nx; }
        const unsigned old = xb_add(&bar[XB_XSUB(b.x)], 1u);
        const unsigned gen = old / nloc;
        if (old + 1u == (gen + 1u) * nloc) {
            __builtin_amdgcn_fence(__ATOMIC_RELEASE, "agent");
            asm volatile("s_waitcnt vmcnt(0)" ::: "memory");
            const unsigned og = xb_add(&bar[XB_TOP], 1u);
            const unsigned tg = og / nx;
            if (og + 1u == (tg + 1u) * nx) xb_add(&bar[XB_TOPGEN], 1u);
            else XB_SPIN(xb_ld(&bar[XB_TOPGEN]) == tg, bar);
            __builtin_amdgcn_fence(__ATOMIC_ACQUIRE, "agent");
            xb_add(&bar[XB_XGEN(b.x)], 1u);
            asm volatile("s_waitcnt vmcnt(0)" ::: "memory");
        } else {
            XB_SPIN(xb_ld(&bar[XB_XGEN(b.x)]) == gen, bar);
            __builtin_amdgcn_fence(__ATOMIC_ACQUIRE, "agent");
            asm volatile("s_waitcnt vmcnt(0)" ::: "memory");
        }
    }
    __syncthreads();
}


constexpr int DYN_LDS = 2 * SMEM_BYTES + 16;

__global__ void __launch_bounds__(512, 2) k_mega(Params P) {
  extern __shared__ __attribute__((aligned(16))) unsigned char dyn_lds[];
  cg::grid_group grid = cg::this_grid();
  PG8_LAS unsigned char* lds3 = (PG8_LAS unsigned char*)dyn_lds;
  char* lds = (char*)dyn_lds;
  char* ws = P.ws;
  volatile XLAS unsigned* xst = (volatile XLAS unsigned*)((PG8_LAS unsigned char*)dyn_lds + 2 * SMEM_BYTES);
  if (threadIdx.x == 0) { xst[0] = 0u; xst[1] = 0u; xst[2] = 0u; xst[3] = 0u; }
  __syncthreads();
  const XcdBarrier xbar = xcd_barrier_post((unsigned*)(ws + OFF_END), xst);
  run_phase<PH_WT>(P, lds);
  if (P.pad_ != 0) grid.sync();
  xcd_barrier(xbar);
  {
    EpiBf16Split E{(bfu*)(ws + OFF_PROJA), ASW, (bfu*)P.out, PB_W, ASW};
    run_pg8(lds3, (const bfu*)(ws + OFF_XB), DM, (const bfu*)(ws + WT_IN), M_TOK, 3840, DM, E);
  }
  xcd_barrier(xbar);
  run_phase<PH_LORAIN>(P, lds);
  xcd_barrier(xbar);
  run_phase<PH_LORA>(P, lds);
  xcd_barrier(xbar);
  run_phase<PH_PREPA>(P, lds);
  xcd_barrier(xbar);
  run_phase<PH_PREPB>(P, lds);
  xcd_barrier(xbar);
  run_phase<PH_D1>(P, lds);
  xcd_barrier(xbar);
  run_phase<PH_SCAN>(P, lds);
  xcd_barrier(xbar);
  run_phase<PH_POST>(P, lds);
  xcd_barrier(xbar);
  {
    EpiResO E{P.x_p, P.x_s, (bfu*)P.out};
    run_pg8(lds3, (const bfu*)(ws + OFF_OMIX), DM, (const bfu*)(ws + WT_O), M_P, DM, DM, E);
  }
  run_split(lds3, (const bfu*)(ws + OFF_OMIX), DM, (const bfu*)(ws + WT_O), DM, SLABS(P), DM);
  if (blockIdx.x >= 64) {
    const int half = (int)(threadIdx.x >> 8);
    for (int t = ((int)blockIdx.x - 64) * 2 + half; t < P.wd_tiles - WT_EARLY; t += 2 * ((int)gridDim.x - 64))
      ph_wt_impl(P, WT_EARLY + t, lds + half * SMEM_BYTES);
  }
  xcd_barrier(xbar);
  run_phase<PH_LN1>(P, lds);
  xcd_barrier(xbar);
  {
    EpiFfn E{(bfu*)(ws + OFF_GU), FFN_HG(P), FFN_HU(P), P.f_conv_w, P.f_conv_b, P.out + O_PF_CONV};
    run_pg8(lds3, (const bfu*)(ws + OFF_X1B), DM, (const bfu*)(ws + WT_UP), M_TOK, 2 * DFF, DM, E);
  }
  xcd_barrier(xbar);
  run_phase<PH_FFNCONV>(P, lds);
  xcd_barrier(xbar);
  {
    EpiResD E{(const bfu*)(ws + OFF_X1B), (bfu*)P.out};
    run_pg8(lds3, (const bfu*)(ws + OFF_GU) + DFF, 2 * DFF, (const bfu*)(ws + WT_DOWN), M_P, DM, DFF, E);
  }
  run_split(lds3, (const bfu*)(ws + OFF_GU) + DFF, 2 * DFF, (const bfu*)(ws + WT_DOWN), DFF, SLABS(P), DM);
  if (blockIdx.x >= 64) {
    EpiBf16Split E{EPRE(ws), EP_LD, EPRE(ws), EP_LD, 1 << 30};
    run_pg8_sub(lds3, (const bfu*)(ws + OFF_PB), PLE, (const bfu*)(ws + WT_PLE), M_TOK, DM, PLE, E, (int)gridDim.x - 64,
                (int)blockIdx.x - 64);
  }
  xcd_barrier(xbar);
  run_phase<PH_LN2_PLE>(P, lds);
  run_phase<PH_RINV>(P, lds);
  xcd_barrier(xbar);
  {
    EpiFin E{(const bfu*)(ws + OFF_X2B), EPRE(ws), (const float*)(ws + OFF_RINV), P.ple_g, P.out};
    run_pg8(lds3, (const bfu*)(ws + OFF_X2B), DM, (const bfu*)(ws + WT_GATE), M_P, DM, DM, E);
  }
  run_split(lds3, (const bfu*)(ws + OFF_X2B), DM, (const bfu*)(ws + WT_GATE), DM, FSLAB(ws), FSL_LD);
  xcd_barrier(xbar);
  run_phase<PH_FINS>(P, lds);
}

extern "C" void kernel_launch(void* const* d_in, const int* in_sizes, int n_in, void* d_out, int out_size,
                              void* d_ws, size_t ws_size, hipStream_t stream) {
  Params P;
  memset(&P, 0, sizeof(P));
  const float** f = (const float**)&P;
  for (int i = 0; i < 37; ++i) f[i] = (const float*)d_in[i];
  P.out = (float*)d_out;
  P.ws = (char*)d_ws;
  char* ws = (char*)d_ws;
  struct { const float* src; size_t off; int K, N, Npad; } wl[9] = {
      {P.w_in, WT_IN, 1024, INW, INW_PAD},   {P.a_w_w2, WT_W2, 64, 512, 512},   {P.a_w_a2, WT_A2, 64, 512, 512},
      {P.a_w_g2, WT_G2, 128, 512, 512},      {P.w_o, WT_O, 1024, 1024, 1024},   {P.w_up, WT_UP, 1024, 5632, 5632},
      {P.w_down, WT_DOWN, 2816, 1024, 1024}, {P.w_ple, WT_PLE, 256, 1024, 1024}, {P.w_ple_gate, WT_GATE, 1024, 1024, 1024}};
  int t0 = 0;
  for (int i = 0; i < 9; ++i) {
    P.wd[i].src = wl[i].src;
    P.wd[i].dst = (bfu*)(ws + wl[i].off);
    P.wd[i].K = wl[i].K;
    P.wd[i].N = wl[i].N;
    P.wd[i].Npad = wl[i].Npad;
    P.wd[i].t0 = t0;
    t0 += (wl[i].Npad / 64) * (wl[i].K / 64);
  }
  P.wd_tiles = t0;
  static int grid_blocks = 0;
  if (!grid_blocks) {
    int dev = 0, cus = 0, per_cu = 0;
    hipGetDevice(&dev);
    hipDeviceGetAttribute(&cus, hipDeviceAttributeMultiprocessorCount, dev);
    hipFuncSetAttribute((const void*)k_mega, hipFuncAttributeMaxDynamicSharedMemorySize, DYN_LDS);
    hipOccupancyMaxActiveBlocksPerMultiprocessor(&per_cu, (const void*)k_mega, 512, DYN_LDS);
    if (per_cu < 1) per_cu = 1;
    if (per_cu > 1) per_cu = 1;
    grid_blocks = cus * per_cu;
  }
  hipMemsetAsync((char*)d_ws + OFF_END, 0, XCD_BAR_WORDS * 4, stream);
  void* args[] = {&P};
  hipError_t e = hipLaunchCooperativeKernel((void*)k_mega, dim3(grid_blocks), dim3(512), args, DYN_LDS, stream);
  if (e != hipSuccess) fprintf(stderr, "cooperative launch failed: %s (grid %d)\n", hipGetErrorString(e), grid_blocks);
}
```

```cpp
#include <hip/hip_runtime.h>
#include <hip/hip_bf16.h>
#include <hip/hip_cooperative_groups.h>
#include <cstdio>
#include <cstring>
namespace cg = cooperative_groups;

#ifndef MULTI_LAUNCH
#define MULTI_LAUNCH 0
#endif

#define DI __device__ __forceinline__
#define VT ((int)(threadIdx.x & 255u))
typedef unsigned short bfu;
using bf16x8 = __attribute__((ext_vector_type(8))) short;
using f32x4 = __attribute__((ext_vector_type(4))) float;
using u32x4 = __attribute__((ext_vector_type(4))) unsigned;

constexpr int M_TOK = 17408, M_P = 16384, NSEQ = 136;
constexpr int DM = 1024, AW = 512, ASW = 1792, BQKV = 1536, PB_W = 2048, INW = 3848, INW_PAD = 3968;
constexpr int DFF = 2816, PLE = 256;
constexpr float DN_ALPHA = 1.189207115002721f;
constexpr float LN_EPS = 1e-5f, GN_EPS = 64e-5f, RMS_EPS = 1e-6f, L2_EPS = 1e-12f;

constexpr size_t O_Y = 0;
constexpr size_t O_PA_WKV = (size_t)M_TOK * 1024;
constexpr size_t O_PA_SHIFT = O_PA_WKV + 8 * 8 * 64 * 64;
constexpr size_t O_PB_SSM = O_PA_SHIFT + 8 * 1792;
constexpr size_t O_PB_CONV = O_PB_SSM + 8 * 4 * 128 * 128;
constexpr size_t O_PF_CONV = O_PB_CONV + 8 * 3 * 1536;
constexpr size_t O_SA_WKV = O_PF_CONV + 8 * 2 * 2816;
constexpr size_t O_SA_SHIFT = O_SA_WKV + (size_t)128 * 8 * 64 * 64;
constexpr size_t O_SB_SSM = O_SA_SHIFT + 128 * 1792;
constexpr size_t O_SB_CONV = O_SB_SSM + (size_t)128 * 4 * 128 * 128;
constexpr size_t O_SF_CONV = O_SB_CONV + 128 * 3 * 1536;

constexpr size_t WL_UP = 0;
constexpr size_t WL_DOWN = WL_UP + (size_t)5632 * 1024 * 2;
constexpr size_t WL_PLE = WL_DOWN + (size_t)1024 * 2816 * 2;
constexpr size_t WL_GATE = WL_PLE + 1024 * 256 * 2;
constexpr size_t OFF_PB = WL_GATE + 1024 * 1024 * 2;
constexpr size_t OFF_STREAM = OFF_PB + (size_t)M_TOK * 256 * 2;
constexpr size_t OFF_G = OFF_STREAM + (size_t)M_TOK * 8 * 384 * 2;
constexpr size_t OFF_PROJA = OFF_G + (size_t)M_TOK * 512 * 2;
constexpr size_t OFF_LORAIN = OFF_PROJA + (size_t)M_TOK * 1792 * 2;
constexpr size_t OFF_ABUF = OFF_LORAIN + (size_t)M_TOK * 256 * 2;
constexpr size_t OFF_BA = OFF_ABUF + (size_t)M_TOK * 512 * 2;
constexpr size_t OFF_BG = OFF_BA + (size_t)M_TOK * 8 * 4;
constexpr size_t OFF_BONUS = OFF_BG + (size_t)M_TOK * 8 * 4;
constexpr size_t WT_IN = OFF_BONUS + (size_t)M_TOK * 8 * 4;
constexpr size_t WT_W2 = WT_IN + (size_t)INW_PAD * 1024 * 2;
constexpr size_t WT_A2 = WT_W2 + 512 * 64 * 2;
constexpr size_t WT_G2 = WT_A2 + 512 * 64 * 2;
constexpr size_t WT_O = WT_G2 + 512 * 128 * 2;
constexpr size_t WT_UP = WL_UP, WT_DOWN = WL_DOWN, WT_PLE = WL_PLE, WT_GATE = WL_GATE;
constexpr size_t OFF_WEND = WT_O + 1024 * 1024 * 2;
constexpr size_t OFF_XB = OFF_STREAM;
constexpr size_t OFF_STREAMB = OFF_PROJA;
constexpr size_t OFF_OMIX = OFF_STREAMB + (size_t)M_TOK * 4 * 384 * 2;
constexpr size_t OFF_GU = OFF_STREAM;
constexpr size_t OFF_X1B = OFF_GU + (size_t)M_TOK * 5632 * 2;
constexpr size_t OFF_RINV = OFF_X1B + (size_t)M_TOK * 1024 * 2;
constexpr size_t OFF_GG = OFF_RINV + (size_t)M_TOK * 4;
constexpr size_t OFF_END = OFF_GG + (size_t)M_TOK * 4 * 4;
constexpr size_t OFF_X2 = OFF_STREAM;
constexpr size_t OFF_X2B = OFF_X1B;
constexpr int EP_LD = 2 * 2816;
constexpr int FSL_LD = 2816;
static_assert(OFF_OMIX + (size_t)M_TOK * 1024 * 2 <= OFF_BA, "omix overlap");
static_assert(OFF_X1B >= OFF_ABUF, "x1b overlaps live data");
static_assert(OFF_X1B >= OFF_OMIX + 0 || true, "");
static_assert(OFF_RINV >= OFF_WEND, "rinv overlaps weights");
static_assert(OFF_END + 3456 * 4 <= 256ull * 1024 * 1024, "ws too small");
static_assert(OFF_END % 256 == 0, "barrier word alignment");

struct WD { const float* src; bfu* dst; int K, N, Npad, t0; };

struct Params {
  const float *x_p, *x_s, *p_p, *p_s, *st_wkv, *st_shift, *st_ssm, *st_bconv, *st_fconv;
  const float *w_in, *a_mu, *a_w0, *a_w_w2, *a_a0, *a_w_a2, *a_w_g2, *a_k_k, *a_k_a, *a_r_k, *a_gn_g, *a_gn_b;
  const float *b_conv_w, *b_a_log, *b_dt_bias, *b_norm_g, *w_o, *ln1_g, *ln1_b, *w_up, *f_conv_w, *f_conv_b,
      *w_down, *ln2_g, *ln2_b, *w_ple, *ple_g, *w_ple_gate;
  float* out;
  char* ws;
  WD wd[9];
  int wd_tiles;
  int pad_;
};

typedef __bf16 bf16x2_t __attribute__((ext_vector_type(2)));
typedef float f32x2_t __attribute__((ext_vector_type(2)));
DI unsigned pack2(float a, float b) {
  const f32x2_t v = {a, b};
  const bf16x2_t r = __builtin_convertvector(v, bf16x2_t);
  return __builtin_bit_cast(unsigned, r);
}
DI bfu f2bf(float f) { return (bfu)pack2(f, f); }
DI float bf2f(bfu h) { return __uint_as_float(((unsigned)h) << 16); }
DI float lo_bf(unsigned u) { return __uint_as_float(u << 16); }
DI float hi_bf(unsigned u) { return __uint_as_float(u & 0xffff0000u); }
DI float sigmoidf_(float x) { return __builtin_amdgcn_rcpf(1.f + __builtin_amdgcn_exp2f(x * -1.4426950408889634f)); }
DI float siluf_(float x) { return x * __builtin_amdgcn_rcpf(1.f + __builtin_amdgcn_exp2f(x * -1.4426950408889634f)); }
DI float softplusf_(float x) { return fmaxf(x, 0.f) + log1pf(__expf(-fabsf(x))); }
DI float wave_sum(float v) {
#pragma unroll
  for (int o = 32; o > 0; o >>= 1) v += __shfl_xor(v, o, 64);
  return v;
}
DI float row16_sum(float x) {
  x += __int_as_float(__builtin_amdgcn_update_dpp(0, __float_as_int(x), 0x128, 0xf, 0xf, false));
  x += __int_as_float(__builtin_amdgcn_update_dpp(0, __float_as_int(x), 0x124, 0xf, 0xf, false));
  x += __int_as_float(__builtin_amdgcn_update_dpp(0, __float_as_int(x), 0x122, 0xf, 0xf, false));
  x += __int_as_float(__builtin_amdgcn_update_dpp(0, __float_as_int(x), 0x121, 0xf, 0xf, false));
  return x;
}
DI float sum8(float x) {
  x += __int_as_float(__builtin_amdgcn_update_dpp(0, __float_as_int(x), 0xB1, 0xf, 0xf, false));
  x += __int_as_float(__builtin_amdgcn_update_dpp(0, __float_as_int(x), 0x4E, 0xf, 0xf, false));
  x += __int_as_float(__builtin_amdgcn_update_dpp(0, __float_as_int(x), 0x141, 0xf, 0xf, false));
  return x;
}
DI void unpack8(u32x4 q, float (&f)[8]) {
  f[0] = lo_bf(q.x); f[1] = hi_bf(q.x); f[2] = lo_bf(q.y); f[3] = hi_bf(q.y);
  f[4] = lo_bf(q.z); f[5] = hi_bf(q.z); f[6] = lo_bf(q.w); f[7] = hi_bf(q.w);
}
DI u32x4 pack8(const float (&f)[8]) {
  u32x4 q;
  q.x = pack2(f[0], f[1]); q.y = pack2(f[2], f[3]); q.z = pack2(f[4], f[5]); q.w = pack2(f[6], f[7]);
  return q;
}
DI void load8f(const float* p, float (&f)[8]) {
  f32x4 a = *(const f32x4*)p, b = *(const f32x4*)(p + 4);
  f[0] = a[0]; f[1] = a[1]; f[2] = a[2]; f[3] = a[3]; f[4] = b[0]; f[5] = b[1]; f[6] = b[2]; f[7] = b[3];
}
DI int seq_of_row(int m) { return m < M_P ? (m >> 11) : 8 + ((m - M_P) >> 3); }
DI int t_of_row(int m) { return m < M_P ? (m & 2047) : (m & 7); }
DI int row0_of_seq(int s) { return s < 8 ? s * 2048 : M_P + (s - 8) * 8; }
DI int T_of_seq(int s) { return s < 8 ? 2048 : 8; }

constexpr int SMEM_BYTES = 81904;

constexpr int LDT = 72;
constexpr int TILE_ELEMS = 128 * LDT;
constexpr int GBK = 64;

template <bool AF32>
DI void g_load(const void* __restrict__ Ap, int lda, const bfu* __restrict__ Bp, int K, int kt, int lrow, int lkc,
               u32x4 (&ra)[4], u32x4 (&rb)[4], f32x4 (&fa)[4][2]) {
#pragma unroll
  for (int j = 0; j < 4; ++j) {
    const int row = lrow + 32 * j;
    if constexpr (AF32) {
      const float* ap = (const float*)Ap + (size_t)row * lda + kt * GBK + lkc;
      fa[j][0] = *(const f32x4*)ap;
      fa[j][1] = *(const f32x4*)(ap + 4);
    } else {
      const bfu* ap = (const bfu*)Ap + (size_t)row * lda + kt * GBK + lkc;
      ra[j] = *(const u32x4*)ap;
    }
    rb[j] = *(const u32x4*)(Bp + (size_t)row * K + kt * GBK + lkc);
  }
}
template <bool AF32>
DI void l_store(bfu* As, bfu* Bs, int lrow, int lkc, const u32x4 (&ra)[4], const u32x4 (&rb)[4],
                const f32x4 (&fa)[4][2]) {
#pragma unroll
  for (int j = 0; j < 4; ++j) {
    const int row = lrow + 32 * j;
    u32x4 va;
    if constexpr (AF32) {
      va.x = pack2(fa[j][0].x, fa[j][0].y);
      va.y = pack2(fa[j][0].z, fa[j][0].w);
      va.z = pack2(fa[j][1].x, fa[j][1].y);
      va.w = pack2(fa[j][1].z, fa[j][1].w);
    } else {
      va = ra[j];
    }
    *(u32x4*)(As + row * LDT + lkc) = va;
    *(u32x4*)(Bs + row * LDT + lkc) = rb[j];
  }
}

template <bool AF32, class Epi>
DI void gemm_tile(const void* __restrict__ Ap, int lda, const bfu* __restrict__ Bp, int K, int m0, int n0,
                  bfu* smem, Epi epi) {
  const int tid = VT, lane = tid & 63, wave = tid >> 6;
  const int wm = wave >> 1, wn = wave & 1;
  bfu* As = smem;
  bfu* Bs = smem + TILE_ELEMS;
  f32x4 acc[4][4];
#pragma unroll
  for (int i = 0; i < 4; ++i)
#pragma unroll
    for (int j = 0; j < 4; ++j) acc[i][j] = f32x4{0.f, 0.f, 0.f, 0.f};
  const int lrow = tid >> 3, lkc = (tid & 7) * 8;
  u32x4 ra[4], rb[4];
  f32x4 fa[4][2];
  const int nk = K / GBK;

  g_load<AF32>(Ap, lda, Bp, K, 0, lrow, lkc, ra, rb, fa);
  for (int kt = 0; kt < nk; ++kt) {
    __syncthreads();
    l_store<AF32>(As, Bs, lrow, lkc, ra, rb, fa);
    __syncthreads();
    if (kt + 1 < nk) g_load<AF32>(Ap, lda, Bp, K, kt + 1, lrow, lkc, ra, rb, fa);
#pragma unroll
    for (int ks = 0; ks < 2; ++ks) {
      bf16x8 af[4], bfr[4];
#pragma unroll
      for (int mi = 0; mi < 4; ++mi)
        af[mi] = *(const bf16x8*)(As + (wm * 64 + mi * 16 + (lane & 15)) * LDT + ks * 32 + (lane >> 4) * 8);
#pragma unroll
      for (int ni = 0; ni < 4; ++ni)
        bfr[ni] = *(const bf16x8*)(Bs + (wn * 64 + ni * 16 + (lane & 15)) * LDT + ks * 32 + (lane >> 4) * 8);
#pragma unroll
      for (int mi = 0; mi < 4; ++mi)
#pragma unroll
        for (int ni = 0; ni < 4; ++ni)
          acc[mi][ni] = __builtin_amdgcn_mfma_f32_16x16x32_bf16(bfr[ni], af[mi], acc[mi][ni], 0, 0, 0);
    }
  }
#pragma unroll
  for (int mi = 0; mi < 4; ++mi)
#pragma unroll
    for (int ni = 0; ni < 4; ++ni) {
      int m = m0 + wm * 64 + mi * 16 + (lane & 15);
      int n = n0 + wn * 64 + ni * 16 + (lane >> 4) * 4;
      epi(m, n, acc[mi][ni]);
    }
  __syncthreads();
}

DI void store_bf4(bfu* p, f32x4 v) {
  uint2 u;
  u.x = pack2(v[0], v[1]);
  u.y = pack2(v[2], v[3]);
  *(uint2*)p = u;
}

namespace pg8 {
#define PG8_LAS __attribute__((address_space(3)))
typedef unsigned short bf16_t;
typedef short bf16x8 __attribute__((ext_vector_type(8)));
typedef float f32x4 __attribute__((ext_vector_type(4)));
typedef unsigned u32x4 __attribute__((ext_vector_type(4)));
constexpr int BM = 256, BK = 64, HALF = 128, HTB = HALF * BK * 2  , STAGE_BYTES = 8 * HTB, NXCD = 8, WGM = 8;

__host__ __device__ __forceinline__ int lds_byte(int r, int c) { const int st = (r >> 4) * 2 + (c >> 5), rr = r & 15, cc = c & 31, ob = rr * 64 + cc * 2; return st * 1024 + (ob ^ (((ob >> 9) & 1) << 5)); }
__host__ __device__ __forceinline__ void stage_rc(int b, int& R, int& C) { const int st = b / 1024, sb = b % 1024, swz = sb ^ (((sb >> 9) & 1) << 5); R = (st >> 1) * 16 + swz / 64; C = (st & 1) * 32 + (swz % 64) / 2; }
__host__ __device__ __forceinline__ int perm32(int rho) { const int n = rho >> 4, i = rho & 15; return 8 * (i >> 2) + 4 * n + (i & 3); }

struct Unit { int pm, pn; };
struct Gemm { const bf16_t* A; const bf16_t* Bt; int M, N, K, lda, ldb; };

struct StaticOrder {
    int nM, nN, nwg, G, c;
    __host__ __device__ void init(int M, int N, int G_, int c_) { nM = M / BM; nN = N / BM; nwg = nM * nN; G = G_; c = c_; }
    __host__ __device__ bool next(int i, Unit& u) const {
        const long L = (long)i * G + c; if (L >= nwg) return false;
        int wgid = (int)L; { const int q = nwg / NXCD, r = nwg % NXCD, xcd = wgid % NXCD, off = wgid / NXCD; wgid = (xcd < r ? xcd * (q + 1) : r * (q + 1) + (xcd - r) * q) + off; }
        const int nig = WGM * nN, gid = wgid / nig, fm = gid * WGM, gsz = (nM - fm) < WGM ? (nM - fm) : WGM;
        u.pm = fm + ((wgid % nig) % gsz); u.pn = (wgid % nig) / gsz; return true;
    }
    __device__ __forceinline__ void a_ready(const Unit&) const {}
    __device__ __forceinline__ void done(const Unit&) const {}
};
__device__ __forceinline__ unsigned cvt_pk_bf16(float lo, float hi) { unsigned r; asm volatile("v_cvt_pk_bf16_f32 %0, %1, %2" : "=v"(r) : "v"(lo), "v"(hi)); return r; }
template <class Epi, class Sched, bool STAMP = false>
__device__ __forceinline__ void gemm_phase(PG8_LAS unsigned char* lds, const Gemm g, const Sched& S, const Epi& E, unsigned long long* stamps) {
    int tid_ = threadIdx.x; asm volatile("" : "+v"(tid_));
    const int tid = tid_, wid = __builtin_amdgcn_readfirstlane(tid >> 6), lane = tid & 63, wr = wid >> 2, wc = wid & 3, fr = lane & 15, fq = lane >> 4;
    const int K = g.K, nt = K / BK;
    int ts_lo = 0, ts_hi = 0, nts = 0; const unsigned long long rt_entry = STAMP ? (unsigned long long)wall_clock64() : 0ull;
#define PG8_STAMP() do { if (STAMP && wid == 0 && nts < 64) { const unsigned long long _c = (unsigned long long)clock64(); \
        ts_lo = (lane == nts) ? (int)(unsigned)_c : ts_lo; ts_hi = (lane == nts) ? (int)(unsigned)(_c >> 32) : ts_hi; ++nts; } } while (0)
    PG8_STAMP();
    unsigned voffA[2], voffB[2];
#pragma unroll
    for (int i = 0; i < 2; ++i) { int R, C; stage_rc(tid * 16 + i * 8192, R, C); const int Rb = Epi::PERM ? ((R & ~31) + perm32(R & 31)) : R;
        voffA[i] = (unsigned)(R * g.lda + C) * 2u; voffB[i] = (unsigned)(Rb * g.ldb + C) * 2u; }
    const size_t kstep = (size_t)(BK * 2);
    const size_t hstep = (size_t)HALF * g.ldb * 2; const size_t hstepA = (size_t)HALF * g.lda * 2;
    const size_t tstep = 2 * hstep; const size_t tstepA = 2 * hstepA;
    const unsigned ldsw = (unsigned)wid * 1024u;
    const int aoff = lds_byte(wr * 64 + fr, fq * 8), boff = lds_byte(wc * 32 + fr, fq * 8);
#define PG8_SA(b, h) (((b) * 2 + (h)) * HTB)
#define PG8_SB(b, h) ((4 + (b) * 2 + (h)) * HTB)
#define PG8_STAGE(bufoff, gbase, voff) do { _Pragma("unroll") for (int _i = 0; _i < 2; ++_i) \
        __builtin_amdgcn_global_load_lds((const unsigned*)((const char*)(gbase) + (voff)[_i]), (PG8_LAS unsigned*)(lds + (bufoff) + ldsw + _i * 8192), 16, 0, 0); } while (0)
#define PG8_LDA(dst, b, h) do { _Pragma("unroll") for (int m = 0; m < 4; ++m) _Pragma("unroll") for (int k = 0; k < 2; ++k) dst[m][k] = *(const PG8_LAS bf16x8*)(lds + PG8_SA(b, h) + aoff + m * 2048 + k * 1024); } while (0)
#define PG8_LDB(dst, b, h) do { _Pragma("unroll") for (int n = 0; n < 2; ++n) _Pragma("unroll") for (int k = 0; k < 2; ++k) dst[n][k] = *(const PG8_LAS bf16x8*)(lds + PG8_SB(b, h) + boff + n * 2048 + k * 1024); } while (0)
#define PG8_MMA(ai, bj, At, Bt) do { __builtin_amdgcn_s_setprio(1); _Pragma("unroll") for (int m = 0; m < 4; ++m) _Pragma("unroll") for (int n = 0; n < 2; ++n) _Pragma("unroll") for (int k = 0; k < 2; ++k) \
        acc[ai][bj][m][n] = __builtin_amdgcn_mfma_f32_16x16x32_bf16(Bt[n][k], At[m][k], acc[ai][bj][m][n], 0, 0, 0); __builtin_amdgcn_s_setprio(0); } while (0)
#define PG8_WAIT_V(n) asm volatile("s_waitcnt vmcnt(" #n ")" ::: "memory")
#define PG8_WAIT_L(n) asm volatile("s_waitcnt lgkmcnt(" #n ")" ::: "memory")
#define PG8_BAR __builtin_amdgcn_s_barrier()
#define PG8_SCHED __builtin_amdgcn_sched_barrier(0)
    Unit cur, nxt; int ui = 0;
    if (!S.next(0, cur)) return;
    f32x4 acc[2][2][4][2];
#pragma unroll
    for (int a = 0; a < 2; ++a)
#pragma unroll
        for (int b = 0; b < 2; ++b)
#pragma unroll
            for (int m = 0; m < 4; ++m)
#pragma unroll
                for (int n = 0; n < 2; ++n) acc[a][b][m][n] = (f32x4){0.f, 0.f, 0.f, 0.f};
    bf16x8 At[4][2], B0[2][2], B1[2][2];
    const char* cA = (const char*)g.A + (size_t)cur.pm * tstepA; const char* cB = (const char*)g.Bt + (size_t)cur.pn * tstep;
    S.a_ready(cur);
    PG8_STAGE(PG8_SB(0, 0), cB, voffB); PG8_STAGE(PG8_SA(0, 0), cA, voffA); PG8_STAGE(PG8_SB(0, 1), cB + hstep, voffB); PG8_STAGE(PG8_SA(0, 1), cA + hstepA, voffA);
    if (wr == 1) PG8_BAR;
    PG8_WAIT_V(4); PG8_BAR;
    PG8_STAGE(PG8_SB(1, 0), cB + kstep, voffB); PG8_STAGE(PG8_SA(1, 0), cA + kstep, voffA); PG8_STAGE(PG8_SB(1, 1), cB + hstep + kstep, voffB);
    PG8_WAIT_V(6); PG8_BAR;
    PG8_STAMP();
    for (;;) {
        const bool has_next = S.next(ui + 1, nxt);
        const char* nA = has_next ? (const char*)g.A + (size_t)nxt.pm * tstepA : cA; const char* nB = has_next ? (const char*)g.Bt + (size_t)nxt.pn * tstep : cB;
        for (int t = 0; t < nt; t += 2) {
            const bool last = (t == nt - 2);
            const char* a1 = cA + (size_t)(t + 1) * kstep;
            const char* a2 = last ? nA : cA + (size_t)(t + 2) * kstep; const char* b2 = last ? nB : cB + (size_t)(t + 2) * kstep;
            const char* a3 = a2 + kstep; const char* b3 = b2 + kstep;
            if (last && has_next) S.a_ready(nxt);
            PG8_LDB(B0, 0, 0); PG8_SCHED; PG8_LDA(At, 0, 0); PG8_STAGE(PG8_SA(1, 1), a1 + hstepA, voffA);
            PG8_WAIT_L(8); PG8_BAR; PG8_WAIT_L(0); PG8_MMA(0, 0, At, B0); PG8_BAR; PG8_SCHED;
            PG8_LDB(B1, 0, 1); PG8_STAGE(PG8_SB(0, 0), b2, voffB);
            PG8_BAR; PG8_WAIT_L(0); PG8_MMA(0, 1, At, B1); PG8_BAR;
            PG8_LDA(At, 0, 1); PG8_STAGE(PG8_SA(0, 0), a2, voffA);
            PG8_BAR; PG8_WAIT_L(0); PG8_MMA(1, 0, At, B0); PG8_BAR; PG8_SCHED;
            PG8_STAGE(PG8_SB(0, 1), b2 + hstep, voffB);
            PG8_WAIT_V(6); PG8_BAR; PG8_MMA(1, 1, At, B1); PG8_BAR;
            PG8_LDB(B0, 1, 0); PG8_SCHED; PG8_LDA(At, 1, 0); PG8_STAGE(PG8_SA(0, 1), a2 + hstepA, voffA);
            PG8_WAIT_L(8); PG8_BAR; PG8_WAIT_L(0); PG8_MMA(0, 0, At, B0); PG8_BAR; PG8_SCHED;
            PG8_LDB(B1, 1, 1); PG8_STAGE(PG8_SB(1, 0), b3, voffB);
            PG8_BAR; PG8_WAIT_L(0); PG8_MMA(0, 1, At, B1); PG8_BAR;
            PG8_LDA(At, 1, 1); PG8_STAGE(PG8_SA(1, 0), a3, voffA);
            PG8_BAR; PG8_WAIT_L(0); PG8_MMA(1, 0, At, B0); PG8_BAR; PG8_SCHED;
            PG8_STAGE(PG8_SB(1, 1), b3 + hstep, voffB);
            PG8_WAIT_V(6); PG8_BAR; PG8_MMA(1, 1, At, B1); PG8_BAR;
        }
        PG8_STAMP();
        if constexpr (!Epi::AFTER_DRAIN) { E(acc, cur, wr, wc, fr, fq); S.done(cur); }
        PG8_STAMP();
        if (!has_next) break;
#pragma unroll
        for (int a = 0; a < 2; ++a)
#pragma unroll
            for (int b = 0; b < 2; ++b)
#pragma unroll
                for (int m = 0; m < 4; ++m)
#pragma unroll
                    for (int n = 0; n < 2; ++n) acc[a][b][m][n] = (f32x4){0.f, 0.f, 0.f, 0.f};
        cur = nxt; cA = nA; cB = nB; ++ui;
    }
    PG8_WAIT_V(0);
    if (wr == 0) PG8_BAR;
    PG8_BAR;
    if constexpr (Epi::AFTER_DRAIN) { E.fused(acc, cur, wr, wc, fr, fq, lds, wid, lane); S.done(cur); }
    PG8_STAMP();
    if (STAMP && wid == 0) { stamps[lane] = lane < nts ? (((unsigned long long)(unsigned)ts_hi << 32) | (unsigned)ts_lo) : 0ull;
        if (lane == 62) stamps[62] = rt_entry; if (lane == 63) stamps[63] = (unsigned long long)wall_clock64(); }
#undef PG8_STAMP
#undef PG8_SA
#undef PG8_SB
#undef PG8_STAGE
#undef PG8_LDA
#undef PG8_LDB
#undef PG8_MMA
#undef PG8_WAIT_V
#undef PG8_WAIT_L
#undef PG8_BAR
#undef PG8_SCHED
}
}

struct EpiBf16Split {
  static constexpr bool PERM = true, AFTER_DRAIN = false;
  bfu* O1; int ld1; bfu* O2; int ld2; int split;
  DI void operator()(const f32x4 (&acc)[2][2][4][2], const pg8::Unit& u, int wr, int wc, int fr, int fq) const {
    const int row0 = u.pm * 256 + wr * 64 + fr;
    int colt = u.pn * 256; bfu* base = O1; int ld = ld1;
    if (colt >= split) { base = O2; ld = ld2; colt -= split; }
    const int col0 = colt + wc * 32 + 8 * fq;
#pragma unroll
    for (int ai = 0; ai < 2; ++ai)
#pragma unroll
      for (int m = 0; m < 4; ++m) {
        bfu* rowp = base + (size_t)(row0 + ai * 128 + m * 16) * ld + col0;
#pragma unroll
        for (int bj = 0; bj < 2; ++bj) {
          const f32x4 v0 = acc[ai][bj][m][0], v1 = acc[ai][bj][m][1];
          u32x4 o;
          o.x = pack2(v0[0], v0[1]); o.y = pack2(v0[2], v0[3]); o.z = pack2(v1[0], v1[1]); o.w = pack2(v1[2], v1[3]);
          *(u32x4*)(rowp + bj * 128) = o;
        }
      }
  }
};
struct EpiRes {
  static constexpr bool PERM = false, AFTER_DRAIN = false;
  const float* Xp; const float* Xs; float* Y;
  DI void operator()(const f32x4 (&acc)[2][2][4][2], const pg8::Unit& u, int wr, int wc, int fr, int fq) const {
    const int row0 = u.pm * 256 + wr * 64 + fr, col0 = u.pn * 256 + wc * 32 + 4 * fq;
    const float* xb = (u.pm * 256 < M_P) ? Xp : Xs - (size_t)M_P * DM;
#pragma unroll
    for (int ai = 0; ai < 2; ++ai)
#pragma unroll
      for (int m = 0; m < 4; ++m) {
        const size_t ro = (size_t)(row0 + ai * 128 + m * 16) * DM + col0;
#pragma unroll
        for (int bj = 0; bj < 2; ++bj)
#pragma unroll
          for (int n = 0; n < 2; ++n) {
            const f32x4 xv = *(const f32x4*)(xb + ro + bj * 128 + n * 16);
            *(f32x4*)(Y + ro + bj * 128 + n * 16) = xv * DN_ALPHA + acc[ai][bj][m][n];
          }
      }
  }
};
struct EpiResB {
  static constexpr bool PERM = false, AFTER_DRAIN = false;
  const bfu* Xb; float* Y;
  DI void operator()(const f32x4 (&acc)[2][2][4][2], const pg8::Unit& u, int wr, int wc, int fr, int fq) const {
    const int row0 = u.pm * 256 + wr * 64 + fr, col0 = u.pn * 256 + wc * 32 + 4 * fq;
#pragma unroll
    for (int ai = 0; ai < 2; ++ai)
#pragma unroll
      for (int m = 0; m < 4; ++m) {
        const size_t ro = (size_t)(row0 + ai * 128 + m * 16) * DM + col0;
#pragma unroll
        for (int bj = 0; bj < 2; ++bj)
#pragma unroll
          for (int n = 0; n < 2; ++n) {
            const uint2 xq = *(const uint2*)(Xb + ro + bj * 128 + n * 16);
            const f32x4 xv = f32x4{lo_bf(xq.x), hi_bf(xq.x), lo_bf(xq.y), hi_bf(xq.y)};
            *(f32x4*)(Y + ro + bj * 128 + n * 16) = xv * DN_ALPHA + acc[ai][bj][m][n];
          }
      }
  }
};
struct EpiResO {
  static constexpr bool PERM = true, AFTER_DRAIN = false;
  const float* Xp; const float* Xs; bfu* Y;
  DI void operator()(const f32x4 (&acc)[2][2][4][2], const pg8::Unit& u, int wr, int wc, int fr, int fq) const {
    const int row0 = u.pm * 256 + wr * 64 + fr, col0 = u.pn * 256 + wc * 32 + 8 * fq;
    const float* xb = (u.pm * 256 < M_P) ? Xp : Xs - (size_t)M_P * DM;
#pragma unroll
    for (int ai = 0; ai < 2; ++ai)
#pragma unroll
      for (int m = 0; m < 4; ++m) {
        const size_t ro = (size_t)(row0 + ai * 128 + m * 16) * DM + col0;
#pragma unroll
        for (int bj = 0; bj < 2; ++bj) {
          const f32x4 x0 = *(const f32x4*)(xb + ro + bj * 128), x1 = *(const f32x4*)(xb + ro + bj * 128 + 4);
          const f32x4 v0 = x0 * DN_ALPHA + acc[ai][bj][m][0], v1 = x1 * DN_ALPHA + acc[ai][bj][m][1];
          u32x4 o;
          o.x = pack2(v0[0], v0[1]); o.y = pack2(v0[2], v0[3]); o.z = pack2(v1[0], v1[1]); o.w = pack2(v1[2], v1[3]);
          *(u32x4*)(Y + ro + bj * 128) = o;
        }
      }
  }
};
struct EpiResD {
  static constexpr bool PERM = true, AFTER_DRAIN = false;
  const bfu* Xb; bfu* Y;
  DI void operator()(const f32x4 (&acc)[2][2][4][2], const pg8::Unit& u, int wr, int wc, int fr, int fq) const {
    const int row0 = u.pm * 256 + wr * 64 + fr, col0 = u.pn * 256 + wc * 32 + 8 * fq;
#pragma unroll
    for (int ai = 0; ai < 2; ++ai)
#pragma unroll
      for (int m = 0; m < 4; ++m) {
        const size_t ro = (size_t)(row0 + ai * 128 + m * 16) * DM + col0;
#pragma unroll
        for (int bj = 0; bj < 2; ++bj) {
          const u32x4 xq = *(const u32x4*)(Xb + ro + bj * 128);
          const f32x4 a0 = acc[ai][bj][m][0], a1 = acc[ai][bj][m][1];
          u32x4 o;
          o.x = pack2(lo_bf(xq.x) * DN_ALPHA + a0[0], hi_bf(xq.x) * DN_ALPHA + a0[1]);
          o.y = pack2(lo_bf(xq.y) * DN_ALPHA + a0[2], hi_bf(xq.y) * DN_ALPHA + a0[3]);
          o.z = pack2(lo_bf(xq.z) * DN_ALPHA + a1[0], hi_bf(xq.z) * DN_ALPHA + a1[1]);
          o.w = pack2(lo_bf(xq.w) * DN_ALPHA + a1[2], hi_bf(xq.w) * DN_ALPHA + a1[3]);
          *(u32x4*)(Y + ro + bj * 128) = o;
        }
      }
  }
};
#define FFN_HG(P) ((bfu*)((P).out + (size_t)M_TOK * 512))
#define FFN_HU(P) (FFN_HG(P) + (size_t)272 * 4 * DFF)
struct EpiFfn {
  static constexpr bool PERM = true, AFTER_DRAIN = false;
  bfu* gu; bfu* hg; bfu* hu; const float* cw; const float* cb; float* ostate;
  DI void operator()(const f32x4 (&acc)[2][2][4][2], const pg8::Unit& u, int wr, int wc, int fr, int fq) const {
    const int lane = (int)(threadIdx.x & 63u);
    const int cgl = u.pn * 128 + wc * 32 + 8 * fq;
    const int rowb = u.pm * 256 + wr * 64 + fr;
    if (u.pm >= 64) {
#pragma unroll
      for (int ai = 0; ai < 2; ++ai)
#pragma unroll
        for (int m = 0; m < 4; ++m) {
          bfu* rp = gu + (size_t)(rowb + ai * 128 + m * 16) * (2 * DFF) + cgl;
#pragma unroll
          for (int bj = 0; bj < 2; ++bj) {
            const f32x4 v0 = acc[ai][bj][m][0], v1 = acc[ai][bj][m][1];
            u32x4 o;
            o.x = pack2(v0[0], v0[1]); o.y = pack2(v0[2], v0[3]); o.z = pack2(v1[0], v1[1]); o.w = pack2(v1[2], v1[3]);
            *(u32x4*)(rp + bj * DFF) = o;
          }
        }
      return;
    }
#pragma unroll
    for (int n = 0; n < 2; ++n) {
      const int cc = cgl + 4 * n;
      const f32x4 w0 = *(const f32x4*)(cw + cc), w1 = *(const f32x4*)(cw + DFF + cc), w2 = *(const f32x4*)(cw + 2 * DFF + cc);
      const f32x4 fb = *(const f32x4*)(cb + cc);
#pragma unroll
      for (int ai = 0; ai < 2; ++ai) {
        unsigned gpx = 0u, gpy = 0u;
#pragma unroll
        for (int m = 0; m < 4; ++m) {
          const int r = rowb + ai * 128 + m * 16;
          const int slab = u.pm * 4 + ai * 2 + wr;
          const f32x4 g = acc[ai][0][m][n];
          const unsigned gx = pack2(g[0], g[1]), gy = pack2(g[2], g[3]);
          const unsigned s1x = fr == 15 ? gpx : gx, s1y = fr == 15 ? gpy : gy;
          const unsigned s2x = fr >= 14 ? gpx : gx, s2y = fr >= 14 ? gpy : gy;
          const unsigned p1x = (unsigned)__builtin_amdgcn_update_dpp(0, (int)s1x, 0x121, 0xf, 0xf, false);
          const unsigned p1y = (unsigned)__builtin_amdgcn_update_dpp(0, (int)s1y, 0x121, 0xf, 0xf, false);
          const unsigned p2x = (unsigned)__builtin_amdgcn_update_dpp(0, (int)s2x, 0x122, 0xf, 0xf, false);
          const unsigned p2y = (unsigned)__builtin_amdgcn_update_dpp(0, (int)s2y, 0x122, 0xf, 0xf, false);
          const f32x4 gc = f32x4{lo_bf(gx), hi_bf(gx), lo_bf(gy), hi_bf(gy)};
          const f32x4 g1 = f32x4{lo_bf(p1x), hi_bf(p1x), lo_bf(p1y), hi_bf(p1y)};
          const f32x4 g2 = f32x4{lo_bf(p2x), hi_bf(p2x), lo_bf(p2y), hi_bf(p2y)};
          const f32x4 up = acc[ai][1][m][n];
          const f32x4 a = w0 * g2 + w1 * g1 + w2 * gc + fb;
          f32x4 hh;
#pragma unroll
          for (int e = 0; e < 4; ++e) hh[e] = siluf_(a[e]) * up[e];
          if (m > 0 || fr >= 2) store_bf4(gu + (size_t)r * (2 * DFF) + DFF + cc, hh);
          if (m == 3 && fr >= 14) {
            *(uint2*)(hg + ((size_t)slab * 4 + (fr - 14)) * DFF + cc) = uint2{gx, gy};
            if ((u.pm & 7) == 7 && ai == 1 && wr == 1)
              *(f32x4*)(ostate + (size_t)(u.pm >> 3) * 2 * DFF + (size_t)(fr - 14) * DFF + cc) = gc;
          }
          if (m == 0 && fr < 2) {
            *(uint2*)(hg + ((size_t)slab * 4 + 2 + fr) * DFF + cc) = uint2{gx, gy};
            store_bf4(hu + ((size_t)slab * 2 + fr) * DFF + cc, up);
          }
          gpx = gx;
          gpy = gy;
        }
      }
    }
  }
};
struct EpiFin {
  static constexpr bool PERM = false, AFTER_DRAIN = false;
  const bfu* x2; const bfu* ep; const float* rinv; const float* pg; float* y;
  DI void operator()(const f32x4 (&acc)[2][2][4][2], const pg8::Unit& u, int wr, int wc, int fr, int fq) const {
    const int row0 = u.pm * 256 + wr * 64 + fr, col0 = u.pn * 256 + wc * 32 + 4 * fq;
#pragma unroll
    for (int ai = 0; ai < 2; ++ai)
#pragma unroll
      for (int m = 0; m < 4; ++m) {
        const int r = row0 + ai * 128 + m * 16;
        const size_t ro = (size_t)r * DM + col0;
        const float ri = rinv[r];
#pragma unroll
        for (int bj = 0; bj < 2; ++bj)
#pragma unroll
          for (int n = 0; n < 2; ++n) {
            const int co = bj * 128 + n * 16;
            const uint2 xq = *(const uint2*)(x2 + ro + co);
            const f32x4 xv = f32x4{lo_bf(xq.x), hi_bf(xq.x), lo_bf(xq.y), hi_bf(xq.y)};
            const uint2 eq = *(const uint2*)(ep + (size_t)r * EP_LD + col0 + co);
            const f32x4 gv = *(const f32x4*)(pg + col0 + co);
            const f32x4 a = acc[ai][bj][m][n];
            f32x4 o;
            o[0] = xv[0] + sigmoidf_(a[0]) * (lo_bf(eq.x) * ri * gv[0]);
            o[1] = xv[1] + sigmoidf_(a[1]) * (hi_bf(eq.x) * ri * gv[1]);
            o[2] = xv[2] + sigmoidf_(a[2]) * (lo_bf(eq.y) * ri * gv[2]);
            o[3] = xv[3] + sigmoidf_(a[3]) * (hi_bf(eq.y) * ri * gv[3]);
            *(f32x4*)(y + ro + co) = o;
          }
      }
  }
};
struct SplitOrder {
  int c;
  DI bool next(int i, pg8::Unit& u) const {
    if (i > 0 || c >= 64) return false;
    u.pm = 64 + (c >> 4); u.pn = (c >> 2) & 3;
    return true;
  }
  DI void a_ready(const pg8::Unit&) const {}
  DI void done(const pg8::Unit&) const {}
};
struct EpiSlab {
  static constexpr bool PERM = false, AFTER_DRAIN = false;
  float* slab; int ld;
  DI void operator()(const f32x4 (&acc)[2][2][4][2], const pg8::Unit& u, int wr, int wc, int fr, int fq) const {
    const int row0 = (u.pm - 64) * 256 + wr * 64 + fr, col0 = u.pn * 256 + wc * 32 + 4 * fq;
#pragma unroll
    for (int ai = 0; ai < 2; ++ai)
#pragma unroll
      for (int m = 0; m < 4; ++m) {
        float* rp = slab + (size_t)(row0 + ai * 128 + m * 16) * ld + col0;
#pragma unroll
        for (int bj = 0; bj < 2; ++bj)
#pragma unroll
          for (int n = 0; n < 2; ++n) *(f32x4*)(rp + bj * 128 + n * 16) = acc[ai][bj][m][n];
      }
  }
};
DI void run_split(PG8_LAS unsigned char* lds, const bfu* A, int lda, const bfu* Bt, int K, float* slabs, int sld) {
  const int c = (int)blockIdx.x;
  if (c >= 64) return;
  const int kp = c & 3;
  int koff, kl;
  if (K == 1024) { koff = kp * 256; kl = 256; }
  else { koff = kp < 2 ? kp * 768 : 1536 + (kp - 2) * 640; kl = kp < 2 ? 768 : 640; }
  pg8::Gemm g{A + koff, Bt + koff, M_TOK, DM, kl, lda, K};
  SplitOrder S{c};
  EpiSlab E{slabs + (size_t)kp * 1024 * sld, sld};
  pg8::gemm_phase<EpiSlab, SplitOrder, false>(lds, g, S, E, nullptr);
}

template <class Epi>
DI void run_pg8_sub(PG8_LAS unsigned char* lds, const bfu* A, int lda, const bfu* Bt, int M, int N, int K, const Epi& E, int G, int c) {
  pg8::Gemm g{A, Bt, M, N, K, lda, K};
  pg8::StaticOrder S;
  S.init(M, N, G, c);
  pg8::gemm_phase<Epi, pg8::StaticOrder, false>(lds, g, S, E, nullptr);
}
template <class Epi>
DI void run_pg8(PG8_LAS unsigned char* lds, const bfu* A, int lda, const bfu* Bt, int M, int N, int K, const Epi& E) {
  pg8::Gemm g{A, Bt, M, N, K, lda, K};
  pg8::StaticOrder S;
  S.init(M, N, (int)gridDim.x, (int)blockIdx.x);
  pg8::gemm_phase<Epi, pg8::StaticOrder, false>(lds, g, S, E, nullptr);
}

enum {
  PH_WT = 0,
  PH_GEMM_IN,
  PH_LORAIN,
  PH_LORA,
  PH_PREPA,
  PH_PREPB,
  PH_D1,
  PH_SCAN,
  PH_POST,
  PH_GEMM_O,
  PH_LN1,
  PH_GEMM_UP,
  PH_FFNCONV,
  PH_GEMM_DOWN,
  PH_LN2_PLE,
  PH_RINV,
  PH_GEMM_FIN,
  PH_FINS,
  PH_COUNT
};

constexpr int MT = M_TOK / 128;

__host__ __device__ constexpr int units_of(int ph, int wd_tiles) {
  return ph == PH_WT ? 1280 + M_TOK / 4
       : ph == PH_LORAIN ? (M_TOK / 64 + M_TOK / 16 + NSEQ)
       : ph == PH_LORA ? MT * 4 * 3
       : ph == PH_PREPA ? M_TOK / 16
       : ph == PH_PREPB ? (M_TOK / 8) * 3 / 4
       : ph == PH_D1 ? 1024
       : ph == PH_SCAN ? 2 * (256 + 1024)
       : ph == PH_POST ? M_TOK / 8
       : ph == PH_LN1 ? M_TOK / 8
       : ph == PH_FFNCONV ? (352 + 176)
       : ph == PH_LN2_PLE ? M_TOK / 8
       : ph == PH_RINV ? M_TOK / 16
       : ph == PH_FINS ? 256
       : 0;
}

constexpr int WT_EARLY = 1280;
DI void ph_wt_impl(const Params& P, int u, char* smem) {
  if (u >= P.wd_tiles) {
    const int lane = VT & 63, wave = VT >> 6;
    const int m = (u - P.wd_tiles) * 4 + wave;
    const float* xr = (m < M_P) ? P.x_p + (size_t)m * DM : P.x_s + (size_t)(m - M_P) * DM;
    f32x4 v[4];
#pragma unroll
    for (int i = 0; i < 4; ++i) v[i] = *(const f32x4*)(xr + i * 256 + lane * 4);
    bfu* xb = (bfu*)(P.ws + OFF_XB) + (size_t)m * DM;
#pragma unroll
    for (int i = 0; i < 4; ++i) store_bf4(xb + i * 256 + lane * 4, v[i]);
    return;
  }
  int wi = 0;
#pragma unroll
  for (int i = 1; i < 9; ++i)
    if (u >= P.wd[i].t0) wi = i;
  const float* src = P.wd[wi].src;
  bfu* dst = P.wd[wi].dst;
  const int K = P.wd[wi].K, N = P.wd[wi].N;
  int tl = u - P.wd[wi].t0;
  const int kts = K >> 6;
  const int nt = tl / kts, kt = tl - nt * kts;
  const int n0 = nt * 64, k0 = kt * 64;
  int drow0 = n0;
  if (wi == 5) {
    const int nn = n0 < DFF ? n0 : n0 - DFF;
    drow0 = (nn >> 7) * 256 + (n0 < DFF ? 0 : 128) + (nn & 127);
  }
  float* tile = (float*)smem;
  const int tid = VT;
#pragma unroll
  for (int i = 0; i < 4; ++i) {
    const int kr = (tid >> 4) + 16 * i, c4 = (tid & 15) * 4;
    f32x4 v = f32x4{0.f, 0.f, 0.f, 0.f};
    if (n0 + c4 + 3 < N) v = *(const f32x4*)(src + (size_t)(k0 + kr) * N + n0 + c4);
    tile[kr * 65 + c4 + 0] = v[0];
    tile[kr * 65 + c4 + 1] = v[1];
    tile[kr * 65 + c4 + 2] = v[2];
    tile[kr * 65 + c4 + 3] = v[3];
  }
  __syncthreads();
#pragma unroll
  for (int j = 0; j < 2; ++j) {
    const int nr = (tid >> 3) + 32 * j, kc = (tid & 7) * 8;
    float f[8];
#pragma unroll
    for (int e = 0; e < 8; ++e) f[e] = tile[(kc + e) * 65 + nr];
    *(u32x4*)(dst + (size_t)(drow0 + nr) * K + k0 + kc) = pack8(f);
  }
  __syncthreads();
}

DI void ph_pconv(const Params& P, int u) {
  const int lane = VT & 63, wave = VT >> 6;
  const int m0 = u * 16 + wave * 4;
  f32x4 pv[4];
#pragma unroll
  for (int r = 0; r < 4; ++r) {
    const int m = m0 + r;
    const float* pr = (m < M_P) ? P.p_p + (size_t)m * PLE : P.p_s + (size_t)(m - M_P) * PLE;
    pv[r] = *(const f32x4*)(pr + lane * 4);
  }
#pragma unroll
  for (int r = 0; r < 4; ++r) store_bf4((bfu*)(P.ws + OFF_PB) + (size_t)(m0 + r) * PLE + lane * 4, pv[r]);
}
DI void ph_wt(const Params& P, int u, char* smem) {
  ph_wt_impl(P, u < WT_EARLY ? u : u + (P.wd_tiles - WT_EARLY), smem);
}

DI void ph_lorain(const Params& P, int u, char* smem) {
  const bfu* projA = (const bfu*)(P.ws + OFF_PROJA);
  const int tid = VT;
  if (u < M_TOK / 64) {
    const int lane = tid & 63, wave = tid >> 6;
    const int r0 = (u * 4 + wave) * 16;
    const bfu* ap = (const bfu*)(P.ws + OFF_XB) + (size_t)(r0 + (lane & 15)) * DM + (lane >> 4) * 8;
    const bfu* bp = (const bfu*)(P.ws + WT_IN) + (size_t)(3840 + (lane & 15)) * DM + (lane >> 4) * 8;
    f32x4 acc = f32x4{0.f, 0.f, 0.f, 0.f};
#pragma unroll 8
    for (int ks = 0; ks < 32; ++ks) {
      const bf16x8 af = *(const bf16x8*)(ap + ks * 32);
      const bf16x8 bf = *(const bf16x8*)(bp + ks * 32);
      acc = __builtin_amdgcn_mfma_f32_16x16x32_bf16(af, bf, acc, 0, 0, 0);
    }
    if ((lane & 15) < 8) {
      float* ba = (float*)(P.ws + OFF_BA);
#pragma unroll
      for (int j = 0; j < 4; ++j) ba[(size_t)(r0 + (lane >> 4) * 4 + j) * 8 + (lane & 15)] = acc[j];
    }
    return;
  }
  u -= M_TOK / 64;
  if (u < M_TOK / 16) {
    bfu* lin = (bfu*)(P.ws + OFF_LORAIN);
    const int lane = tid & 63, wave = tid >> 6;
    const int cg = lane & 31, sub = lane >> 5;
    const int mb = u * 16 + wave * 4 + sub * 2;
    const int col = 1536 + cg * 8;
    float mu[8];
    load8f(P.a_mu + col, mu);
    const int t0 = t_of_row(mb);
    u32x4 rows[3];
    if (t0 != 0) rows[0] = *(const u32x4*)(projA + (size_t)(mb - 1) * ASW + col);
#pragma unroll
    for (int i = 0; i < 2; ++i) rows[i + 1] = *(const u32x4*)(projA + (size_t)(mb + i) * ASW + col);
    float prev[8];
    if (t0 != 0) unpack8(rows[0], prev);
    else {
      const int s = seq_of_row(mb);
      if (s < 8) {
#pragma unroll
        for (int e = 0; e < 8; ++e) prev[e] = 0.f;
      } else load8f(P.st_shift + (size_t)(s - 8) * ASW + col, prev);
    }
#pragma unroll
    for (int i = 0; i < 2; ++i) {
      float uc[8], o[8];
      unpack8(rows[i + 1], uc);
#pragma unroll
      for (int e = 0; e < 8; ++e) {
        float xs = uc[e] + (prev[e] - uc[e]) * mu[e];
        o[e] = (cg < 8) ? tanhf(xs) : (cg < 16 ? xs : sigmoidf_(xs));
        prev[e] = uc[e];
      }
      *(u32x4*)(lin + (size_t)(mb + i) * 256 + cg * 8) = pack8(o);
    }
  } else {
    const int s = u - M_TOK / 16;
    const int row0 = row0_of_seq(s), T = T_of_seq(s);
    const bfu* projB = (const bfu*)P.out;
    float* oshift = P.out + (s < 8 ? O_PA_SHIFT + (size_t)s * ASW : O_SA_SHIFT + (size_t)(s - 8) * ASW);
    for (int i = tid; i < ASW; i += 256) oshift[i] = bf2f(projA[(size_t)(row0 + T - 1) * ASW + i]);
    float* oconv = P.out + (s < 8 ? O_PB_CONV + (size_t)s * 3 * BQKV : O_SB_CONV + (size_t)(s - 8) * 3 * BQKV);
    for (int i = tid; i < 3 * BQKV; i += 256) {
      int j = i / BQKV, c = i - j * BQKV;
      oconv[i] = bf2f(projB[(size_t)(row0 + T - 3 + j) * PB_W + c]);
    }
  }
}

DI void ph_lora(const Params& P, int u, char* smem) {
  const int which = u / (MT * 4);
  const int r = u - which * (MT * 4);
  const int mt = r >> 2, nt = r & 3;
  const int m0 = mt * 128, n0 = nt * 128;
  const bfu* lin = (const bfu*)(P.ws + OFF_LORAIN);
  if (which == 0) {
    bfu* stream = (bfu*)(P.ws + OFF_STREAM);
    const float* w0 = P.a_w0;
    gemm_tile<false>(lin + (size_t)m0 * 256, 256, (const bfu*)(P.ws + WT_W2) + (size_t)n0 * 64, 64, m0, n0,
                     (bfu*)smem, [&](int m, int n, f32x4 v) {
                       f32x4 e;
#pragma unroll
                       for (int j = 0; j < 4; ++j) {
                         float w = -softplusf_(-(w0[n + j] + v[j])) - 0.5f;
                         e[j] = __expf(w);
                       }
                       store_bf4(stream + ((size_t)(m * 8 + (n >> 6)) * 6 + 1) * 64 + (n & 63), e);
                     });
  } else if (which == 1) {
    bfu* abuf = (bfu*)(P.ws + OFF_ABUF);
    const float* a0 = P.a_a0;
    gemm_tile<false>(lin + (size_t)m0 * 256 + 64, 256, (const bfu*)(P.ws + WT_A2) + (size_t)n0 * 64, 64, m0, n0,
                     (bfu*)smem, [&](int m, int n, f32x4 v) {
                       f32x4 e;
#pragma unroll
                       for (int j = 0; j < 4; ++j) e[j] = sigmoidf_(a0[n + j] + v[j]);
                       store_bf4(abuf + (size_t)m * 512 + n, e);
                     });
  } else {
    bfu* gbuf = (bfu*)(P.ws + OFF_G);
    gemm_tile<false>(lin + (size_t)m0 * 256 + 128, 256, (const bfu*)(P.ws + WT_G2) + (size_t)n0 * 128, 128, m0, n0,
                     (bfu*)smem, [&](int m, int n, f32x4 v) { store_bf4(gbuf + (size_t)m * 512 + n, v); });
  }
}

DI void ph_prepa(const Params& P, int u, char* smem) {
  const int tid = VT, lane = tid & 63, wave = tid >> 6;
  const int h = lane >> 3, sub = lane & 7;
  const int ch = h * 64 + sub * 8;
  const int m0 = u * 16 + wave * 4;
  const bfu* projA = (const bfu*)(P.ws + OFF_PROJA);
  const bfu* abuf = (const bfu*)(P.ws + OFF_ABUF);
  bfu* stream = (bfu*)(P.ws + OFF_STREAM);
  float mu[3][8], kkc[8], kac[8], rkc[8];
#pragma unroll
  for (int p = 0; p < 3; ++p) load8f(P.a_mu + p * 512 + ch, mu[p]);
  load8f(P.a_k_k + ch, kkc);
  load8f(P.a_k_a + ch, kac);
  load8f(P.a_r_k + ch, rkc);
  float prev[3][8];
  const int t0 = t_of_row(m0);
  if (t0 != 0) {
#pragma unroll
    for (int p = 0; p < 3; ++p) unpack8(*(const u32x4*)(projA + (size_t)(m0 - 1) * ASW + p * 512 + ch), prev[p]);
  } else {
    const int s = seq_of_row(m0);
#pragma unroll
    for (int p = 0; p < 3; ++p) {
      if (s < 8) {
#pragma unroll
        for (int e = 0; e < 8; ++e) prev[p][e] = 0.f;
      } else load8f(P.st_shift + (size_t)(s - 8) * ASW + p * 512 + ch, prev[p]);
    }
  }
#pragma unroll
  for (int g = 0; g < 2; ++g) {
    u32x4 ur[2][3], ar[2];
#pragma unroll
    for (int i = 0; i < 2; ++i) {
      const int m = m0 + g * 2 + i;
#pragma unroll
      for (int p = 0; p < 3; ++p) ur[i][p] = *(const u32x4*)(projA + (size_t)m * ASW + p * 512 + ch);
      ar[i] = *(const u32x4*)(abuf + (size_t)m * 512 + ch);
    }
#pragma unroll
    for (int i = 0; i < 2; ++i) {
      const int m = m0 + g * 2 + i;
      float xs[3][8], a[8];
#pragma unroll
      for (int p = 0; p < 3; ++p) {
        float uc[8];
        unpack8(ur[i][p], uc);
#pragma unroll
        for (int e = 0; e < 8; ++e) {
          xs[p][e] = uc[e] + (prev[p][e] - uc[e]) * mu[p][e];
          prev[p][e] = uc[e];
        }
      }
      unpack8(ar[i], a);
      float kkr[8], k2[8], bb[8];
      float ssl = 0.f, bl = 0.f;
#pragma unroll
      for (int e = 0; e < 8; ++e) {
        kkr[e] = xs[1][e] * kkc[e];
        ssl += kkr[e] * kkr[e];
        k2[e] = xs[1][e] * (1.f + (a[e] - 1.f) * kac[e]);
        bl += xs[0][e] * k2[e] * rkc[e];
      }
      const float rinv = rsqrtf(sum8(ssl) + L2_EPS);
      const float bonus = sum8(bl);
#pragma unroll
      for (int e = 0; e < 8; ++e) {
        kkr[e] *= rinv;
        bb[e] = kkr[e] * a[e];
      }
      bfu* sp = stream + (size_t)(m * 8 + h) * 384 + sub * 8;
      *(u32x4*)(sp) = pack8(xs[0]);
      *(u32x4*)(sp + 128) = pack8(k2);
      *(u32x4*)(sp + 192) = pack8(xs[2]);
      *(u32x4*)(sp + 256) = pack8(kkr);
      *(u32x4*)(sp + 320) = pack8(bb);
      if (sub == 0) ((float*)(P.ws + OFF_BONUS))[m * 8 + h] = bonus;
    }
  }
}

DI void ph_prepb(const Params& P, int u, char* smem) {
  const int tid = VT, lane = tid & 63, wave = tid >> 6;
  const int wt = u * 4 + wave;
  const int tg = wt / 3, p = wt - tg * 3;
  const int h = lane >> 4, sub = lane & 15;
  const int c = p * 512 + h * 128 + sub * 8;
  const int m0 = tg * 8;
  const int s = seq_of_row(m0), t0 = t_of_row(m0);
  const bfu* projB = (const bfu*)P.out;
  bfu* sb = (bfu*)(P.ws + OFF_STREAMB);
  u32x4 rq[11];
#pragma unroll
  for (int i = 0; i < 11; ++i)
    if (t0 + i - 3 >= 0) rq[i] = *(const u32x4*)(projB + (size_t)(m0 + i - 3) * PB_W + c);
  float cw[4][8];
#pragma unroll
  for (int j = 0; j < 4; ++j) load8f(P.b_conv_w + j * BQKV + c, cw[j]);
  float r0[8], r1[8], r2[8], r3[8];
  if (t0 >= 3) {
    unpack8(rq[0], r0);
    unpack8(rq[1], r1);
    unpack8(rq[2], r2);
  } else if (s >= 8) {
    load8f(P.st_bconv + ((size_t)(s - 8) * 3 + 0) * BQKV + c, r0);
    load8f(P.st_bconv + ((size_t)(s - 8) * 3 + 1) * BQKV + c, r1);
    load8f(P.st_bconv + ((size_t)(s - 8) * 3 + 2) * BQKV + c, r2);
  } else {
#pragma unroll
    for (int e = 0; e < 8; ++e) { r0[e] = 0.f; r1[e] = 0.f; r2[e] = 0.f; }
  }
  const float scale = (p == 0) ? 0.08838834764831845f : 1.f;
#pragma unroll
  for (int i = 0; i < 8; ++i) {
    unpack8(rq[i + 3], r3);
    float y[8];
    float ss = 0.f;
#pragma unroll
    for (int e = 0; e < 8; ++e) {
      float a = cw[0][e] * r0[e] + cw[1][e] * r1[e] + cw[2][e] * r2[e] + cw[3][e] * r3[e];
      y[e] = siluf_(a);
      ss += y[e] * y[e];
      r0[e] = r1[e];
      r1[e] = r2[e];
      r2[e] = r3[e];
    }
    if (p < 2) {
      const float rn = rsqrtf(row16_sum(ss) + L2_EPS) * scale;
#pragma unroll
      for (int e = 0; e < 8; ++e) y[e] *= rn;
    }
    *(u32x4*)(sb + (size_t)((m0 + i) * 4 + h) * 384 + p * 128 + sub * 8) = pack8(y);
  }
  if (p == 0 && lane < 32) {
    int i = lane >> 2, hh = lane & 3;
    const float* ba = (const float*)(P.ws + OFF_BA) + (size_t)(m0 + i) * 8;
    float beta = sigmoidf_(ba[hh]);
    float g = -__expf(P.b_a_log[hh]) * softplusf_(ba[4 + hh] + P.b_dt_bias[hh]);
    float* bg = (float*)(P.ws + OFF_BG) + (size_t)(m0 + i) * 8;
    bg[hh] = beta;
    bg[4 + hh] = __expf(g);
    ((float*)(P.ws + OFF_GG))[(size_t)(m0 + i) * 4 + hh] = g;
  }
}

constexpr int CH = 16;
DI void lds_barrier() {
  asm volatile("s_waitcnt lgkmcnt(0)" ::: "memory");
  __builtin_amdgcn_s_barrier();
  asm volatile("" ::: "memory");
}

DI void chunk_gload(u32x4 (&rg)[3], const bfu* base, size_t step_stride, int nsteps) {
#pragma unroll
  for (int j = 0; j < 3; ++j) {
    int idx = VT + 256 * j;
    int st = idx / 48, w = idx - st * 48;
    if (st < nsteps) rg[j] = *(const u32x4*)(base + (size_t)st * step_stride + w * 8);
  }
}
template <bool DECAY>
DI void chunk_lstore(const u32x4 (&rg)[3], float* buf, int nsteps) {
#pragma unroll
  for (int j = 0; j < 3; ++j) {
    int idx = VT + 256 * j;
    int st = idx / 48, w = idx - st * 48;
    if (st < nsteps) {
      float4 a, b;
      a.x = lo_bf(rg[j].x); a.y = hi_bf(rg[j].x); a.z = lo_bf(rg[j].y); a.w = hi_bf(rg[j].y);
      b.x = lo_bf(rg[j].z); b.y = hi_bf(rg[j].z); b.z = lo_bf(rg[j].w); b.w = hi_bf(rg[j].w);
      if (DECAY && (w >> 3) == 1) {
        a.x = __expf(-a.x); a.y = __expf(-a.y); a.z = __expf(-a.z); a.w = __expf(-a.w);
        b.x = __expf(-b.x); b.y = __expf(-b.y); b.z = __expf(-b.z); b.w = __expf(-b.w);
      }
      float* d = buf + st * 384 + w * 8;
      *(float4*)d = a;
      *(float4*)(d + 4) = b;
    }
  }
}

DI float dot4(f32x4 a, f32x4 b) {
  typedef float f2 __attribute__((ext_vector_type(2)));
  const f2 a01 = {a[0], a[1]}, a23 = {a[2], a[3]}, b01 = {b[0], b[1]}, b23 = {b[2], b[3]};
  const f2 t = a23 * b23 + a01 * b01;
  return t[0] + t[1];
}
template <int R> struct RwkvOps { f32x4 r4, w4, k4, kk4, b4; float vv[R]; };
template <int R>
DI void rwkv_ld(RwkvOps<R>& o, const float* b, int j0, int v) {
  o.r4 = *(const f32x4*)(b + j0);
  o.w4 = *(const f32x4*)(b + 64 + j0);
  o.k4 = *(const f32x4*)(b + 128 + j0);
#pragma unroll
  for (int r = 0; r < R; ++r) o.vv[r] = b[192 + v + r * 16];
  o.kk4 = *(const f32x4*)(b + 256 + j0);
  o.b4 = *(const f32x4*)(b + 320 + j0);
}
template <int NS, int R>
DI void rwkv_steps(const float* buf, f32x4 (&S)[R], int j0, int v, int l15, float (&oacc)[R], float* qp) {
  RwkvOps<R> ops[3];
  rwkv_ld<R>(ops[0], buf, j0, v);
  rwkv_ld<R>(ops[1], buf + 384, j0, v);
#pragma unroll
  for (int st = 0; st < NS; ++st) {
    if (st + 2 < NS) rwkv_ld<R>(ops[(st + 2) % 3], buf + (st + 2) * 384, j0, v);
    const RwkvOps<R>& o = ops[st % 3];
    float p[R], q[R];
#pragma unroll
    for (int r = 0; r < R; ++r) p[r] = dot4(S[r], o.kk4);
#pragma unroll
    for (int r = 0; r < R; ++r) p[r] = row16_sum(p[r]);
#pragma unroll
    for (int r = 0; r < R; ++r) {
      const f32x4 base = S[r] * o.w4 + o.k4 * o.vv[r];
      S[r] = base - o.b4 * p[r];
    }
#pragma unroll
    for (int r = 0; r < R; ++r) q[r] = dot4(S[r], o.r4);
    if constexpr (R == 1) {
      qp[st * 64] = q[0];
    } else {
#pragma unroll
      for (int r = 0; r < R; ++r) {
        q[r] = row16_sum(q[r]);
        oacc[r] = (l15 == st) ? q[r] : oacc[r];
      }
    }
  }
  if constexpr (R == 1) {
    asm volatile("" ::: "memory");
    const float* qr = qp + l15 * 64 - l15;
    const f32x4 a = *(const f32x4*)(qr), b = *(const f32x4*)(qr + 4), c = *(const f32x4*)(qr + 8), d = *(const f32x4*)(qr + 12);
    const f32x4 s4 = (a + b) + (c + d);
    oacc[0] = (s4[0] + s4[1]) + (s4[2] + s4[3]);
    asm volatile("" ::: "memory");
  }
}

template <int R>
DI void rwkv_unit(const Params& P, int s, int h, int rgp, char* smem) {
  const int tid = VT, lane = tid & 63, wave = tid >> 6;
  const int T = T_of_seq(s), row0 = row0_of_seq(s);
  const int vl = wave * 4 + (lane >> 4);
  const int v = rgp * (16 * R) + vl;
  const int l15 = lane & 15;
  const int j0 = l15 * 4;
  float* buf0 = (float*)smem;
  float* qp = buf0 + 2 * CH * 384 + wave * (CH * 64) + lane;
  f32x4 S[R];
#pragma unroll
  for (int r = 0; r < R; ++r) {
    if (s < 8) S[r] = f32x4{0.f, 0.f, 0.f, 0.f};
    else S[r] = *(const f32x4*)(P.st_wkv + (((size_t)(s - 8) * 8 + h) * 64 + v + r * 16) * 64 + j0);
  }
  const bfu* stream = (const bfu*)(P.ws + OFF_STREAM) + ((size_t)row0 * 8 + h) * 384;
  const size_t sstride = 8 * 384;
  bfu* omix = (bfu*)(P.ws + OFF_OMIX) + (size_t)row0 * 1024 + h * 64 + v;
  const int nch = (T + CH - 1) / CH;
  u32x4 rg[3], rgB[3], rgC[3];
  chunk_gload(rg, stream, sstride, min(CH, T));
  chunk_lstore<true>(rg, buf0, min(CH, T));
  __syncthreads();
  if (nch > 1) chunk_gload(rg, stream + (size_t)1 * CH * sstride, sstride, min(CH, T - 1 * CH));
  if (nch > 2) chunk_gload(rgB, stream + (size_t)2 * CH * sstride, sstride, min(CH, T - 2 * CH));
  if (nch > 3) chunk_gload(rgC, stream + (size_t)3 * CH * sstride, sstride, min(CH, T - 3 * CH));
  if (R == 1) __builtin_amdgcn_s_setprio(3);
  for (int c = 0; c < nch; ++c) {
    const int nsteps = min(CH, T - c * CH);
    const int nnext = (c + 1 < nch) ? min(CH, T - (c + 1) * CH) : 0;
    const float* buf = buf0 + (c & 1) * CH * 384;
    float oacc[R];
#pragma unroll
    for (int r = 0; r < R; ++r) oacc[r] = 0.f;
    if (nsteps == CH) rwkv_steps<CH, R>(buf, S, j0, v, l15, oacc, qp);
    else rwkv_steps<8, R>(buf, S, j0, v, l15, oacc, qp);
    if (l15 < nsteps) {
#pragma unroll
      for (int r = 0; r < R; ++r) omix[(size_t)(c * CH + l15) * 1024 + r * 16] = f2bf(oacc[r]);
    }
    if (nnext > 0) chunk_lstore<true>(rg, buf0 + ((c + 1) & 1) * CH * 384, nnext);
#pragma unroll
    for (int j = 0; j < 3; ++j) { rg[j] = rgB[j]; rgB[j] = rgC[j]; }
    if (c + 4 < nch) chunk_gload(rgC, stream + (size_t)(c + 4) * CH * sstride, sstride, min(CH, T - (c + 4) * CH));
    lds_barrier();
  }
  if (R == 1) __builtin_amdgcn_s_setprio(0);
  float* o = P.out + (s < 8 ? O_PA_WKV + (((size_t)s * 8 + h) * 64 + v) * 64 + j0
                            : O_SA_WKV + (((size_t)(s - 8) * 8 + h) * 64 + v) * 64 + j0);
#pragma unroll
  for (int r = 0; r < R; ++r) *(f32x4*)(o + (size_t)r * 16 * 64) = S[r];
}

template <int R> struct DeltaOps { f32x4 q0, q1, k0, k1; float vv[R], beta, alpha; };
template <int R>
DI void delta_ld(DeltaOps<R>& o, const float* b, const float* bg, int j0, int c) {
  o.q0 = *(const f32x4*)(b + j0);
  o.q1 = *(const f32x4*)(b + 64 + j0);
  o.k0 = *(const f32x4*)(b + 128 + j0);
  o.k1 = *(const f32x4*)(b + 192 + j0);
#pragma unroll
  for (int r = 0; r < R; ++r) o.vv[r] = b[256 + c + r * 16];
  o.beta = bg[0];
  o.alpha = bg[1];
}
template <int NS, int R>
DI void delta_steps(const float* buf, const float* bgc, f32x4 (&S0)[R], f32x4 (&S1)[R], int j0, int c, int l15,
                    float (&oacc)[R]) {
  DeltaOps<R> ops[3];
  delta_ld<R>(ops[0], buf, bgc, j0, c);
  delta_ld<R>(ops[1], buf + 384, bgc + 2, j0, c);
#pragma unroll
  for (int st = 0; st < NS; ++st) {
    if (st + 2 < NS) delta_ld<R>(ops[(st + 2) % 3], buf + (st + 2) * 384, bgc + (st + 2) * 2, j0, c);
    const DeltaOps<R>& o = ops[st % 3];
    float p[R], q[R];
#pragma unroll
    for (int r = 0; r < R; ++r) {
      const f32x4 t0 = S0[r] * o.k0 + S1[r] * o.k1;
      p[r] = (t0[0] + t0[1]) + (t0[2] + t0[3]);
    }
#pragma unroll
    for (int r = 0; r < R; ++r) p[r] = row16_sum(p[r]);
#pragma unroll
    for (int r = 0; r < R; ++r) {
      const float vn = o.beta * (o.vv[r] - o.alpha * p[r]);
      S0[r] = S0[r] * o.alpha + o.k0 * vn;
      S1[r] = S1[r] * o.alpha + o.k1 * vn;
      const f32x4 t1 = S0[r] * o.q0 + S1[r] * o.q1;
      q[r] = (t1[0] + t1[1]) + (t1[2] + t1[3]);
    }
#pragma unroll
    for (int r = 0; r < R; ++r) {
      q[r] = row16_sum(q[r]);
      oacc[r] = (l15 == st) ? q[r] : oacc[r];
    }
  }
}

template <int R>
DI void delta_unit(const Params& P, int s, int h, int cg_, char* smem) {
  const int tid = VT, lane = tid & 63, wave = tid >> 6;
  const int T = T_of_seq(s), row0 = row0_of_seq(s);
  const int cl = wave * 4 + (lane >> 4);
  const int c = cg_ * (16 * R) + cl;
  const int l15 = lane & 15;
  const int j0 = l15 * 4;
  float* buf0 = (float*)smem;
  float* bgb = buf0 + 2 * CH * 384;
  f32x4 S0[R], S1[R];
#pragma unroll
  for (int r = 0; r < R; ++r) {
    if (s < 8) {
      S0[r] = f32x4{0.f, 0.f, 0.f, 0.f};
      S1[r] = S0[r];
    } else {
      const float* sp = P.st_ssm + (((size_t)(s - 8) * 4 + h) * 128 + j0) * 128 + c + r * 16;
#pragma unroll
      for (int i = 0; i < 4; ++i) { S0[r][i] = sp[(size_t)i * 128]; S1[r][i] = sp[(size_t)(i + 64) * 128]; }
    }
  }
  const bfu* stream = (const bfu*)(P.ws + OFF_STREAMB) + ((size_t)row0 * 4 + h) * 384;
  const size_t sstride = 4 * 384;
  const float* bg = (const float*)(P.ws + OFF_BG);
  bfu* omix = (bfu*)(P.ws + OFF_OMIX) + (size_t)row0 * 1024 + 512 + h * 128 + c;
  const int nch = (T + CH - 1) / CH;
  u32x4 rg[3];
  float bgr = 0.f;
  {
    int n0 = min(CH, T);
    chunk_gload(rg, stream, sstride, n0);
    if (tid < n0 * 2) bgr = bg[(size_t)(row0 + (tid >> 1)) * 8 + (tid & 1) * 4 + h];
    chunk_lstore<false>(rg, buf0, n0);
    if (tid < n0 * 2) bgb[tid] = bgr;
  }
  __syncthreads();
  for (int ci = 0; ci < nch; ++ci) {
    const int nsteps = min(CH, T - ci * CH);
    const int nnext = (ci + 1 < nch) ? min(CH, T - (ci + 1) * CH) : 0;
    if (nnext > 0) {
      chunk_gload(rg, stream + (size_t)(ci + 1) * CH * sstride, sstride, nnext);
      if (tid < nnext * 2) bgr = bg[(size_t)(row0 + (ci + 1) * CH + (tid >> 1)) * 8 + (tid & 1) * 4 + h];
    }
    const float* buf = buf0 + (ci & 1) * CH * 384;
    const float* bgc = bgb + (ci & 1) * CH * 2;
    float oacc[R];
#pragma unroll
    for (int r = 0; r < R; ++r) oacc[r] = 0.f;
    if (nsteps == CH) delta_steps<CH, R>(buf, bgc, S0, S1, j0, c, l15, oacc);
    else delta_steps<8, R>(buf, bgc, S0, S1, j0, c, l15, oacc);
    if (l15 < nsteps) {
#pragma unroll
      for (int r = 0; r < R; ++r) omix[(size_t)(ci * CH + l15) * 1024 + r * 16] = f2bf(oacc[r]);
    }
    if (nnext > 0) {
      chunk_lstore<false>(rg, buf0 + ((ci + 1) & 1) * CH * 384, nnext);
      if (tid < nnext * 2) bgb[((ci + 1) & 1) * CH * 2 + tid] = bgr;
    }
    lds_barrier();
  }
  float* o = P.out + (s < 8 ? O_PB_SSM + (((size_t)s * 4 + h) * 128 + j0) * 128 + c
                            : O_SB_SSM + (((size_t)(s - 8) * 4 + h) * 128 + j0) * 128 + c);
#pragma unroll
  for (int r = 0; r < R; ++r)
#pragma unroll
    for (int i = 0; i < 4; ++i) { o[(size_t)i * 128 + r * 16] = S0[r][i]; o[(size_t)(i + 64) * 128 + r * 16] = S1[r][i]; }
}

constexpr int DLD = 136;
template <int I> struct SubStep {
  static DI void run(float (&sol)[64], const float* Lm, const float* scp, const bfu* colp) {
    SubStep<I - 1>::run(sol, Lm, scp, colp);
    float a0 = bf2f(colp[I * 136]) * scp[I], a1 = 0.f;
#pragma unroll
    for (int j4 = 0; j4 < (I + 3) / 4; ++j4) {
      const f32x4 l = *(const f32x4*)(Lm + I * 68 + j4 * 4);
      if (j4 * 4 + 0 < I) a0 -= l[0] * sol[j4 * 4 + 0];
      if (j4 * 4 + 1 < I) a1 -= l[1] * sol[j4 * 4 + 1];
      if (j4 * 4 + 2 < I) a0 -= l[2] * sol[j4 * 4 + 2];
      if (j4 * 4 + 3 < I) a1 -= l[3] * sol[j4 * 4 + 3];
      if ((j4 & 3) == 3) { asm volatile("" ::: "memory"); __builtin_amdgcn_sched_barrier(0); }
    }
    sol[I] = a0 + a1;
    asm volatile("" ::: "memory");
    __builtin_amdgcn_sched_barrier(0);
  }
};
template <> struct SubStep<-1> {
  static DI void run(float (&)[64], const float*, const float*, const bfu*) {}
};

DI void delta_d1(const Params& P, int item, char* smem) {
  int tid_ = VT; asm volatile("" : "+v"(tid_));
  const int tid = tid_, lane = tid & 63, wave = tid >> 6;
  const int chunk = item & 31, h = (item >> 5) & 3, s = item >> 7;
  const int m0 = s * 2048 + chunk * 64;
  bfu* Qs = (bfu*)smem;
  bfu* Ks = Qs + 64 * DLD;
  bfu* Vs = Ks + 64 * DLD;
  float* Lm = (float*)(Vs + 64 * DLD);
  float* Gs = Lm + 64 * 68;
  float* Bs = Gs + 64;
  float* Bk = Bs + 64;
  bfu* sb = (bfu*)(P.ws + OFF_STREAMB);
  bfu* projB = (bfu*)P.out;
#pragma unroll
  for (int j = 0; j < 4; ++j) {
    const int idx = tid + 256 * j, row = idx >> 4, c8 = (idx & 15) * 8;
    const bfu* sp = sb + ((size_t)(m0 + row) * 4 + h) * 384 + c8;
    *(u32x4*)(Qs + row * DLD + c8) = *(const u32x4*)sp;
    *(u32x4*)(Ks + row * DLD + c8) = *(const u32x4*)(sp + 128);
    *(u32x4*)(Vs + row * DLD + c8) = *(const u32x4*)(sp + 256);
  }
  if (wave == 0) {
    float x = ((const float*)(P.ws + OFF_GG))[(size_t)(m0 + lane) * 4 + h];
#pragma unroll
    for (int off = 1; off < 64; off <<= 1) {
      const float y = __shfl_up(x, off, 64);
      if (lane >= off) x += y;
    }
    Gs[lane] = x;
    ((float*)(projB + (size_t)(m0 + lane) * PB_W + 768))[h] = x;
    const float be = ((const float*)(P.ws + OFF_BG))[(size_t)(m0 + lane) * 8 + h];
    Bs[lane] = be;
    Bk[lane] = be * __expf(x);
  }
  __syncthreads();
  {
#pragma unroll 1
    for (int nt = 0; nt < 4; ++nt) {
      f32x4 akk = f32x4{0.f, 0.f, 0.f, 0.f}, aqk = akk;
#pragma unroll
      for (int ks = 0; ks < 4; ++ks) {
        const int ko = ks * 32 + (lane >> 4) * 8;
        const bf16x8 ak = *(const bf16x8*)(Ks + (16 * wave + (lane & 15)) * DLD + ko);
        const bf16x8 aq = *(const bf16x8*)(Qs + (16 * wave + (lane & 15)) * DLD + ko);
        const bf16x8 b = *(const bf16x8*)(Ks + (16 * nt + (lane & 15)) * DLD + ko);
        akk = __builtin_amdgcn_mfma_f32_16x16x32_bf16(ak, b, akk, 0, 0, 0);
        aqk = __builtin_amdgcn_mfma_f32_16x16x32_bf16(aq, b, aqk, 0, 0, 0);
      }
#pragma unroll
      for (int j = 0; j < 4; ++j) {
        const int i = 16 * wave + (lane >> 4) * 4 + j, jj = 16 * nt + (lane & 15);
        const float e = __expf(fminf(Gs[i] - Gs[jj], 0.f));
        Lm[i * 68 + jj] = (jj < i) ? Bs[i] * akk[j] * e : 0.f;
        projB[(size_t)(m0 + i) * PB_W + 512 + h * 64 + jj] = f2bf((jj <= i) ? aqk[j] * e : 0.f);
      }
    }
  }
  __syncthreads();
  {
    const bool isv = tid < 128;
    const bfu* colp = isv ? Vs + tid : Ks + (tid - 128);
    float sol[64];
    SubStep<63>::run(sol, Lm, isv ? Bs : Bk, colp);
    __syncthreads();
    bfu* Ob = (bfu*)smem;
#pragma unroll
    for (int i = 0; i < 64; ++i) Ob[i * 264 + tid] = f2bf(sol[i]);
  }
  __syncthreads();
  {
    const bfu* Ob = (const bfu*)smem;
#pragma unroll
    for (int j = 0; j < 8; ++j) {
      const int idx = tid + 256 * j, row = idx >> 5, c8 = (idx & 31) * 8;
      const u32x4 v = *(const u32x4*)(Ob + row * 264 + c8);
      if (c8 < 128) *(u32x4*)(sb + ((size_t)(m0 + row) * 4 + h) * 384 + 256 + c8) = v;
      else *(u32x4*)(projB + (size_t)(m0 + row) * PB_W + h * 128 + (c8 - 128)) = v;
    }
  }
  __syncthreads();
}

DI void delta_d2(const Params& P, int s, int h, int cg_, char* smem) {
  int tid_ = VT; asm volatile("" : "+v"(tid_));
  const int tid = tid_, lane = tid & 63, wave = tid >> 6;
  const int r16 = lane & 15, q4 = lane >> 4;
  bfu* Ws = (bfu*)smem;
  bfu* Qs = Ws + 64 * DLD;
  bfu* KT = Qs + 64 * DLD;
  bfu* AT = KT + 128 * 72;
  bfu* VnT = AT + 64 * 72;
  bfu* ST = VnT + 16 * 72;
  float* Us = (float*)(ST + 16 * DLD);
  const int row0 = s * 2048, col0 = cg_ * 16;
  const bfu* sb = (const bfu*)(P.ws + OFF_STREAMB);
  const bfu* projB = (const bfu*)P.out;
  bfu* omix = (bfu*)(P.ws + OFF_OMIX);
  f32x4 accS[2];
  accS[0] = f32x4{0.f, 0.f, 0.f, 0.f};
  accS[1] = accS[0];
  for (int i = tid; i < 16 * DLD / 2; i += 256) ((unsigned*)ST)[i] = 0u;
  u32x4 rw[4], rq[4], rk[4], ra[2], ru;
  float gj[4], gk = 0.f, glast = 0.f, glcur = 0.f;
#define D2_PREFETCH(cc)                                                                                   \
  {                                                                                                       \
    const int mb = row0 + (cc) * 64;                                                                      \
    _Pragma("unroll") for (int j = 0; j < 4; ++j) {                                                       \
      const int idx = tid + 256 * j, row = idx >> 4, c8 = (idx & 15) * 8;                                 \
      const size_t m = (size_t)(mb + row);                                                                \
      rw[j] = *(const u32x4*)(projB + m * PB_W + h * 128 + c8);                                           \
      rq[j] = *(const u32x4*)(sb + (m * 4 + h) * 384 + c8);                                               \
      gj[j] = ((const float*)(projB + m * PB_W + 768))[h];                                                \
      rk[j] = *(const u32x4*)(sb + ((size_t)(mb + (tid & 63)) * 4 + h) * 384 + 128 + ((tid >> 6) + 4 * j) * 8); \
    }                                                                                                     \
    gk = ((const float*)(projB + (size_t)(mb + (tid & 63)) * PB_W + 768))[h];                             \
    _Pragma("unroll") for (int j = 0; j < 2; ++j) {                                                       \
      const int idx = tid + 256 * j, row = idx >> 3, c8 = (idx & 7) * 8;                                  \
      ra[j] = *(const u32x4*)(projB + (size_t)(mb + row) * PB_W + 512 + h * 64 + c8);                     \
    }                                                                                                     \
    if (tid < 128) ru = *(const u32x4*)(sb + ((size_t)(mb + (tid >> 1)) * 4 + h) * 384 + 256 + col0 + (tid & 1) * 8); \
    glast = ((const float*)(projB + (size_t)(mb + 63) * PB_W + 768))[h];                                  \
  }
#define D2_STAGE1()                                                                                       \
  {                                                                                                       \
    const float ek = __expf(glast - gk);                                                                  \
    _Pragma("unroll") for (int j = 0; j < 4; ++j) {                                                       \
      const int c8 = ((tid >> 6) + 4 * j) * 8;                                                            \
      float f[8];                                                                                         \
      unpack8(rk[j], f);                                                                                  \
      _Pragma("unroll") for (int e = 0; e < 8; ++e) KT[(c8 + e) * 72 + (tid & 63)] = f2bf(f[e] * ek);     \
    }                                                                                                     \
  }
#define D2_STAGE2()                                                                                       \
  {                                                                                                       \
    _Pragma("unroll") for (int j = 0; j < 4; ++j) {                                                       \
      const int idx = tid + 256 * j, row = idx >> 4, c8 = (idx & 15) * 8;                                 \
      *(u32x4*)(Ws + row * DLD + c8) = rw[j];                                                             \
      const float eq = __expf(gj[j]);                                                                     \
      float f[8];                                                                                         \
      unpack8(rq[j], f);                                                                                  \
      _Pragma("unroll") for (int e = 0; e < 8; ++e) f[e] *= eq;                                           \
      *(u32x4*)(Qs + row * DLD + c8) = pack8(f);                                                          \
    }                                                                                                     \
    _Pragma("unroll") for (int j = 0; j < 2; ++j) {                                                       \
      const int idx = tid + 256 * j, row = idx >> 3, c8 = (idx & 7) * 8;                                  \
      *(u32x4*)(AT + row * 72 + c8) = ra[j];                                                              \
    }                                                                                                     \
    if (tid < 128) {                                                                                      \
      float f[8];                                                                                         \
      unpack8(ru, f);                                                                                     \
      float* up = Us + (tid >> 1) * 16 + (tid & 1) * 8;                                                   \
      *(f32x4*)up = f32x4{f[0], f[1], f[2], f[3]};                                                        \
      *(f32x4*)(up + 4) = f32x4{f[4], f[5], f[6], f[7]};                                                  \
    }                                                                                                     \
    glcur = glast;                                                                                        \
  }
  D2_PREFETCH(0);
  D2_STAGE1();
  D2_STAGE2();
  D2_PREFETCH(1);
  __syncthreads();
  for (int c = 0; c < 32; ++c) {
    f32x4 av = f32x4{0.f, 0.f, 0.f, 0.f}, ao = av;
#pragma unroll
    for (int ks = 0; ks < 4; ++ks) {
      const int ko = ks * 32 + q4 * 8;
      const bf16x8 bw = *(const bf16x8*)(Ws + (16 * wave + r16) * DLD + ko);
      const bf16x8 bq = *(const bf16x8*)(Qs + (16 * wave + r16) * DLD + ko);
      const bf16x8 bs = *(const bf16x8*)(ST + r16 * DLD + ko);
      av = __builtin_amdgcn_mfma_f32_16x16x32_bf16(bw, bs, av, 0, 0, 0);
      ao = __builtin_amdgcn_mfma_f32_16x16x32_bf16(bq, bs, ao, 0, 0, 0);
    }
    {
      const int tk = 16 * wave + q4 * 4;
      float vn[4];
#pragma unroll
      for (int j = 0; j < 4; ++j) vn[j] = Us[(tk + j) * 16 + r16] - av[j];
      *(uint2*)(VnT + r16 * 72 + tk) = uint2{pack2(vn[0], vn[1]), pack2(vn[2], vn[3])};
    }
    lds_barrier();
    bf16x8 bv[2];
#pragma unroll
    for (int ks = 0; ks < 2; ++ks) {
      bv[ks] = *(const bf16x8*)(VnT + r16 * 72 + ks * 32 + q4 * 8);
      const bf16x8 ba = *(const bf16x8*)(AT + (16 * wave + r16) * 72 + ks * 32 + q4 * 8);
      ao = __builtin_amdgcn_mfma_f32_16x16x32_bf16(ba, bv[ks], ao, 0, 0, 0);
    }
    {
      bfu* op = omix + (size_t)(row0 + c * 64 + 16 * wave + q4 * 4) * 1024 + 512 + h * 128 + col0 + r16;
#pragma unroll
      for (int j = 0; j < 4; ++j) op[(size_t)j * 1024] = f2bf(ao[j]);
    }
    {
      const float gl = __expf(glcur);
#pragma unroll
      for (int t = 0; t < 2; ++t) {
        accS[t] = accS[t] * gl;
#pragma unroll
        for (int ks = 0; ks < 2; ++ks) {
          const bf16x8 bk = *(const bf16x8*)(KT + (16 * (2 * wave + t) + r16) * 72 + ks * 32 + q4 * 8);
          accS[t] = __builtin_amdgcn_mfma_f32_16x16x32_bf16(bv[ks], bk, accS[t], 0, 0, 0);
        }
      }
    }
    lds_barrier();
#pragma unroll
    for (int t = 0; t < 2; ++t)
#pragma unroll
      for (int j = 0; j < 4; ++j) ST[(q4 * 4 + j) * DLD + 16 * (2 * wave + t) + r16] = f2bf(accS[t][j]);
    if (c + 1 < 32) D2_STAGE1();
    lds_barrier();
    if (c + 1 < 32) D2_STAGE2();
    if (c + 2 < 32) D2_PREFETCH(c + 2);
    lds_barrier();
  }
#undef D2_PREFETCH
#undef D2_STAGE1
#undef D2_STAGE2
  float* o = P.out + O_PB_SSM + ((size_t)(s * 4 + h) * 128) * 128 + col0;
#pragma unroll
  for (int t = 0; t < 2; ++t)
#pragma unroll
    for (int j = 0; j < 4; ++j) o[(size_t)(16 * (2 * wave + t) + r16) * 128 + q4 * 4 + j] = accS[t][j];
}

DI void ph_d1(const Params& P, int u, char* smem) { delta_d1(P, u, smem); }

DI void ph_scan(const Params& P, int u, char* smem) {
  const int k = u >> 1;
  if (k < 256) {
    if (u & 1) delta_d2(P, k >> 5, (k >> 3) & 3, k & 7, smem);
    else rwkv_unit<1>(P, k >> 5, (k >> 2) & 7, k & 3, smem);
  } else {
    const int j = k - 256;
    if (u & 1) delta_unit<4>(P, 8 + (j >> 3), (j >> 1) & 3, j & 1, smem);
    else rwkv_unit<4>(P, 8 + (j >> 3), j & 7, 0, smem);
  }
}

DI void ph_post(const Params& P, int u, char* smem) {
  const int tid = VT, lane = tid & 63, wave = tid >> 6;
  const int m0 = u * 8 + wave * 2;
  bfu* omix = (bfu*)(P.ws + OFF_OMIX);
  {
    const int h = lane >> 3, sub = lane & 7, ch = h * 64 + sub * 8;
    float gng[8], gnb[8];
    load8f(P.a_gn_g + ch, gng);
    load8f(P.a_gn_b + ch, gnb);
    u32x4 oq[2], vq[2], gq[2];
    float bon[2];
#pragma unroll
    for (int i = 0; i < 2; ++i) {
      const int m = m0 + i;
      oq[i] = *(const u32x4*)(omix + (size_t)m * 1024 + ch);
      vq[i] = *(const u32x4*)((const bfu*)(P.ws + OFF_STREAM) + (size_t)(m * 8 + h) * 384 + 192 + sub * 8);
      gq[i] = *(const u32x4*)((const bfu*)(P.ws + OFF_G) + (size_t)m * 512 + ch);
      bon[i] = ((const float*)(P.ws + OFF_BONUS))[m * 8 + h];
    }
#pragma unroll
    for (int i = 0; i < 2; ++i) {
      float o[8], v[8], g[8], r[8];
      unpack8(oq[i], o);
      unpack8(vq[i], v);
      unpack8(gq[i], g);
      float s = 0.f;
#pragma unroll
      for (int e = 0; e < 8; ++e) s += o[e];
      const float mean = sum8(s) * (1.f / 64.f);
      float q = 0.f;
#pragma unroll
      for (int e = 0; e < 8; ++e) {
        o[e] -= mean;
        q += o[e] * o[e];
      }
      const float rs = rsqrtf(sum8(q) * (1.f / 64.f) + GN_EPS);
#pragma unroll
      for (int e = 0; e < 8; ++e) r[e] = ((o[e] * rs * gng[e] + gnb[e]) + bon[i] * v[e]) * g[e];
      *(u32x4*)(omix + (size_t)(m0 + i) * 1024 + ch) = pack8(r);
    }
  }
  {
    const int h = lane >> 4, sub = lane & 15, ch = h * 128 + sub * 8;
    float ng[8];
    load8f(P.b_norm_g + sub * 8, ng);
    u32x4 oq[2], zq[2];
#pragma unroll
    for (int i = 0; i < 2; ++i) {
      const int m = m0 + i;
      oq[i] = *(const u32x4*)(omix + (size_t)m * 1024 + 512 + ch);
      zq[i] = *(const u32x4*)((const bfu*)P.out + (size_t)m * PB_W + 1536 + ch);
    }
#pragma unroll
    for (int i = 0; i < 2; ++i) {
      float o[8], z[8], r[8];
      unpack8(oq[i], o);
      unpack8(zq[i], z);
      float q = 0.f;
#pragma unroll
      for (int e = 0; e < 8; ++e) q += o[e] * o[e];
      const float rinv = rsqrtf(row16_sum(q) * (1.f / 128.f) + RMS_EPS);
#pragma unroll
      for (int e = 0; e < 8; ++e) r[e] = o[e] * rinv * ng[e] * siluf_(z[e]);
      *(u32x4*)(omix + (size_t)(m0 + i) * 1024 + 512 + ch) = pack8(r);
    }
  }
}

DI void ln_rows4(const float* src, float* dst, bfu* dstb, const float* g, const float* b, int lane) {
  f32x4 v[4][4];
#pragma unroll
  for (int r = 0; r < 4; ++r)
#pragma unroll
    for (int i = 0; i < 4; ++i) v[r][i] = *(const f32x4*)(src + (size_t)r * DM + i * 256 + lane * 4);
  f32x4 gg[4], bb[4];
#pragma unroll
  for (int i = 0; i < 4; ++i) {
    gg[i] = *(const f32x4*)(g + i * 256 + lane * 4);
    bb[i] = *(const f32x4*)(b + i * 256 + lane * 4);
  }
#pragma unroll
  for (int r = 0; r < 4; ++r) {
    float s = 0.f;
#pragma unroll
    for (int i = 0; i < 4; ++i) s += (v[r][i][0] + v[r][i][1]) + (v[r][i][2] + v[r][i][3]);
    const float mean = wave_sum(s) * (1.f / 1024.f);
    float q = 0.f;
#pragma unroll
    for (int i = 0; i < 4; ++i) {
      v[r][i] = v[r][i] - mean;
      q += (v[r][i][0] * v[r][i][0] + v[r][i][1] * v[r][i][1]) + (v[r][i][2] * v[r][i][2] + v[r][i][3] * v[r][i][3]);
    }
    const float rstd = rsqrtf(wave_sum(q) * (1.f / 1024.f) + LN_EPS);
#pragma unroll
    for (int i = 0; i < 4; ++i) {
      const f32x4 o = v[r][i] * rstd * gg[i] + bb[i];
      if (dst) *(f32x4*)(dst + (size_t)r * DM + i * 256 + lane * 4) = o;
      store_bf4(dstb + (size_t)r * DM + i * 256 + lane * 4, o);
    }
  }
}

template <int NR>
DI void ln_rowsb(const bfu* src, bfu* dst, const float* g, const float* b, int lane) {
  u32x4 q[NR][2];
#pragma unroll
  for (int r = 0; r < NR; ++r)
#pragma unroll
    for (int i = 0; i < 2; ++i) q[r][i] = *(const u32x4*)(src + (size_t)r * DM + i * 512 + lane * 8);
  float gg[2][8], bb[2][8];
#pragma unroll
  for (int i = 0; i < 2; ++i) {
    load8f(g + i * 512 + lane * 8, gg[i]);
    load8f(b + i * 512 + lane * 8, bb[i]);
  }
#pragma unroll
  for (int r = 0; r < NR; ++r) {
    float v[2][8];
    unpack8(q[r][0], v[0]);
    unpack8(q[r][1], v[1]);
    float s = 0.f;
#pragma unroll
    for (int i = 0; i < 2; ++i)
#pragma unroll
      for (int e = 0; e < 8; ++e) s += v[i][e];
    const float mean = wave_sum(s) * (1.f / 1024.f);
    float sq = 0.f;
#pragma unroll
    for (int i = 0; i < 2; ++i)
#pragma unroll
      for (int e = 0; e < 8; ++e) {
        v[i][e] -= mean;
        sq += v[i][e] * v[i][e];
      }
    const float rstd = rsqrtf(wave_sum(sq) * (1.f / 1024.f) + LN_EPS);
#pragma unroll
    for (int i = 0; i < 2; ++i) {
      float o[8];
#pragma unroll
      for (int e = 0; e < 8; ++e) o[e] = v[i][e] * rstd * gg[i][e] + bb[i][e];
      *(u32x4*)(dst + (size_t)r * DM + i * 512 + lane * 8) = pack8(o);
    }
  }
}

template <bool RESF>
DI void ln_row_slabs(const float* slabrow, const void* res, bfu* dst, const float* g, const float* b, int lane) {
  f32x4 v[4];
#pragma unroll
  for (int i = 0; i < 4; ++i) {
    const int co = i * 256 + lane * 4;
    f32x4 r;
    if constexpr (RESF) r = *(const f32x4*)((const float*)res + co);
    else {
      const uint2 q = *(const uint2*)((const bfu*)res + co);
      r = f32x4{lo_bf(q.x), hi_bf(q.x), lo_bf(q.y), hi_bf(q.y)};
    }
    const f32x4 s0 = *(const f32x4*)(slabrow + co), s1 = *(const f32x4*)(slabrow + (size_t)1024 * 1024 + co);
    const f32x4 s2 = *(const f32x4*)(slabrow + (size_t)2 * 1024 * 1024 + co), s3 = *(const f32x4*)(slabrow + (size_t)3 * 1024 * 1024 + co);
    v[i] = r * DN_ALPHA + ((s0 + s1) + (s2 + s3));
  }
  float s = 0.f;
#pragma unroll
  for (int i = 0; i < 4; ++i) s += (v[i][0] + v[i][1]) + (v[i][2] + v[i][3]);
  const float mean = wave_sum(s) * (1.f / 1024.f);
  float q = 0.f;
#pragma unroll
  for (int i = 0; i < 4; ++i) {
    v[i] = v[i] - mean;
    q += (v[i][0] * v[i][0] + v[i][1] * v[i][1]) + (v[i][2] * v[i][2] + v[i][3] * v[i][3]);
  }
  const float rstd = rsqrtf(wave_sum(q) * (1.f / 1024.f) + LN_EPS);
#pragma unroll
  for (int i = 0; i < 4; ++i) {
    const int co = i * 256 + lane * 4;
    const f32x4 gg = *(const f32x4*)(g + co), bb = *(const f32x4*)(b + co);
    store_bf4(dst + co, v[i] * rstd * gg + bb);
  }
}
#define EPRE(ws_) ((bfu*)((ws_) + OFF_GU))
#define FSLAB(ws_) ((float*)((ws_) + OFF_GU + 5632))
#define SLABS(P) ((P).out + (size_t)M_TOK * 512)

DI void ph_ln1(const Params& P, int u, char* smem) {
  const int lane = VT & 63, wave = VT >> 6;
  const int m = u * 8 + wave * 2;
  if (m >= M_P) {
    for (int r = 0; r < 2; ++r) {
      const int rs = m - M_P + r;
      ln_row_slabs<true>(SLABS(P) + (size_t)rs * DM, P.x_s + (size_t)rs * DM, (bfu*)(P.ws + OFF_X1B) + (size_t)(m + r) * DM,
                         P.ln1_g, P.ln1_b, lane);
    }
    return;
  }
  ln_rowsb<2>((const bfu*)P.out + (size_t)m * DM, (bfu*)(P.ws + OFF_X1B) + (size_t)m * DM, P.ln1_g, P.ln1_b, lane);
}

DI void ffnconv_slot(const Params& P, int slot) {
  const int tg = slot / 352, cs = slot - tg * 352;
  const int m0 = tg * 8, c = cs * 8;
  const int s = seq_of_row(m0), t0 = t_of_row(m0);
  const int T = T_of_seq(s);
  bfu* gu = (bfu*)(P.ws + OFF_GU);
  u32x4 gq[10], uq[8];
#pragma unroll
  for (int i = 0; i < 10; ++i)
    if (t0 + i - 2 >= 0) gq[i] = *(const u32x4*)(gu + (size_t)(m0 + i - 2) * 5632 + c);
#pragma unroll
  for (int i = 0; i < 8; ++i) uq[i] = *(const u32x4*)(gu + (size_t)(m0 + i) * 5632 + DFF + c);
  float w[3][8], fb[8];
#pragma unroll
  for (int j = 0; j < 3; ++j) load8f(P.f_conv_w + j * DFF + c, w[j]);
  load8f(P.f_conv_b + c, fb);
  float g0[8], g1[8], g2[8];
  if (t0 >= 2) {
    unpack8(gq[0], g0);
    unpack8(gq[1], g1);
  } else if (s >= 8) {
    load8f(P.st_fconv + ((size_t)(s - 8) * 2 + 0) * DFF + c, g0);
    load8f(P.st_fconv + ((size_t)(s - 8) * 2 + 1) * DFF + c, g1);
  } else {
#pragma unroll
    for (int e = 0; e < 8; ++e) { g0[e] = 0.f; g1[e] = 0.f; }
  }
#pragma unroll
  for (int i = 0; i < 8; ++i) {
    float up[8], hh[8];
    unpack8(gq[i + 2], g2);
    unpack8(uq[i], up);
#pragma unroll
    for (int e = 0; e < 8; ++e) {
      float a = w[0][e] * g0[e] + w[1][e] * g1[e] + w[2][e] * g2[e] + fb[e];
      hh[e] = siluf_(a) * up[e];
      g0[e] = g1[e];
      g1[e] = g2[e];
    }
    *(u32x4*)(gu + (size_t)(m0 + i) * 5632 + DFF + c) = pack8(hh);
  }
  if (t0 + 8 == T) {
    float* ostate = P.out + (s < 8 ? O_PF_CONV + (size_t)s * 2 * DFF : O_SF_CONV + (size_t)(s - 8) * 2 * DFF);
    *(f32x4*)(ostate + c) = f32x4{g0[0], g0[1], g0[2], g0[3]};
    *(f32x4*)(ostate + c + 4) = f32x4{g0[4], g0[5], g0[6], g0[7]};
    *(f32x4*)(ostate + DFF + c) = f32x4{g1[0], g1[1], g1[2], g1[3]};
    *(f32x4*)(ostate + DFF + c + 4) = f32x4{g1[4], g1[5], g1[6], g1[7]};
  }
}

DI void ph_ffnconv(const Params& P, int u, char* smem) {
  if (u >= 352) {
    ffnconv_slot(P, 2048 * 352 + (u - 352) * 256 + VT);
    return;
  }
  const int slot = u * 256 + VT;
  const int slab = slot / 352, c = (slot - slab * 352) * 8;
  const bfu* hg = FFN_HG(P);
  const bfu* hu = FFN_HU(P);
  bfu* gu = (bfu*)(P.ws + OFF_GU);
  float w0[8], w1[8], w2[8], fb[8];
  load8f(P.f_conv_w + c, w0);
  load8f(P.f_conv_w + DFF + c, w1);
  load8f(P.f_conv_w + 2 * DFF + c, w2);
  load8f(P.f_conv_b + c, fb);
  float a2[8], a1[8], c0[8], c1[8], u0[8], u1[8];
  if ((slab & 31) != 0) {
    unpack8(*(const u32x4*)(hg + ((size_t)(slab - 1) * 4 + 0) * DFF + c), a2);
    unpack8(*(const u32x4*)(hg + ((size_t)(slab - 1) * 4 + 1) * DFF + c), a1);
  } else {
#pragma unroll
    for (int e = 0; e < 8; ++e) { a2[e] = 0.f; a1[e] = 0.f; }
  }
  unpack8(*(const u32x4*)(hg + ((size_t)slab * 4 + 2) * DFF + c), c0);
  unpack8(*(const u32x4*)(hg + ((size_t)slab * 4 + 3) * DFF + c), c1);
  unpack8(*(const u32x4*)(hu + ((size_t)slab * 2 + 0) * DFF + c), u0);
  unpack8(*(const u32x4*)(hu + ((size_t)slab * 2 + 1) * DFF + c), u1);
  float h0[8], h1[8];
#pragma unroll
  for (int e = 0; e < 8; ++e) {
    h0[e] = siluf_(w0[e] * a2[e] + w1[e] * a1[e] + w2[e] * c0[e] + fb[e]) * u0[e];
    h1[e] = siluf_(w0[e] * a1[e] + w1[e] * c0[e] + w2[e] * c1[e] + fb[e]) * u1[e];
  }
  *(u32x4*)(gu + (size_t)(slab * 64) * (2 * DFF) + DFF + c) = pack8(h0);
  *(u32x4*)(gu + (size_t)(slab * 64 + 1) * (2 * DFF) + DFF + c) = pack8(h1);
}

DI void ph_ln2_ple(const Params& P, int u, char* smem) {
  const int lane = VT & 63, wave = VT >> 6;
  const int m = u * 8 + wave * 2;
  if (m >= M_P) {
    for (int r = 0; r < 2; ++r) {
      const int rs = m - M_P + r;
      ln_row_slabs<false>(SLABS(P) + (size_t)rs * DM, (const bfu*)(P.ws + OFF_X1B) + (size_t)(m + r) * DM,
                          (bfu*)(P.ws + OFF_X2B) + (size_t)(m + r) * DM, P.ln2_g, P.ln2_b, lane);
    }
    return;
  }
  ln_rowsb<2>((const bfu*)P.out + (size_t)m * DM, (bfu*)(P.ws + OFF_X2B) + (size_t)m * DM, P.ln2_g, P.ln2_b, lane);
}

DI void ph_rinv(const Params& P, int u, char* smem) {
  const int lane = VT & 63, wave = VT >> 6;
  const int m = u * 16 + wave * 4;
  const bfu* ep = EPRE(P.ws) + (size_t)m * EP_LD;
  u32x4 v[4][2];
#pragma unroll
  for (int r = 0; r < 4; ++r)
#pragma unroll
    for (int i = 0; i < 2; ++i) v[r][i] = *(const u32x4*)(ep + (size_t)r * EP_LD + i * 512 + lane * 8);
#pragma unroll
  for (int r = 0; r < 4; ++r) {
    float q = 0.f;
#pragma unroll
    for (int i = 0; i < 2; ++i) {
      float a[8];
      unpack8(v[r][i], a);
#pragma unroll
      for (int e = 0; e < 8; ++e) q += a[e] * a[e];
    }
    q = wave_sum(q);
    if (lane == 0) ((float*)(P.ws + OFF_RINV))[m + r] = rsqrtf(q * (1.f / 1024.f) + RMS_EPS);
  }
}

DI void ph_fins(const Params& P, int u, char* smem) {
  const int lane = VT & 63, wave = VT >> 6;
  const int rs = u * 4 + wave, m = M_P + rs;
  const float* sl = FSLAB(P.ws) + (size_t)rs * FSL_LD;
  const bfu* x2 = (const bfu*)(P.ws + OFF_X2B) + (size_t)m * DM;
  const bfu* ep = EPRE(P.ws) + (size_t)m * EP_LD;
  const float ri = ((const float*)(P.ws + OFF_RINV))[m];
#pragma unroll
  for (int i = 0; i < 4; ++i) {
    const int co = i * 256 + lane * 4;
    const f32x4 s0 = *(const f32x4*)(sl + co), s1 = *(const f32x4*)(sl + (size_t)1024 * FSL_LD + co);
    const f32x4 s2 = *(const f32x4*)(sl + (size_t)2 * 1024 * FSL_LD + co), s3 = *(const f32x4*)(sl + (size_t)3 * 1024 * FSL_LD + co);
    const f32x4 a = (s0 + s1) + (s2 + s3);
    const uint2 xq = *(const uint2*)(x2 + co);
    const uint2 eq = *(const uint2*)(ep + co);
    const f32x4 gv = *(const f32x4*)(P.ple_g + co);
    f32x4 o;
    o[0] = lo_bf(xq.x) + sigmoidf_(a[0]) * (lo_bf(eq.x) * ri * gv[0]);
    o[1] = hi_bf(xq.x) + sigmoidf_(a[1]) * (hi_bf(eq.x) * ri * gv[1]);
    o[2] = lo_bf(xq.y) + sigmoidf_(a[2]) * (lo_bf(eq.y) * ri * gv[2]);
    o[3] = hi_bf(xq.y) + sigmoidf_(a[3]) * (hi_bf(eq.y) * ri * gv[3]);
    *(f32x4*)(P.out + (size_t)m * DM + co) = o;
  }
}

template <int PH>
DI void run_unit(const Params& P, int u, char* smem) {
  if (PH == PH_WT) ph_wt(P, u, smem);
  else if (PH == PH_LORAIN) ph_lorain(P, u, smem);
  else if (PH == PH_LORA) ph_lora(P, u, smem);
  else if (PH == PH_PREPA) ph_prepa(P, u, smem);
  else if (PH == PH_PREPB) ph_prepb(P, u, smem);
  else if (PH == PH_D1) ph_d1(P, u, smem);
  else if (PH == PH_SCAN) ph_scan(P, u, smem);
  else if (PH == PH_POST) ph_post(P, u, smem);
  else if (PH == PH_LN1) ph_ln1(P, u, smem);
  else if (PH == PH_FFNCONV) ph_ffnconv(P, u, smem);
  else if (PH == PH_LN2_PLE) ph_ln2_ple(P, u, smem);
  else if (PH == PH_RINV) ph_rinv(P, u, smem);
  else if (PH == PH_FINS) ph_fins(P, u, smem);
}

template <int PH>
DI void run_phase(const Params& P, char* lds) {
  const int half = (int)(threadIdx.x >> 8);
  char* smem = lds + half * SMEM_BYTES;
  const int n = units_of(PH, P.wd_tiles);
  for (int u = (int)blockIdx.x * 2 + half; u < n; u += 2 * (int)gridDim.x) run_unit<PH>(P, u, smem);
}

#define XB_TMO      128
#define XB_XCNT(j)  (256  + 64 * (j))
#define XB_XSUB(j)  (1280 + 64 * (j))
#define XB_XGEN(j)  (2304 + 64 * (j))
#define XB_TOP      3328
#define XB_TOPGEN   3392
#define XCD_BAR_WORDS 3456
#define XB_SPIN_CAP (1u << 18)
#define XLAS __attribute__((address_space(3)))

__device__ __forceinline__ unsigned xb_ld(unsigned* p)              { return __hip_atomic_load(p, __ATOMIC_RELAXED, __HIP_MEMORY_SCOPE_AGENT); }
__device__ __forceinline__ unsigned xb_add(unsigned* p, unsigned v) { return __hip_atomic_fetch_add(p, v, __ATOMIC_RELAXED, __HIP_MEMORY_SCOPE_AGENT); }
__device__ __forceinline__ unsigned xb_xcc_id() { return (unsigned)__builtin_amdgcn_s_getreg((3 << 11) | 20) & 0xFu; }
#define XB_SPIN(cond, bar) do { unsigned _sp = 0; while (cond) { __builtin_amdgcn_s_sleep(1); \
    if ((++_sp & 255u) == 0u) { if (xb_ld(&(bar)[XB_TMO])) break; if (_sp > XB_SPIN_CAP) { atomicAdd(&(bar)[XB_TMO], 1u); break; } } } } while (0)

struct XcdBarrier {
    unsigned* bar; unsigned x;
    volatile XLAS unsigned* st;
};

__device__ __forceinline__ XcdBarrier xcd_barrier_post(unsigned* bar, volatile XLAS unsigned* st) {
    XcdBarrier b; b.bar = bar; b.x = xb_xcc_id(); b.st = st;
    if (threadIdx.x == 0) (void)xb_add(&bar[XB_XCNT(b.x)], 1u);
    return b;
}
__device__ __forceinline__ void xcd_barrier_complete(unsigned* bar, unsigned x, unsigned& nloc, unsigned& nx) {
    const unsigned G = gridDim.x * gridDim.y * gridDim.z;
    unsigned sum, cnt, mine, sp = 0u;
    for (;;) {
        sum = 0u; cnt = 0u; mine = 0u;
#pragma unroll
        for (unsigned j = 0; j < 16; ++j) { const unsigned c = xb_ld(&bar[XB_XCNT(j)]); sum += c; cnt += (c > 0u) ? 1u : 0u; mine = (j == x) ? c : mine; }
        if (sum == G) break;
        __builtin_amdgcn_s_sleep(1);
        if ((++sp & 255u) == 0u) { if (xb_ld(&bar[XB_TMO])) break; if (sp > XB_SPIN_CAP) { atomicAdd(&bar[XB_TMO], 1u); break; } }
    }
    nloc = mine > 0u ? mine : 1u; nx = cnt > 0u ? cnt : 1u;
}

__device__ __forceinline__ void xcd_barrier(const XcdBarrier& b) {
    asm volatile("s_waitcnt vmcnt(0)" ::: "memory");
    __syncthreads();
    if (threadIdx.x == 0) {
        unsigned* bar = b.bar;
        __builtin_amdgcn_s_waitcnt(0);
        unsigned nloc = b.st[0], nx = b.st[1];
        if (nloc == 0u) { xcd_barrier_complete(bar, b.x, nloc, nx); b.st[0] = nloc; b.st[1] = nx; }
        const unsigned old = xb_add(&bar[XB_XSUB(b.x)], 1u);
        const unsigned gen = old / nloc;
        if (old + 1u == (gen + 1u) * nloc) {
            __builtin_amdgcn_fence(__ATOMIC_RELEASE, "agent");
            asm volatile("s_waitcnt vmcnt(0)" ::: "memory");
            const unsigned og = xb_add(&bar[XB_TOP], 1u);
            const unsigned tg = og / nx;
            if (og + 1u == (tg + 1u) * nx) xb_add(&bar[XB_TOPGEN], 1u);
            else XB_SPIN(xb_ld(&bar[XB_TOPGEN]) == tg, bar);
            __builtin_amdgcn_fence(__ATOMIC_ACQUIRE, "agent");
            xb_add(&bar[XB_XGEN(b.x)], 1u);
            asm volatile("s_waitcnt vmcnt(0)" ::: "memory");
        } else {
            XB_SPIN(xb_ld(&bar[XB_XGEN(b.x)]) == gen, bar);
            __builtin_amdgcn_fence(__ATOMIC_ACQUIRE, "agent");
            asm volatile("s_waitcnt vmcnt(0)" ::: "memory");
        }
    }
    __syncthreads();
}


constexpr int DYN_LDS = 2 * SMEM_BYTES + 16;

__global__ void __launch_bounds__(512, 2) k_mega(Params P) {
  extern __shared__ __attribute__((aligned(16))) unsigned char dyn_lds[];
  cg::grid_group grid = cg::this_grid();
  PG8_LAS unsigned char* lds3 = (PG8_LAS unsigned char*)dyn_lds;
  char* lds = (char*)dyn_lds;
  char* ws = P.ws;
  volatile XLAS unsigned* xst = (volatile XLAS unsigned*)((PG8_LAS unsigned char*)dyn_lds + 2 * SMEM_BYTES);
  if (threadIdx.x == 0) { xst[0] = 0u; xst[1] = 0u; xst[2] = 0u; xst[3] = 0u; }
  __syncthreads();
  const XcdBarrier xbar = xcd_barrier_post((unsigned*)(ws + OFF_END), xst);
  run_phase<PH_WT>(P, lds);
  if (P.pad_ != 0) grid.sync();
  xcd_barrier(xbar);
  {
    EpiBf16Split E{(bfu*)(ws + OFF_PROJA), ASW, (bfu*)P.out, PB_W, ASW};
    run_pg8(lds3, (const bfu*)(ws + OFF_XB), DM, (const bfu*)(ws + WT_IN), M_TOK, 3840, DM, E);
  }
  xcd_barrier(xbar);
  run_phase<PH_LORAIN>(P, lds);
  xcd_barrier(xbar);
  run_phase<PH_LORA>(P, lds);
  xcd_barrier(xbar);
  run_phase<PH_PREPA>(P, lds);
  xcd_barrier(xbar);
  run_phase<PH_PREPB>(P, lds);
  xcd_barrier(xbar);
  run_phase<PH_D1>(P, lds);
  xcd_barrier(xbar);
  run_phase<PH_SCAN>(P, lds);
  xcd_barrier(xbar);
  run_phase<PH_POST>(P, lds);
  xcd_barrier(xbar);
  {
    EpiResO E{P.x_p, P.x_s, (bfu*)P.out};
    run_pg8(lds3, (const bfu*)(ws + OFF_OMIX), DM, (const bfu*)(ws + WT_O), M_P, DM, DM, E);
  }
  run_split(lds3, (const bfu*)(ws + OFF_OMIX), DM, (const bfu*)(ws + WT_O), DM, SLABS(P), DM);
  if (blockIdx.x >= 64) {
    const int half = (int)(threadIdx.x >> 8);
    for (int t = ((int)blockIdx.x - 64) * 2 + half; t < P.wd_tiles - WT_EARLY; t += 2 * ((int)gridDim.x - 64))
      ph_wt_impl(P, WT_EARLY + t, lds + half * SMEM_BYTES);
  }
  xcd_barrier(xbar);
  run_phase<PH_LN1>(P, lds);
  xcd_barrier(xbar);
  {
    EpiFfn E{(bfu*)(ws + OFF_GU), FFN_HG(P), FFN_HU(P), P.f_conv_w, P.f_conv_b, P.out + O_PF_CONV};
    run_pg8(lds3, (const bfu*)(ws + OFF_X1B), DM, (const bfu*)(ws + WT_UP), M_TOK, 2 * DFF, DM, E);
  }
  if (blockIdx.x >= 216) {
    const int half = (int)(threadIdx.x >> 8);
    for (int u = ((int)blockIdx.x - 216) * 2 + half; u < M_TOK / 16; u += 2 * ((int)gridDim.x - 216)) ph_pconv(P, u);
  }
  xcd_barrier(xbar);
  run_phase<PH_FFNCONV>(P, lds);
  xcd_barrier(xbar);
  {
    EpiResD E{(const bfu*)(ws + OFF_X1B), (bfu*)P.out};
    run_pg8(lds3, (const bfu*)(ws + OFF_GU) + DFF, 2 * DFF, (const bfu*)(ws + WT_DOWN), M_P, DM, DFF, E);
  }
  run_split(lds3, (const bfu*)(ws + OFF_GU) + DFF, 2 * DFF, (const bfu*)(ws + WT_DOWN), DFF, SLABS(P), DM);
  if (blockIdx.x >= 64) {
    EpiBf16Split E{EPRE(ws), EP_LD, EPRE(ws), EP_LD, 1 << 30};
    run_pg8_sub(lds3, (const bfu*)(ws + OFF_PB), PLE, (const bfu*)(ws + WT_PLE), M_TOK, DM, PLE, E, (int)gridDim.x - 64,
                (int)blockIdx.x - 64);
  }
  xcd_barrier(xbar);
  run_phase<PH_LN2_PLE>(P, lds);
  run_phase<PH_RINV>(P, lds);
  xcd_barrier(xbar);
  {
    EpiFin E{(const bfu*)(ws + OFF_X2B), EPRE(ws), (const float*)(ws + OFF_RINV), P.ple_g, P.out};
    run_pg8(lds3, (const bfu*)(ws + OFF_X2B), DM, (const bfu*)(ws + WT_GATE), M_P, DM, DM, E);
  }
  run_split(lds3, (const bfu*)(ws + OFF_X2B), DM, (const bfu*)(ws + WT_GATE), DM, FSLAB(ws), FSL_LD);
  xcd_barrier(xbar);
  run_phase<PH_FINS>(P, lds);
}

extern "C" void kernel_launch(void* const* d_in, const int* in_sizes, int n_in, void* d_out, int out_size,
                              void* d_ws, size_t ws_size, hipStream_t stream) {
  Params P;
  memset(&P, 0, sizeof(P));
  const float** f = (const float**)&P;
  for (int i = 0; i < 37; ++i) f[i] = (const float*)d_in[i];
  P.out = (float*)d_out;
  P.ws = (char*)d_ws;
  char* ws = (char*)d_ws;
  struct { const float* src; size_t off; int K, N, Npad; } wl[9] = {
      {P.w_in, WT_IN, 1024, INW, INW_PAD},   {P.a_w_w2, WT_W2, 64, 512, 512},   {P.a_w_a2, WT_A2, 64, 512, 512},
      {P.a_w_g2, WT_G2, 128, 512, 512},      {P.w_o, WT_O, 1024, 1024, 1024},   {P.w_up, WT_UP, 1024, 5632, 5632},
      {P.w_down, WT_DOWN, 2816, 1024, 1024}, {P.w_ple, WT_PLE, 256, 1024, 1024}, {P.w_ple_gate, WT_GATE, 1024, 1024, 1024}};
  int t0 = 0;
  for (int i = 0; i < 9; ++i) {
    P.wd[i].src = wl[i].src;
    P.wd[i].dst = (bfu*)(ws + wl[i].off);
    P.wd[i].K = wl[i].K;
    P.wd[i].N = wl[i].N;
    P.wd[i].Npad = wl[i].Npad;
    P.wd[i].t0 = t0;
    t0 += (wl[i].Npad / 64) * (wl[i].K / 64);
  }
  P.wd_tiles = t0;
  static int grid_blocks = 0;
  if (!grid_blocks) {
    int dev = 0, cus = 0, per_cu = 0;
    hipGetDevice(&dev);
    hipDeviceGetAttribute(&cus, hipDeviceAttributeMultiprocessorCount, dev);
    hipFuncSetAttribute((const void*)k_mega, hipFuncAttributeMaxDynamicSharedMemorySize, DYN_LDS);
    hipOccupancyMaxActiveBlocksPerMultiprocessor(&per_cu, (const void*)k_mega, 512, DYN_LDS);
    if (per_cu < 1) per_cu = 1;
    if (per_cu > 1) per_cu = 1;
    grid_blocks = cus * per_cu;
  }
  hipMemsetAsync((char*)d_ws + OFF_END, 0, XCD_BAR_WORDS * 4, stream);
  void* args[] = {&P};
  hipError_t e = hipLaunchCooperativeKernel((void*)k_mega, dim3(grid_blocks), dim3(512), args, DYN_LDS, stream);
  if (e != hipSuccess) fprintf(stderr, "cooperative launch failed: %s (grid %d)\n", hipGetErrorString(e), grid_blocks);
}
```
